# Optimizing an MI355X kernel written in HIP

```python
import jax, jax.numpy as jnp
from jax import lax
import numpy as np

D_MODEL = 1024
BATCH = 4
SEQ = 4096
DEPTH = 1
DEC_BATCH = 2
DEC_SEQ = 8192
PAST_LEN = 128

HEAD_DIM = 64
D_MIX = D_MODEL
D_RWKV = D_MIX // 2
D_ATTN = D_MIX - D_RWKV
N_RWKV_HEADS = D_RWKV // HEAD_DIM
N_Q_HEADS = D_ATTN // HEAD_DIM
N_KV_HEADS = 2
D_KV = N_KV_HEADS * HEAD_DIM
DECAY_LORA = 64
AAA_LORA = 64
GATE_LORA = 128
N_DIR = 2
RWKV_GN_EPS = 64e-5
SHIFT_SIZES = (D_RWKV, D_RWKV, D_RWKV, N_DIR * DECAY_LORA, N_DIR * AAA_LORA, GATE_LORA)
ATTN_SIZES = (D_ATTN, D_KV, D_KV)
D_SHIFT = 3 * D_RWKV + N_DIR * (DECAY_LORA + AAA_LORA) + GATE_LORA
D_IN = D_SHIFT + D_ATTN + 2 * D_KV
GRID_W = 64
ROPE_THETA = 10000.0
ROPE_AXIS_DIM = HEAD_DIM // 2
Q_BLOCK = 128
N_KEYS = 128
N_EXPERTS = N_KEYS * N_KEYS
PEER_HEADS = 8
PEER_TOPK = 16
PEER_DKEY = 256
PEER_BLOCK = 128
NORM_EPS = 1e-6

kernel_name = "hymba_rwkv7_axialgqa_peer_encoder"


def rms_norm(x, g):
    xf = x.astype(jnp.float32)
    y = xf * lax.rsqrt(jnp.mean(xf * xf, axis=-1, keepdims=True) + NORM_EPS)
    return (y * g.astype(jnp.float32)).astype(x.dtype)


def split_cols(z, sizes):
    outs, o = [], 0
    for s in sizes:
        outs.append(z[..., o:o + s])
        o += s
    return outs


def centred_shift(z):
    prev = jnp.pad(z[:, :-1], ((0, 0), (1, 0), (0, 0)))
    nxt = jnp.pad(z[:, 1:], ((0, 0), (0, 1), (0, 0)))
    return 0.5 * (prev + nxt) - z


def rwkv_scan(r, w, k, v, kk, a):
    def step(S, inp):
        r_t, w_t, k_t, v_t, kk_t, a_t = inp
        sa = jnp.einsum('dbhvk,dbhk->dbhv', S, -kk_t)
        S = S * w_t[..., None, :] + sa[..., None] * (kk_t * a_t)[..., None, :] + v_t[..., None] * k_t[..., None, :]
        y = jnp.einsum('dbhvk,dbhk->dbhv', S, r_t)
        return S, y
    T, Dd, B, H, N = r.shape
    S0 = jnp.zeros((Dd, B, H, N, N), jnp.float32)
    _, ys = lax.scan(step, S0, (r, w, k, v, kk, a))
    return ys


def rwkv7_bidir(p_r, p_k, p_v, p_w, p_a, p_g, w0, w2, a0, a2, g2, k_k, k_a, r_k, ln_w, ln_b):
    B, T, C = p_r.shape
    H, N = N_RWKV_HEADS, HEAD_DIM
    f32 = jnp.float32
    r = p_r.astype(f32)
    k = p_k.astype(f32)
    v = p_v.astype(f32)
    hw = jnp.tanh(p_w.astype(f32).reshape(B, T, N_DIR, DECAY_LORA))
    w_log = w0.astype(f32) + jnp.einsum('btdl,dlc->btdc', hw, w2.astype(f32))
    decay = jnp.exp(-jnp.exp(-jax.nn.softplus(-w_log) - 0.5))
    ha = p_a.astype(f32).reshape(B, T, N_DIR, AAA_LORA)
    a = jax.nn.sigmoid(a0.astype(f32) + jnp.einsum('btdl,dlc->btdc', ha, a2.astype(f32)))
    g = jax.nn.sigmoid(p_g.astype(f32)) @ g2.astype(f32)
    kk = (k * k_k.astype(f32)).reshape(B, T, H, N)
    kk = (kk / jnp.maximum(jnp.linalg.norm(kk, axis=-1, keepdims=True), 1e-12)).reshape(B, T, C)
    k_dir = k[:, :, None, :] * (1.0 + (a - 1.0) * k_a.astype(f32))

    def to_scan(z):
        if z.ndim == 3:
            z = jnp.broadcast_to(z[:, :, None, :], (B, T, N_DIR, C))
        z = jnp.stack([z[:, :, 0], jnp.flip(z[:, :, 1], axis=1)], axis=0)
        return z.reshape(N_DIR, B, T, H, N).transpose(2, 0, 1, 3, 4)

    ys = rwkv_scan(to_scan(r), to_scan(decay), to_scan(k_dir), to_scan(v), to_scan(kk), to_scan(a))
    y = (ys[:, 0] + jnp.flip(ys[:, 1], axis=0)).transpose(1, 0, 2, 3)
    mu = jnp.mean(y, axis=-1, keepdims=True)
    var = jnp.mean(jnp.square(y - mu), axis=-1, keepdims=True)
    y = ((y - mu) * lax.rsqrt(var + RWKV_GN_EPS)).reshape(B, T, C) * ln_w.astype(f32) + ln_b.astype(f32)
    k_b = jnp.mean(k_dir, axis=2).reshape(B, T, H, N)
    bonus = jnp.sum(r.reshape(B, T, H, N) * k_b * r_k.astype(f32), axis=-1, keepdims=True) * v.reshape(B, T, H, N)
    return (y + bonus.reshape(B, T, C)) * g


def rope_1d(x, ang):
    cos = jnp.cos(ang)[None, :, None, :].astype(x.dtype)
    sin = jnp.sin(ang)[None, :, None, :].astype(x.dtype)
    x1, x2 = jnp.split(x, 2, axis=-1)
    return jnp.concatenate([x1 * cos - x2 * sin, x1 * sin + x2 * cos], axis=-1)


def axial_rope(x, n_rows):
    inv_freq = ROPE_THETA ** (-jnp.arange(0, ROPE_AXIS_DIM, 2, dtype=jnp.float32) / ROPE_AXIS_DIM)
    rows = jnp.repeat(jnp.arange(n_rows, dtype=jnp.float32), GRID_W)
    cols = jnp.tile(jnp.arange(GRID_W, dtype=jnp.float32), n_rows)
    xr, xc = x[..., :ROPE_AXIS_DIM], x[..., ROPE_AXIS_DIM:]
    return jnp.concatenate([rope_1d(xr, rows[:, None] * inv_freq), rope_1d(xc, cols[:, None] * inv_freq)], axis=-1)


def gqa_axial(q, k, v, q_g, k_g, out_g):
    B, T, _ = q.shape
    n_rows = T // GRID_W
    G = N_Q_HEADS // N_KV_HEADS
    nblk = T // Q_BLOCK
    scale = HEAD_DIM ** -0.5
    q = axial_rope(rms_norm(q.reshape(B, T, N_Q_HEADS, HEAD_DIM), q_g), n_rows)
    k = axial_rope(rms_norm(k.reshape(B, T, N_KV_HEADS, HEAD_DIM), k_g), n_rows)
    v = v.reshape(B, T, N_KV_HEADS, HEAD_DIM)
    qb = q.reshape(B, nblk, Q_BLOCK, N_KV_HEADS, G, HEAD_DIM).transpose(1, 0, 3, 4, 2, 5)
    kt = k.transpose(0, 2, 1, 3)
    vt = v.transpose(0, 2, 1, 3)

    def block(qx):
        s = jnp.einsum('bkgqd,bkld->bkgql', qx, kt).astype(jnp.float32) * scale
        p = jax.nn.softmax(s, axis=-1).astype(vt.dtype)
        return jnp.einsum('bkgql,bkld->bkgqd', p, vt)

    o = lax.map(block, qb)
    o = o.transpose(1, 0, 4, 2, 3, 5).reshape(B, T, N_Q_HEADS, HEAD_DIM)
    o = rms_norm(o, out_g.reshape(N_Q_HEADS, HEAD_DIM))
    return o.reshape(B, T, D_ATTN)


def peer(h, wq, sub_keys, u_tab, v_tab):
    B, T, D = h.shape
    nb = T // PEER_BLOCK
    hb = h.reshape(B, nb, PEER_BLOCK, D).transpose(1, 0, 2, 3)

    def block(hx):
        q = (hx @ wq).reshape(B, PEER_BLOCK, PEER_HEADS, 2, PEER_DKEY // 2)
        s = jnp.einsum('bqhpd,pnd->bqhpn', q, sub_keys).astype(jnp.float32)
        sv, si = lax.top_k(s, PEER_TOPK)
        cand = (sv[..., 0, :, None] + sv[..., 1, None, :]).reshape(B, PEER_BLOCK, PEER_HEADS, PEER_TOPK * PEER_TOPK)
        cidx = (si[..., 0, :, None] * N_KEYS + si[..., 1, None, :]).reshape(B, PEER_BLOCK, PEER_HEADS, PEER_TOPK * PEER_TOPK)
        tv, ti = lax.top_k(cand, PEER_TOPK)
        eidx = jnp.take_along_axis(cidx, ti, axis=-1).reshape(B, PEER_BLOCK, PEER_HEADS * PEER_TOPK)
        gate = jax.nn.softmax(tv, axis=-1).reshape(B, PEER_BLOCK, PEER_HEADS * PEER_TOPK)
        u = u_tab[eidx]
        act = jax.nn.gelu(jnp.einsum('bqed,bqd->bqe', u, hx).astype(jnp.float32), approximate=False)
        vv = v_tab[eidx]
        return jnp.einsum('bqe,bqed->bqd', (gate * act).astype(hx.dtype), vv)

    out = lax.map(block, hb)
    return out.transpose(1, 0, 2, 3).reshape(B, T, D)


def encoder_layer(x, c, ada_w, ada_b, norm1_g, norm2_g, w_in, mu_shift, w0, w2, a0, a2, g2, k_k, k_a, r_k,
                  ln_x_w, ln_x_b, q_norm_g, k_norm_g, attn_out_g, w_out, peer_wq, peer_sub_keys, peer_u, peer_v):
    mod = (jax.nn.silu(c.astype(jnp.float32)) @ ada_w.astype(jnp.float32) + ada_b.astype(jnp.float32)).astype(x.dtype)
    sh1, sc1, gt1, sh2, sc2, gt2 = [m[:, None, :] for m in jnp.split(mod, 6, axis=-1)]
    h = rms_norm(x, norm1_g) * (1 + sc1) + sh1
    proj = h @ w_in
    p_shift, p_attn = proj[..., :D_SHIFT], proj[..., D_SHIFT:]
    p_shift = p_shift + mu_shift * centred_shift(p_shift)
    p_r, p_k, p_v, p_w, p_a, p_g = split_cols(p_shift, SHIFT_SIZES)
    q, k, v = split_cols(p_attn, ATTN_SIZES)
    y_rwkv = rwkv7_bidir(p_r, p_k, p_v, p_w, p_a, p_g, w0, w2, a0, a2, g2, k_k, k_a, r_k, ln_x_w, ln_x_b)
    y_attn = gqa_axial(q, k, v, q_norm_g, k_norm_g, attn_out_g)
    mix = jnp.concatenate([y_rwkv.astype(x.dtype), y_attn], axis=-1) @ w_out
    x = x + gt1 * mix
    h2 = rms_norm(x, norm2_g) * (1 + sc2) + sh2
    x = x + gt2 * peer(h2, peer_wq, peer_sub_keys, peer_u, peer_v)
    return x


def setup_inputs(seed: int = 0) -> dict:
    key = jax.random.key(seed)
    ks = iter(jax.random.split(key, 40))
    f32 = jnp.float32

    def nrm(shape, s):
        return jax.random.normal(next(ks), shape, f32) * s

    return {
        "x_prompt": nrm((BATCH, SEQ, D_MODEL), 1.0),
        "x_sample": nrm((DEC_BATCH, DEC_SEQ, D_MODEL), 1.0),
        "c_prompt": nrm((BATCH, D_MODEL), 1.0),
        "c_sample": nrm((DEC_BATCH, D_MODEL), 1.0),
        "ada_w": nrm((DEPTH, D_MODEL, 6 * D_MODEL), 0.2 * D_MODEL ** -0.5),
        "ada_b": nrm((DEPTH, 6 * D_MODEL), 0.01),
        "norm1_g": 1.0 + nrm((DEPTH, D_MODEL), 0.02),
        "norm2_g": 1.0 + nrm((DEPTH, D_MODEL), 0.02),
        "w_in": nrm((DEPTH, D_MODEL, D_IN), D_MODEL ** -0.5),
        "mu_shift": jax.random.uniform(next(ks), (DEPTH, D_SHIFT), f32),
        "w0": jax.random.uniform(next(ks), (DEPTH, N_DIR, D_RWKV), f32, -5.0, 1.0),
        "w2": nrm((DEPTH, N_DIR, DECAY_LORA, D_RWKV), 0.1 * DECAY_LORA ** -0.5),
        "a0": nrm((DEPTH, N_DIR, D_RWKV), 0.1),
        "a2": nrm((DEPTH, N_DIR, AAA_LORA, D_RWKV), 0.1 * AAA_LORA ** -0.5),
        "g2": nrm((DEPTH, GATE_LORA, D_RWKV), GATE_LORA ** -0.5),
        "k_k": 0.85 + nrm((DEPTH, D_RWKV), 0.02),
        "k_a": 1.0 + nrm((DEPTH, D_RWKV), 0.02),
        "r_k": nrm((DEPTH, N_RWKV_HEADS, HEAD_DIM), 0.1),
        "ln_x_w": 1.0 + nrm((DEPTH, D_RWKV), 0.02),
        "ln_x_b": nrm((DEPTH, D_RWKV), 0.01),
        "q_norm_g": 1.0 + nrm((DEPTH, HEAD_DIM), 0.02),
        "k_norm_g": 1.0 + nrm((DEPTH, HEAD_DIM), 0.02),
        "attn_out_g": 1.0 + nrm((DEPTH, D_ATTN), 0.02),
        "w_out": nrm((DEPTH, D_MIX, D_MODEL), D_MIX ** -0.5),
        "peer_wq": nrm((DEPTH, D_MODEL, PEER_HEADS * PEER_DKEY), D_MODEL ** -0.5),
        "peer_sub_keys": nrm((DEPTH, 2, N_KEYS, PEER_DKEY // 2), (PEER_DKEY // 2) ** -0.5),
        "peer_u": nrm((DEPTH, N_EXPERTS, D_MODEL), D_MODEL ** -0.5),
        "peer_v": nrm((DEPTH, N_EXPERTS, D_MODEL), PEER_HEADS ** -0.5),
    }


def reference(x_prompt, x_sample, c_prompt, c_sample, ada_w, ada_b, norm1_g, norm2_g, w_in, mu_shift, w0, w2, a0, a2,
              g2, k_k, k_a, r_k, ln_x_w, ln_x_b, q_norm_g, k_norm_g, attn_out_g, w_out, peer_wq, peer_sub_keys,
              peer_u, peer_v):
    y_p, y_s = x_prompt, x_sample
    for l in range(DEPTH):
        params_l = (ada_w[l], ada_b[l], norm1_g[l], norm2_g[l], w_in[l], mu_shift[l], w0[l], w2[l], a0[l], a2[l],
                    g2[l], k_k[l], k_a[l], r_k[l], ln_x_w[l], ln_x_b[l], q_norm_g[l], k_norm_g[l], attn_out_g[l],
                    w_out[l], peer_wq[l], peer_sub_keys[l], peer_u[l], peer_v[l])
        y_p = encoder_layer(y_p, c_prompt, *params_l)
        y_s = encoder_layer(y_s, c_sample, *params_l)
    return (y_p, y_s)
```

```cpp
#include <hip/hip_runtime.h>
#include <hip/hip_cooperative_groups.h>
#include <stdint.h>
#include <stdio.h>
namespace cg = cooperative_groups;

typedef unsigned short bf16_t;
typedef short bf16x8 __attribute__((ext_vector_type(8)));
#define LAS __attribute__((address_space(3)))
typedef int i32x4 __attribute__((ext_vector_type(4)));
typedef int i32x8 __attribute__((ext_vector_type(8)));
typedef float f32x4 __attribute__((ext_vector_type(4)));
typedef unsigned u32x4 __attribute__((ext_vector_type(4)));
typedef unsigned u32x2 __attribute__((ext_vector_type(2)));
typedef float f32x16 __attribute__((ext_vector_type(16)));

#define NTOK 32768
#define DM 1024
#define DIN 2688
#define NTHR 256

struct P {
  const float *x_prompt, *x_sample, *c_prompt, *c_sample, *ada_w, *ada_b, *norm1_g, *norm2_g, *w_in, *mu, *w0, *w2, *a0, *a2, *g2,
      *k_k, *k_a, *r_k, *ln_w, *ln_b, *qn_g, *kn_g, *ao_g, *w_out, *wq, *subk, *u_tab, *v_tab;
  float* out;
  bf16_t *w_inT, *w_outT, *wqT;
  float *mod, *cd;
  bf16_t *proj, *h2, *h, *yd, *ut, *vt, *qp;
  int* eidx;
  float* gate;
  int* ctr;
  bf16_t *Kc, *Vt, *w2f, *a2f, *skb;
  unsigned char *Q8, *K8, *V8t;
  int* topl;
  unsigned* bar;
  bf16_t *ps_rk, *ps_vwa, *g2T;
  float* rope;
  unsigned char *ut8, *vt8, *h8, *hq8, *w_in8, *wq8, *ut4;
  float *hs1, *hstep, *w_in_s, *wq_s;
  unsigned* sflag;
  char* ring;
  long long never;
  float *ustep, *vstep;
};

__device__ __forceinline__ bf16_t f2bf(float f) {
  uint32_t u = __float_as_uint(f);
  u += 0x7fffu + ((u >> 16) & 1u);
  return (bf16_t)(u >> 16);
}
__device__ __forceinline__ float bf2f(bf16_t b) { return __uint_as_float(((uint32_t)b) << 16); }
__device__ __forceinline__ float bflo(uint32_t w) { return __uint_as_float(w << 16); }
__device__ __forceinline__ float bfhi(uint32_t w) { return __uint_as_float(w & 0xffff0000u); }
__device__ __forceinline__ uint32_t pack2(float lo, float hi) { typedef float f2_ __attribute__((ext_vector_type(2))); typedef __bf16 b2_ __attribute__((ext_vector_type(2))); f2_ v = {lo, hi}; return __builtin_bit_cast(uint32_t, __builtin_convertvector(v, b2_)); }
typedef float f32x2 __attribute__((ext_vector_type(2)));
typedef __bf16 bf16x2n __attribute__((ext_vector_type(2)));
__device__ __forceinline__ uint32_t cvtpk(float lo, float hi) { f32x2 v = {lo, hi}; return __builtin_bit_cast(uint32_t, __builtin_convertvector(v, bf16x2n)); }
__device__ __forceinline__ float dot2bf(uint32_t a, uint32_t b_, float c) {
  return __builtin_amdgcn_fdot2_f32_bf16(__builtin_bit_cast(bf16x2n, a), __builtin_bit_cast(bf16x2n, b_), c, false);
}
__device__ __forceinline__ float sigmoidf_(float x) { return 1.f / (1.f + __expf(-x)); }
__device__ __forceinline__ float wave_sum(float v) {
#pragma unroll
  for (int o = 32; o >= 1; o >>= 1) v += __shfl_xor(v, o);
  return v;
}
__device__ __forceinline__ void tok_info(int m, int& bb, int& t, int& T) {
  if (m < 16384) { bb = m >> 12; t = m & 4095; T = 4096; }
  else { int mm = m - 16384; bb = 4 + (mm >> 13); t = mm & 8191; T = 8192; }
}
__device__ __forceinline__ float shifted(const bf16_t* proj, const float* mu, int m, int t, int T, int col) {
  float mu_ = mu[col];
  float c = bf2f(proj[(size_t)m * DIN + col]);
  float pv = t > 0 ? bf2f(proj[(size_t)(m - 1) * DIN + col]) : 0.f;
  float nx = t < T - 1 ? bf2f(proj[(size_t)(m + 1) * DIN + col]) : 0.f;
  return c + mu_ * (0.5f * (pv + nx) - c);
}

__device__ void phase_mod(const P& p, float* smem) {
  float* sc = smem;
  float* red = smem + 6144;
  const int tid = threadIdx.x;
  if (blockIdx.x >= 384) return;
  for (int i = tid; i < 6 * 1024; i += NTHR) {
    int bb = i >> 10, k = i & 1023;
    float c = bb < 4 ? p.c_prompt[bb * 1024 + k] : p.c_sample[(bb - 4) * 1024 + k];
    sc[i] = c / (1.f + __expf(-c));
  }
  __syncthreads();
  const int c = tid & 15, kg = tid >> 4;
  const int col = blockIdx.x * 16 + c;
  float a0 = 0, a1 = 0, a2 = 0, a3 = 0, a4 = 0, a5 = 0;
#pragma unroll 8
  for (int it = 0; it < 64; ++it) {
    const int k = it * 16 + kg;
    const float w = p.ada_w[(size_t)k * 6144 + col];
    a0 += sc[k] * w; a1 += sc[1024 + k] * w; a2 += sc[2048 + k] * w;
    a3 += sc[3072 + k] * w; a4 += sc[4096 + k] * w; a5 += sc[5120 + k] * w;
  }
  red[(kg * 6 + 0) * 16 + c] = a0; red[(kg * 6 + 1) * 16 + c] = a1; red[(kg * 6 + 2) * 16 + c] = a2;
  red[(kg * 6 + 3) * 16 + c] = a3; red[(kg * 6 + 4) * 16 + c] = a4; red[(kg * 6 + 5) * 16 + c] = a5;
  __syncthreads();
  if (tid < 96) {
    const int bb = tid >> 4, cc = tid & 15;
    float s_ = 0.f;
#pragma unroll
    for (int g = 0; g < 16; ++g) s_ += red[(g * 6 + bb) * 16 + cc];
    p.mod[bb * 6144 + blockIdx.x * 16 + cc] = s_ + p.ada_b[blockIdx.x * 16 + cc];
  }
  __syncthreads();
}

__device__ void phase_transpose(const float* in, bf16_t* out, int K, int N, float* smem) {
  int ntk = K / 64, ntn = N / 64;
  for (int tile = blockIdx.x; tile < ntk * ntn; tile += gridDim.x) {
    int k0 = (tile / ntn) * 64, n0 = (tile % ntn) * 64;
    int c = threadIdx.x & 63, r0 = threadIdx.x >> 6;
    __syncthreads();
    for (int r = r0; r < 64; r += 4) smem[r * 65 + c] = in[(size_t)(k0 + r) * N + n0 + c];
    __syncthreads();
    for (int r = r0; r < 64; r += 4) out[(size_t)(n0 + r) * K + k0 + c] = f2bf(smem[c * 65 + r]);
  }
  __syncthreads();
}

__device__ void phase_norm(const P& p, int which) {
  int wave = threadIdx.x >> 6, lane = threadIdx.x & 63;
  const float* g = which == 1 ? p.norm1_g : p.norm2_g;
  unsigned char* dst8 = which == 1 ? p.h8 : p.hq8;
  float* dsts = which == 1 ? p.hs1 : p.hstep;
  for (int m = blockIdx.x * 4 + wave; m < NTOK; m += gridDim.x * 4) {
    int bb, t, T; tok_info(m, bb, t, T);
    const float* src = which == 1 ? (m < 16384 ? p.x_prompt + (size_t)m * DM : p.x_sample + (size_t)(m - 16384) * DM) : p.out + (size_t)m * DM;
    const float* sc = p.mod + bb * 6144 + (which == 1 ? 1024 : 4096);
    const float* sh = p.mod + bb * 6144 + (which == 1 ? 0 : 3072);
    f32x4 v[4]; float ss = 0.f;
#pragma unroll
    for (int j = 0; j < 4; ++j) { v[j] = ((const f32x4*)src)[lane + 64 * j]; ss += v[j][0] * v[j][0] + v[j][1] * v[j][1] + v[j][2] * v[j][2] + v[j][3] * v[j][3]; }
    ss = wave_sum(ss);
    const float rs = rsqrtf(ss * (1.f / 1024.f) + 1e-6f);
    float am = 0.f;
#pragma unroll
    for (int j = 0; j < 4; ++j) {
      const int c = (lane + 64 * j) * 4;
      const f32x4 gg = *(const f32x4*)(g + c), s4 = *(const f32x4*)(sc + c), h4 = *(const f32x4*)(sh + c);
#pragma unroll
      for (int e = 0; e < 4; ++e) { v[j][e] = v[j][e] * rs * gg[e] * (1.f + s4[e]) + h4[e]; am = fmaxf(am, fabsf(v[j][e])); }
    }
    if (which == 2) {
#pragma unroll
      for (int j = 0; j < 4; ++j) { u32x2 o; o.x = cvtpk(v[j][0], v[j][1]); o.y = cvtpk(v[j][2], v[j][3]); *(u32x2*)(p.h2 + (size_t)m * DM + (lane + 64 * j) * 4) = o; }
    }
#pragma unroll
    for (int o = 32; o >= 1; o >>= 1) am = fmaxf(am, __shfl_xor(am, o));
    const float step = am > 0.f ? am * (1.f / 127.f) : 1.f, inv = 1.f / step;
#pragma unroll
    for (int j = 0; j < 4; ++j) {
      const int q0 = (int)rintf(v[j][0] * inv), q1 = (int)rintf(v[j][1] * inv), q2 = (int)rintf(v[j][2] * inv), q3 = (int)rintf(v[j][3] * inv);
      *(uint32_t*)(dst8 + (size_t)m * DM + (lane + 64 * j) * 4) = (uint32_t)(q0 & 0xff) | ((uint32_t)(q1 & 0xff) << 8) | ((uint32_t)(q2 & 0xff) << 16) | ((uint32_t)(q3 & 0xff) << 24);
    }
    if (lane == 0) dsts[m] = step;
  }
}

__device__ void phase_wq8(const float* w, int N, unsigned char* out8, float* scale, float* smem) {
  const int K = 1024;
  float* red = smem;
  float* sstep = smem + 256;
  int* tile = (int*)(smem + 320);
  const int tid = threadIdx.x, c = tid & 63, kq = tid >> 6;
  for (int blk = blockIdx.x; blk < N / 64; blk += gridDim.x) {
    const int n0 = blk * 64;
    float am = 0.f;
    for (int k = kq; k < K; k += 4) am = fmaxf(am, fabsf(w[(size_t)k * N + n0 + c]));
    __syncthreads();
    red[kq * 64 + c] = am;
    __syncthreads();
    if (tid < 64) {
      const float a4 = fmaxf(fmaxf(red[tid], red[64 + tid]), fmaxf(red[128 + tid], red[192 + tid]));
      const float st = a4 > 0.f ? a4 * (1.f / 127.f) : 1.f;
      sstep[tid] = st; scale[n0 + tid] = st;
    }
    __syncthreads();
    const float inv = 1.f / sstep[c];
    for (int k0 = 0; k0 < K; k0 += 64) {
#pragma unroll
      for (int i = 0; i < 16; ++i) { const int k = kq + 4 * i; tile[k * 65 + c] = (int)rintf(w[(size_t)(k0 + k) * N + n0 + c] * inv); }
      __syncthreads();
      {
        const int r = tid >> 2, part = tid & 3;
        u32x4 o;
#pragma unroll
        for (int wd = 0; wd < 4; ++wd) {
          const int kb = part * 16 + wd * 4;
          o[wd] = (uint32_t)(tile[kb * 65 + r] & 0xff) | ((uint32_t)(tile[(kb + 1) * 65 + r] & 0xff) << 8) | ((uint32_t)(tile[(kb + 2) * 65 + r] & 0xff) << 16) | ((uint32_t)(tile[(kb + 3) * 65 + r] & 0xff) << 24);
        }
        *(u32x4*)(out8 + (size_t)(n0 + r) * K + k0 + part * 16) = o;
      }
      __syncthreads();
    }
  }
}

#define GEMM_BUF_ELEMS (2 * 128 * 72)
#define QSCALE 0.18033688f
#define GM_STORE(BUF, RA, RB) { bf16_t* As_ = sm + (BUF) * GEMM_BUF_ELEMS; bf16_t* Bs_ = As_ + 128 * 72; \
    _Pragma("unroll") for (int j = 0; j < 4; ++j) { *(u32x4*)(As_ + (row0 + 32 * j) * 72 + kc8) = RA[j]; *(u32x4*)(Bs_ + (row0 + 32 * j) * 72 + kc8) = RB[j]; } }
template <bool AMAP>
__device__ __forceinline__ void gemm_mainloop(const bf16_t* __restrict__ A, const int lda, const bf16_t* __restrict__ Bt, const int m0, const int n0, bf16_t* sm, f32x4 (&acc)[4][4]) {
  constexpr int K = 1024, NK = K / 64;
  const int tid = threadIdx.x, lane = tid & 63, wave = tid >> 6, wr = wave >> 1, wc = wave & 1;
#pragma unroll
  for (int i = 0; i < 4; ++i)
#pragma unroll
    for (int j = 0; j < 4; ++j) acc[i][j] = (f32x4){0.f, 0.f, 0.f, 0.f};
  u32x4 ra0[4], rb0[4], ra1[4], rb1[4];
  const int row0 = tid >> 3, kc8 = (tid & 7) * 8;
  const __amdgpu_buffer_rsrc_t rsA = __builtin_amdgcn_make_buffer_rsrc((void*)(A + (size_t)m0 * lda), 0, 128 * lda * 2, 0x00020000);
  const __amdgpu_buffer_rsrc_t rsB = __builtin_amdgcn_make_buffer_rsrc((void*)(Bt + (size_t)n0 * K), 0, 128 * K * 2, 0x00020000);
  const unsigned voA = (unsigned)(row0 * lda + kc8) * 2u, voB = (unsigned)(row0 * K + kc8) * 2u;
#define GM_LOAD(KT, RA, RB) { const int k0_ = (KT) * 64; const int ka_ = AMAP ? (k0_ < 512 ? k0_ : k0_ + 1408) : k0_; \
    _Pragma("unroll") for (int j = 0; j < 4; ++j) { RA[j] = __builtin_amdgcn_raw_buffer_load_b128(rsA, voA, (unsigned)((32 * j * lda + ka_) * 2), 0); \
                                                    RB[j] = __builtin_amdgcn_raw_buffer_load_b128(rsB, voB, (unsigned)((32 * j * K + k0_) * 2), 0); } }
#define GM_MMA(BUF) { const bf16_t* As = sm + (BUF) * GEMM_BUF_ELEMS; const bf16_t* Bs = As + 128 * 72; \
    _Pragma("unroll") for (int ks = 0; ks < 2; ++ks) { bf16x8 af[4], bfr[4]; \
      _Pragma("unroll") for (int i = 0; i < 4; ++i) af[i] = *(const bf16x8*)(As + (wr * 64 + i * 16 + (lane & 15)) * 72 + ks * 32 + (lane >> 4) * 8); \
      _Pragma("unroll") for (int j = 0; j < 4; ++j) bfr[j] = *(const bf16x8*)(Bs + (wc * 64 + j * 16 + (lane & 15)) * 72 + ks * 32 + (lane >> 4) * 8); \
      _Pragma("unroll") for (int i = 0; i < 4; ++i) _Pragma("unroll") for (int j = 0; j < 4; ++j) acc[i][j] = __builtin_amdgcn_mfma_f32_16x16x32_bf16(bfr[j], af[i], acc[i][j], 0, 0, 0); } }
  GM_LOAD(0, ra0, rb0);
  GM_LOAD(1, ra1, rb1);
  GM_STORE(0, ra0, rb0);
  GM_LOAD(2, ra0, rb0);
  __syncthreads();
  for (int kt = 0; kt < NK; kt += 2) {
    GM_STORE(1, ra1, rb1);
    if (kt + 3 < NK) GM_LOAD(kt + 3, ra1, rb1);
    __builtin_amdgcn_sched_barrier(0);
    GM_MMA(0);
    __syncthreads();
    if (kt + 2 < NK) GM_STORE(0, ra0, rb0);
    if (kt + 4 < NK) GM_LOAD(kt + 4, ra0, rb0);
    __builtin_amdgcn_sched_barrier(0);
    GM_MMA(1);
    __syncthreads();
  }
}

#define SGB_(mask, n) __builtin_amdgcn_sched_group_barrier(mask, n, 0)
template <bool AMAP>
__device__ __forceinline__ void gemm_mainloop_p(const bf16_t* __restrict__ A, const int lda, const bf16_t* __restrict__ Bt, const int m0, const int n0, bf16_t* sm, f32x4 (&acc)[4][4]) {
  constexpr int K = 1024, NK = K / 64;
  const int tid = threadIdx.x, lane = tid & 63, wave = tid >> 6, wr = wave >> 1, wc = wave & 1;
#pragma unroll
  for (int i = 0; i < 4; ++i)
#pragma unroll
    for (int j = 0; j < 4; ++j) acc[i][j] = (f32x4){0.f, 0.f, 0.f, 0.f};
  u32x4 ra0[4], rb0[4], ra1[4], rb1[4];
  const int row0 = tid >> 3, kc8 = (tid & 7) * 8;
  const __amdgpu_buffer_rsrc_t rsA = __builtin_amdgcn_make_buffer_rsrc((void*)(A + (size_t)m0 * lda), 0, 128 * lda * 2, 0x00020000);
  const __amdgpu_buffer_rsrc_t rsB = __builtin_amdgcn_make_buffer_rsrc((void*)(Bt + (size_t)n0 * K), 0, 128 * K * 2, 0x00020000);
  const unsigned voA = (unsigned)(row0 * lda + kc8) * 2u, voB = (unsigned)(row0 * K + kc8) * 2u;
  const int aoff = (wr * 64 + (lane & 15)) * 72 + (lane >> 4) * 8, boff = (wc * 64 + (lane & 15)) * 72 + (lane >> 4) * 8;
#define GP_LOAD(KT, RA, RB) { const int kt_ = (KT) < NK ? (KT) : NK - 1; const int k0_ = kt_ * 64; const int ka_ = AMAP ? (k0_ < 512 ? k0_ : k0_ + 1408) : k0_; \
    _Pragma("unroll") for (int j = 0; j < 4; ++j) { RA[j] = __builtin_amdgcn_raw_buffer_load_b128(rsA, voA, (unsigned)((32 * j * lda + ka_) * 2), 0); \
                                                    RB[j] = __builtin_amdgcn_raw_buffer_load_b128(rsB, voB, (unsigned)((32 * j * K + k0_) * 2), 0); } }
#define GP_STORE(BUF, RA, RB) { bf16_t* As_ = sm + (BUF) * GEMM_BUF_ELEMS; bf16_t* Bs_ = As_ + 128 * 72; \
    _Pragma("unroll") for (int j = 0; j < 4; ++j) { *(u32x4*)(As_ + (row0 + 32 * j) * 72 + kc8) = RA[j]; *(u32x4*)(Bs_ + (row0 + 32 * j) * 72 + kc8) = RB[j]; } }
#define GP_READ(BUF, KS, AF, BF) { const bf16_t* As_ = sm + (BUF) * GEMM_BUF_ELEMS + (KS) * 32; const bf16_t* Bs_ = As_ + 128 * 72; \
    _Pragma("unroll") for (int i = 0; i < 4; ++i) { AF[i] = *(const bf16x8*)(As_ + aoff + i * 16 * 72); BF[i] = *(const bf16x8*)(Bs_ + boff + i * 16 * 72); } }
#define GP_MMA(AF, BF) { _Pragma("unroll") for (int i = 0; i < 4; ++i) _Pragma("unroll") for (int j = 0; j < 4; ++j) acc[i][j] = __builtin_amdgcn_mfma_f32_16x16x32_bf16(BF[j], AF[i], acc[i][j], 0, 0, 0); }
#define GP_HALF1(BUF, RA, RB) { GP_MMA(a0, b0); GP_READ(BUF, 1, a1, b1); GP_STORE((BUF) ^ 1, RA, RB); \
    _Pragma("unroll") for (int q_ = 0; q_ < 8; ++q_) { SGB_(0x008, 2); SGB_(0x100, 1); SGB_(0x200, 1); } \
    __builtin_amdgcn_sched_barrier(0); __syncthreads(); __builtin_amdgcn_sched_barrier(0); }
#define GP_HALF2(BUF, KT3, RA, RB) { GP_MMA(a1, b1); GP_LOAD(KT3, RA, RB); GP_READ((BUF) ^ 1, 0, a0, b0); \
    _Pragma("unroll") for (int q_ = 0; q_ < 8; ++q_) { SGB_(0x008, 2); SGB_(0x020, 1); SGB_(0x100, 1); } \
    __builtin_amdgcn_sched_barrier(0); }
  bf16x8 a0[4], b0[4], a1[4], b1[4];
  GP_LOAD(0, ra0, rb0);
  GP_LOAD(1, ra1, rb1);
  GP_STORE(0, ra0, rb0);
  GP_LOAD(2, ra0, rb0);
  __syncthreads();
  GP_READ(0, 0, a0, b0);
  __builtin_amdgcn_sched_barrier(0);
  for (int kt = 0; kt < NK; kt += 2) {
    GP_HALF1(0, ra1, rb1);
    GP_HALF2(0, kt + 3, ra1, rb1);
    GP_HALF1(1, ra0, rb0);
    GP_HALF2(1, kt + 4, ra0, rb0);
  }
  __syncthreads();
}

#ifndef DRYCFG
#define DRYCFG 14
#endif
__device__ __forceinline__ void gemm_mainloop_dry(const bf16_t* __restrict__ A, const int lda, const bf16_t* __restrict__ Bt, const int m0, const int n0, bf16_t* sm, f32x4 (&acc)[4][4]) {
  constexpr int K = 1024, NK = K / 64;
  const int tid = threadIdx.x, lane = tid & 63, wave = tid >> 6, wr = wave >> 1, wc = wave & 1;
#pragma unroll
  for (int i = 0; i < 4; ++i)
#pragma unroll
    for (int j = 0; j < 4; ++j) acc[i][j] = (f32x4){0.f, 0.f, 0.f, 0.f};
  u32x4 ra[4], rb[4];
  const int row0 = tid >> 3, kc8 = (tid & 7) * 8;
  const bf16_t* Ap = A + (size_t)(m0 + row0) * lda + kc8;
  const bf16_t* Bp = Bt + (size_t)(n0 + row0) * K + kc8;
#pragma unroll
  for (int j = 0; j < 4; ++j) { ra[j] = *(const u32x4*)(Ap + (size_t)(32 * j) * lda); rb[j] = *(const u32x4*)(Bp + (size_t)(32 * j) * K); }
  bf16x8 af[4], bfr[4];
#pragma unroll
  for (int i = 0; i < 4; ++i) { af[i] = __builtin_bit_cast(bf16x8, ra[i]); bfr[i] = __builtin_bit_cast(bf16x8, rb[i]); }
  for (int kt = 0; kt < NK; ++kt) {
    const int buf = kt & 1;
    if (DRYCFG & 2) { bf16_t* As_ = sm + (buf ^ 1) * GEMM_BUF_ELEMS; bf16_t* Bs_ = As_ + 128 * 72;
      _Pragma("unroll") for (int j = 0; j < 4; ++j) { *(u32x4*)(As_ + (row0 + 32 * j) * 72 + kc8) = ra[j]; *(u32x4*)(Bs_ + (row0 + 32 * j) * 72 + kc8) = rb[j]; } }
    if (DRYCFG & 1) { const int k0_ = ((kt + 2) & 15) * 64;
      _Pragma("unroll") for (int j = 0; j < 4; ++j) { ra[j] = *(const u32x4*)(Ap + (size_t)(32 * j) * lda + k0_); rb[j] = *(const u32x4*)(Bp + (size_t)(32 * j) * K + k0_); } }
    __builtin_amdgcn_sched_barrier(0);
    const bf16_t* As = sm + buf * GEMM_BUF_ELEMS;
    const bf16_t* Bs = As + 128 * 72;
#pragma unroll
    for (int ks = 0; ks < 2; ++ks) {
      if (DRYCFG & 4) {
#pragma unroll
        for (int i = 0; i < 4; ++i) af[i] = *(const bf16x8*)(As + (wr * 64 + i * 16 + (lane & 15)) * 72 + ks * 32 + (lane >> 4) * 8);
#pragma unroll
        for (int j = 0; j < 4; ++j) bfr[j] = *(const bf16x8*)(Bs + (wc * 64 + j * 16 + (lane & 15)) * 72 + ks * 32 + (lane >> 4) * 8);
      }
#pragma unroll
      for (int i = 0; i < 4; ++i)
#pragma unroll
        for (int j = 0; j < 4; ++j) acc[i][j] = __builtin_amdgcn_mfma_f32_16x16x32_bf16(bfr[j], af[i], acc[i][j], 0, 0, 0);
    }
    if (DRYCFG & 8) __syncthreads(); else __builtin_amdgcn_sched_barrier(0);
  }
  if (!(DRYCFG & 1)) { float t_ = 0.f; _Pragma("unroll") for (int j = 0; j < 4; ++j) t_ += __uint_as_float(ra[j].x ^ rb[j].y); acc[0][0][0] += t_ * 0.f; }
}

#define GG_BUF_BYTES 32768
template <bool I8, bool AMAP, typename ACC>
__device__ __forceinline__ void gemm_mainloop_g(const char* __restrict__ A, const int ldab, const char* __restrict__ Bt, const int m0, const int n0, char* sm, ACC (&acc)[4][4]) {
  constexpr int NK = I8 ? 8 : 16, ldbb = I8 ? 1024 : 2048;
  const int tid = threadIdx.x, lane = tid & 63, wave = tid >> 6, wr = wave >> 1, wc = wave & 1;
#pragma unroll
  for (int i = 0; i < 4; ++i)
#pragma unroll
    for (int j = 0; j < 4; ++j) { acc[i][j][0] = 0; acc[i][j][1] = 0; acc[i][j][2] = 0; acc[i][j][3] = 0; }
  const int srow = wave * 8 + (lane >> 3), sch = (lane & 7) ^ (4 * (wave & 1) + (lane >> 4));
  const char* Ag = A + (size_t)(m0 + srow) * ldab + sch * 16;
  const char* Bg = Bt + (size_t)(n0 + srow) * ldbb + sch * 16;
  const int fr = lane & 15, fq = lane >> 4;
  const int aoff0 = (wr * 64 + fr) * 128 + ((fq ^ (fr >> 1)) * 16), boff0 = (wc * 64 + fr) * 128 + ((fq ^ (fr >> 1)) * 16);
#define GG_STAGE(BUF, KT) { const int k0_ = (KT) * 128; const int ka_ = AMAP ? (k0_ < 1024 ? k0_ : k0_ + 2816) : k0_; \
    const unsigned lb_ = __builtin_amdgcn_readfirstlane(lds0 + (unsigned)((BUF) * GG_BUF_BYTES)); \
    _Pragma("unroll") for (int i = 0; i < 4; ++i) { \
      asm volatile("s_mov_b32 m0, %1\n\ts_nop 0\n\tglobal_load_lds_dwordx4 %0, off" :: "v"(Ag + (size_t)(32 * i) * ldab + ka_), "s"(lb_ + (unsigned)(i * 4096)) : "memory", "m0"); \
      asm volatile("s_mov_b32 m0, %1\n\ts_nop 0\n\tglobal_load_lds_dwordx4 %0, off" :: "v"(Bg + (size_t)(32 * i) * ldbb + k0_), "s"(lb_ + (unsigned)(16384 + i * 4096)) : "memory", "m0"); } }
  const unsigned lds0 = (unsigned)(size_t)(LAS char*)sm + (unsigned)(wave * 1024);
  GG_STAGE(0, 0);
  asm volatile("s_waitcnt vmcnt(0)" ::: "memory");
  __syncthreads();
  for (int kt = 0; kt < NK; ++kt) {
    const int buf = kt & 1;
    if (kt + 1 < NK) GG_STAGE(buf ^ 1, kt + 1);
    const char* As = sm + buf * GG_BUF_BYTES;
    const char* Bs = As + 16384;
#pragma unroll
    for (int ks = 0; ks < 2; ++ks) {
      u32x4 af[4], bfr[4];
#pragma unroll
      for (int i = 0; i < 4; ++i) af[i] = *(const u32x4*)(As + ((aoff0 + i * 2048) ^ (ks * 64)));
#pragma unroll
      for (int j = 0; j < 4; ++j) bfr[j] = *(const u32x4*)(Bs + ((boff0 + j * 2048) ^ (ks * 64)));
#pragma unroll
      for (int i = 0; i < 4; ++i)
#pragma unroll
        for (int j = 0; j < 4; ++j) {
          if constexpr (I8) acc[i][j] = __builtin_amdgcn_mfma_i32_16x16x64_i8(__builtin_bit_cast(i32x4, bfr[j]), __builtin_bit_cast(i32x4, af[i]), acc[i][j], 0, 0, 0);
          else acc[i][j] = __builtin_amdgcn_mfma_f32_16x16x32_bf16(__builtin_bit_cast(bf16x8, bfr[j]), __builtin_bit_cast(bf16x8, af[i]), acc[i][j], 0, 0, 0);
        }
    }
    asm volatile("s_waitcnt vmcnt(0)" ::: "memory");
    __syncthreads();
  }
}

__device__ __forceinline__ void gemm_mainloop_s(const bf16_t* __restrict__ A, const int lda, const bf16_t* __restrict__ Bt, const int m0, const int n0, bf16_t* sm, f32x4 (&acc)[4][4]) {
  constexpr int K = 1024, NK = K / 64;
  const int tid = threadIdx.x, lane = tid & 63, wave = tid >> 6, wr = wave >> 1, wc = wave & 1;
#pragma unroll
  for (int i = 0; i < 4; ++i)
#pragma unroll
    for (int j = 0; j < 4; ++j) acc[i][j] = (f32x4){0.f, 0.f, 0.f, 0.f};
  u32x4 ra[4], rb[4];
  const int row0 = tid >> 3, kc8 = (tid & 7) * 8;
  const bf16_t* Ap = A + (size_t)(m0 + row0) * lda + kc8;
  const bf16_t* Bp = Bt + (size_t)(n0 + row0) * K + kc8;
#define GS_LOAD(KT) { const int k0_ = (KT) * 64; const int ka_ = k0_; \
    _Pragma("unroll") for (int j = 0; j < 4; ++j) { ra[j] = *(const u32x4*)(Ap + (size_t)(32 * j) * lda + ka_); rb[j] = *(const u32x4*)(Bp + (size_t)(32 * j) * K + k0_); } }
#define GS_STORE(BUF) { bf16_t* As_ = sm + (BUF) * GEMM_BUF_ELEMS; bf16_t* Bs_ = As_ + 128 * 72; \
    _Pragma("unroll") for (int j = 0; j < 4; ++j) { *(u32x4*)(As_ + (row0 + 32 * j) * 72 + kc8) = ra[j]; *(u32x4*)(Bs_ + (row0 + 32 * j) * 72 + kc8) = rb[j]; } }
  GS_LOAD(0);
  GS_STORE(0);
  GS_LOAD(1);
  __syncthreads();
  for (int kt = 0; kt < NK; ++kt) {
    const int buf = kt & 1;
    if (kt + 1 < NK) GS_STORE(buf ^ 1);
    if (kt + 2 < NK) GS_LOAD(kt + 2);
    __builtin_amdgcn_sched_barrier(0);
    const bf16_t* As = sm + buf * GEMM_BUF_ELEMS;
    const bf16_t* Bs = As + 128 * 72;
#pragma unroll
    for (int ks = 0; ks < 2; ++ks) {
      bf16x8 af[4], bfr[4];
#pragma unroll
      for (int i = 0; i < 4; ++i) af[i] = *(const bf16x8*)(As + (wr * 64 + i * 16 + (lane & 15)) * 72 + ks * 32 + (lane >> 4) * 8);
#pragma unroll
      for (int j = 0; j < 4; ++j) bfr[j] = *(const bf16x8*)(Bs + (wc * 64 + j * 16 + (lane & 15)) * 72 + ks * 32 + (lane >> 4) * 8);
#pragma unroll
      for (int i = 0; i < 4; ++i)
#pragma unroll
        for (int j = 0; j < 4; ++j) acc[i][j] = __builtin_amdgcn_mfma_f32_16x16x32_bf16(bfr[j], af[i], acc[i][j], 0, 0, 0);
    }
    __syncthreads();
  }
}

__device__ __forceinline__ void gemm_mainloop_i8(const unsigned char* __restrict__ A8, const unsigned char* __restrict__ B8, const int m0, const int n0, bf16_t* sm, i32x4 (&acc)[4][4]) {
  constexpr int KB = 1024, NK = KB / 128;
  const int tid = threadIdx.x, lane = tid & 63, wave = tid >> 6, wr = wave >> 1, wc = wave & 1;
#pragma unroll
  for (int i = 0; i < 4; ++i)
#pragma unroll
    for (int j = 0; j < 4; ++j) acc[i][j] = (i32x4){0, 0, 0, 0};
  u32x4 ra0[4], rb0[4], ra1[4], rb1[4];
  const int row0 = tid >> 3, kc8 = (tid & 7) * 8;
  const __amdgpu_buffer_rsrc_t rsA = __builtin_amdgcn_make_buffer_rsrc((void*)(A8 + (size_t)m0 * KB), 0, 128 * KB, 0x00020000);
  const __amdgpu_buffer_rsrc_t rsB = __builtin_amdgcn_make_buffer_rsrc((void*)(B8 + (size_t)n0 * KB), 0, 128 * KB, 0x00020000);
  const unsigned vo8 = (unsigned)(row0 * KB + kc8 * 2);
#define G8_LOAD(KT, RA, RB) { _Pragma("unroll") for (int j = 0; j < 4; ++j) { RA[j] = __builtin_amdgcn_raw_buffer_load_b128(rsA, vo8, (unsigned)(32 * j * KB + (KT) * 128), 0); \
                                                                              RB[j] = __builtin_amdgcn_raw_buffer_load_b128(rsB, vo8, (unsigned)(32 * j * KB + (KT) * 128), 0); } }
#define G8_MMA(BUF) { const bf16_t* As = sm + (BUF) * GEMM_BUF_ELEMS; const bf16_t* Bs = As + 128 * 72; \
    _Pragma("unroll") for (int ks = 0; ks < 2; ++ks) { i32x4 af[4], bfr[4]; \
      _Pragma("unroll") for (int i = 0; i < 4; ++i) af[i] = *(const i32x4*)(As + (wr * 64 + i * 16 + (lane & 15)) * 72 + ks * 32 + (lane >> 4) * 8); \
      _Pragma("unroll") for (int j = 0; j < 4; ++j) bfr[j] = *(const i32x4*)(Bs + (wc * 64 + j * 16 + (lane & 15)) * 72 + ks * 32 + (lane >> 4) * 8); \
      _Pragma("unroll") for (int i = 0; i < 4; ++i) _Pragma("unroll") for (int j = 0; j < 4; ++j) acc[i][j] = __builtin_amdgcn_mfma_i32_16x16x64_i8(bfr[j], af[i], acc[i][j], 0, 0, 0); } }
  G8_LOAD(0, ra0, rb0);
  G8_LOAD(1, ra1, rb1);
  GM_STORE(0, ra0, rb0);
  G8_LOAD(2, ra0, rb0);
  __syncthreads();
  for (int kt = 0; kt < NK; kt += 2) {
    GM_STORE(1, ra1, rb1);
    if (kt + 3 < NK) G8_LOAD(kt + 3, ra1, rb1);
    __builtin_amdgcn_sched_barrier(0);
    G8_MMA(0);
    __syncthreads();
    if (kt + 2 < NK) GM_STORE(0, ra0, rb0);
    if (kt + 4 < NK) G8_LOAD(kt + 4, ra0, rb0);
    __builtin_amdgcn_sched_barrier(0);
    G8_MMA(1);
    __syncthreads();
  }
}

template <int MODE>
__device__ void phase_gemm(const P& p, char* smem, int mrow0, int Mrows) {
  constexpr int N = MODE == 0 ? 2688 : MODE == 1 ? 1024 : 2048;
  constexpr int lda = MODE == 1 ? DIN : 1024;
  const bf16_t* A = MODE == 0 ? p.h : MODE == 1 ? p.proj : p.h2;
  const bf16_t* Bt = MODE == 0 ? p.w_inT : MODE == 1 ? p.w_outT : p.wqT;
  const int tid = threadIdx.x, lane = tid & 63, wave = tid >> 6, wr = wave >> 1, wc = wave & 1;
  const int nN = N / 128, nM = Mrows / 128;
  const int grp = blockIdx.x & 7, gidx = blockIdx.x >> 3, gsz = gridDim.x >> 3;
  const bool xcd_order = (gridDim.x & 7) == 0 && (nM & 7) == 0;
  const int ntl = xcd_order ? (nM >> 3) * nN : nM * nN;
  for (int u = xcd_order ? gidx : (int)blockIdx.x; u < ntl; u += xcd_order ? gsz : (int)gridDim.x) {
    const int tm = xcd_order ? (u / nN) * 8 + grp : u / nN, tn = u % nN;
    const int m0 = mrow0 + tm * 128, n0 = tn * 128;
    f32x4 acc[4][4];
    if (MODE == 0) {
      i32x4 ai[4][4];
      gemm_mainloop_g<true, false>((const char*)p.h8, 1024, (const char*)p.w_in8, m0, n0, smem, ai);
#pragma unroll
      for (int i = 0; i < 4; ++i) {
        const float sa = p.hs1[m0 + wr * 64 + i * 16 + (lane & 15)];
#pragma unroll
        for (int j = 0; j < 4; ++j) {
          const f32x4 sb = *(const f32x4*)(p.w_in_s + n0 + wc * 64 + j * 16 + (lane >> 4) * 4);
          acc[i][j][0] = (float)ai[i][j][0] * sa * sb[0]; acc[i][j][1] = (float)ai[i][j][1] * sa * sb[1];
          acc[i][j][2] = (float)ai[i][j][2] * sa * sb[2]; acc[i][j][3] = (float)ai[i][j][3] * sa * sb[3];
        }
      }
    } else gemm_mainloop_g<false, MODE == 1>((const char*)A, lda * 2, (const char*)Bt, m0, n0, smem, acc);
    int bb, t_, T_; tok_info(m0, bb, t_, T_);
    if (MODE == 0) {
      bf16_t* stg = (bf16_t*)smem;
#pragma unroll
      for (int i = 0; i < 4; ++i)
#pragma unroll
        for (int j = 0; j < 4; ++j) {
          const f32x4 a = acc[i][j];
          u32x2 o; o.x = pack2(a[0], a[1]); o.y = pack2(a[2], a[3]);
          *(u32x2*)(stg + (wr * 64 + i * 16 + (lane & 15)) * 136 + wc * 64 + j * 16 + (lane >> 4) * 4) = o;
        }
      __syncthreads();
      if (tn >= 15 && tn < 20) {
        const int row = tid >> 1, hh = tid & 1;
        int b2, t, T2; tok_info(m0 + row, b2, t, T2);
        bf16_t* sp = stg + row * 136 + hh * 64;
        float ss = 0.f;
#pragma unroll
        for (int k = 0; k < 8; ++k) {
          const u32x4 w = *(const u32x4*)(sp + k * 8);
          ss += bflo(w.x) * bflo(w.x) + bfhi(w.x) * bfhi(w.x) + bflo(w.y) * bflo(w.y) + bfhi(w.y) * bfhi(w.y)
              + bflo(w.z) * bflo(w.z) + bfhi(w.z) * bfhi(w.z) + bflo(w.w) * bflo(w.w) + bfhi(w.w) * bfhi(w.w);
        }
        const float rs = rsqrtf(ss * (1.f / 64.f) + 1e-6f) * (tn < 19 ? QSCALE : 1.f);
        const float* g = tn < 19 ? p.qn_g : p.kn_g;
#pragma unroll
        for (int hf = 0; hf < 2; ++hf) {
          const float* rp = p.rope + (hf == 0 ? (t >> 6) : (t & 63)) * 32;
          float x[32];
#pragma unroll
          for (int k = 0; k < 4; ++k) {
            const u32x4 w = *(const u32x4*)(sp + hf * 32 + k * 8);
            x[8 * k + 0] = bflo(w.x); x[8 * k + 1] = bfhi(w.x); x[8 * k + 2] = bflo(w.y); x[8 * k + 3] = bfhi(w.y);
            x[8 * k + 4] = bflo(w.z); x[8 * k + 5] = bfhi(w.z); x[8 * k + 6] = bflo(w.w); x[8 * k + 7] = bfhi(w.w);
          }
#pragma unroll
          for (int j = 0; j < 16; ++j) {
            const f32x2 rr = *(const f32x2*)(rp + 2 * j);
            const float y0 = x[j] * rs * g[hf * 32 + j], y1 = x[j + 16] * rs * g[hf * 32 + j + 16];
            x[j] = y0 * rr.x - y1 * rr.y; x[j + 16] = y0 * rr.y + y1 * rr.x;
          }
#pragma unroll
          for (int k = 0; k < 4; ++k) {
            u32x4 w; w.x = cvtpk(x[8 * k], x[8 * k + 1]); w.y = cvtpk(x[8 * k + 2], x[8 * k + 3]); w.z = cvtpk(x[8 * k + 4], x[8 * k + 5]); w.w = cvtpk(x[8 * k + 6], x[8 * k + 7]);
            *(u32x4*)(sp + hf * 32 + k * 8) = w;
          }
          {
            const float f8s = tn < 19 ? 8.f : 1.f;
            unsigned char* d8 = tn < 19 ? p.Q8 + ((size_t)(m0 + row) * 8 + (tn - 15) * 2 + hh) * 64 + hf * 32 : p.K8 + ((size_t)hh * NTOK + m0 + row) * 64 + hf * 32;
            u32x4 wa, wb;
#define F8PK(A, B, C, D) (uint32_t)__builtin_amdgcn_cvt_pk_fp8_f32((C) * f8s, (D) * f8s, __builtin_amdgcn_cvt_pk_fp8_f32((A) * f8s, (B) * f8s, 0, false), true)
            wa.x = F8PK(x[0], x[1], x[2], x[3]); wa.y = F8PK(x[4], x[5], x[6], x[7]); wa.z = F8PK(x[8], x[9], x[10], x[11]); wa.w = F8PK(x[12], x[13], x[14], x[15]);
            wb.x = F8PK(x[16], x[17], x[18], x[19]); wb.y = F8PK(x[20], x[21], x[22], x[23]); wb.z = F8PK(x[24], x[25], x[26], x[27]); wb.w = F8PK(x[28], x[29], x[30], x[31]);
            *(u32x4*)d8 = wa; *(u32x4*)(d8 + 16) = wb;
          }
          __builtin_amdgcn_sched_barrier(0);
        }
        __syncthreads();
      }
      if (tn < 14) {
        const int ch = tid & 15, col = n0 + ch * 8;
        const f32x4 mA = *(const f32x4*)(p.mu + col), mB = *(const f32x4*)(p.mu + col + 4);
#pragma unroll
        for (int k = 0; k < 8; ++k) {
          const int row = (tid >> 4) + 16 * k;
          const u32x4 c = *(const u32x4*)(stg + row * 136 + ch * 8);
          if (row < 2 || row > 125) *(u32x4*)(p.proj + (size_t)(m0 + row) * DIN + col) = c;
          if (row > 0 && row < 127) {
            const u32x4 pv = *(const u32x4*)(stg + (row - 1) * 136 + ch * 8), nx = *(const u32x4*)(stg + (row + 1) * 136 + ch * 8);
            float o[8];
#pragma unroll
            for (int w = 0; w < 4; ++w) {
              const float c0 = bflo(c[w]), c1 = bfhi(c[w]);
              const float mu0 = w < 2 ? mA[2 * w] : mB[2 * w - 4], mu1 = w < 2 ? mA[2 * w + 1] : mB[2 * w - 3];
              o[2 * w] = c0 + mu0 * (0.5f * (bflo(pv[w]) + bflo(nx[w])) - c0);
              o[2 * w + 1] = c1 + mu1 * (0.5f * (bfhi(pv[w]) + bfhi(nx[w])) - c1);
            }
            if (tn == 12) {
#pragma unroll
              for (int e = 0; e < 8; ++e) { const float ex = __expf(2.f * o[e]); o[e] = 1.f - 2.f / (ex + 1.f); }
            }
            u32x4 r; r.x = cvtpk(o[0], o[1]); r.y = cvtpk(o[2], o[3]); r.z = cvtpk(o[4], o[5]); r.w = cvtpk(o[6], o[7]);
            if (tn < 8) *(u32x4*)(p.ps_rk + (size_t)(m0 + row) * 1024 + col) = r;
            else *(u32x4*)(p.ps_vwa + (size_t)(m0 + row) * 768 + (col - 1024)) = r;
          }
        }
      } else if (tn < 19) {
#pragma unroll
        for (int k = 0; k < 8; ++k) {
          const int c = tid + 256 * k, row = c >> 4, ch = c & 15;
          *(u32x4*)(p.proj + (size_t)(m0 + row) * DIN + n0 + ch * 8) = *(const u32x4*)(stg + row * 136 + ch * 8);
        }
      } else if (tn == 19) {
#pragma unroll
        for (int k = 0; k < 8; ++k) {
          const int c = tid + 256 * k, row = c >> 4, ch = c & 15;
          *(u32x4*)(p.Kc + ((size_t)(ch >> 3) * NTOK + m0 + row) * 64 + (ch & 7) * 8) = *(const u32x4*)(stg + row * 136 + ch * 8);
        }
      } else {
        const int c = tid >> 1, hf = tid & 1;
        const bf16_t* col = stg + (hf * 64) * 136 + c;
        bf16_t* dst = p.Vt + (size_t)c * NTOK + m0 + hf * 64;
#pragma unroll
        for (int q4 = 0; q4 < 8; ++q4) {
          u32x4 w;
          w.x = (uint32_t)col[(q4 * 8 + 0) * 136] | ((uint32_t)col[(q4 * 8 + 1) * 136] << 16);
          w.y = (uint32_t)col[(q4 * 8 + 2) * 136] | ((uint32_t)col[(q4 * 8 + 3) * 136] << 16);
          w.z = (uint32_t)col[(q4 * 8 + 4) * 136] | ((uint32_t)col[(q4 * 8 + 5) * 136] << 16);
          w.w = (uint32_t)col[(q4 * 8 + 6) * 136] | ((uint32_t)col[(q4 * 8 + 7) * 136] << 16);
          *(u32x4*)(dst + q4 * 8) = w;
        }
        unsigned char* d8 = p.V8t + (size_t)c * NTOK + m0 + hf * 64;
#pragma unroll
        for (int g4 = 0; g4 < 4; ++g4) {
          u32x4 w8;
#pragma unroll
          for (int u = 0; u < 4; ++u) {
            const int dw = g4 * 4 + u, kb = 32 * ((dw >> 2) & 1) + 4 * (dw >> 3) + 8 * (dw & 3);
            const float f0 = bf2f(col[(kb + 0) * 136]), f1 = bf2f(col[(kb + 1) * 136]), f2 = bf2f(col[(kb + 2) * 136]), f3 = bf2f(col[(kb + 3) * 136]);
            w8[u] = (uint32_t)__builtin_amdgcn_cvt_pk_fp8_f32(f2, f3, __builtin_amdgcn_cvt_pk_fp8_f32(f0, f1, 0, false), true);
          }
          *(u32x4*)(d8 + g4 * 16) = w8;
        }
      }
      __syncthreads();
    } else if (MODE == 1) {
      float* stg = (float*)smem;
#pragma unroll
      for (int i = 0; i < 4; ++i)
#pragma unroll
        for (int j = 0; j < 4; ++j) *(f32x4*)(stg + (wr * 64 + i * 16 + (lane & 15)) * 132 + wc * 64 + j * 16 + (lane >> 4) * 4) = acc[i][j];
      __syncthreads();
#pragma unroll
      for (int k = 0; k < 16; ++k) {
        const int c = tid + 256 * k, row = c >> 5, ch = c & 31;
        const int m = m0 + row, n = n0 + ch * 4;
        const float* xs = m < 16384 ? p.x_prompt + (size_t)m * DM : p.x_sample + (size_t)(m - 16384) * DM;
        const f32x4 xv = *(const f32x4*)(xs + n), gt = *(const f32x4*)(p.mod + bb * 6144 + 2048 + n), a = *(const f32x4*)(stg + row * 132 + ch * 4);
        f32x4 o; o[0] = xv[0] + gt[0] * a[0]; o[1] = xv[1] + gt[1] * a[1]; o[2] = xv[2] + gt[2] * a[2]; o[3] = xv[3] + gt[3] * a[3];
        *(f32x4*)(p.out + (size_t)m * DM + n) = o;
      }
      __syncthreads();
    }
  }
  __syncthreads();
}

__device__ void phase_qkprep(const P& p, char* smem) {
  bf16_t* sT = (bf16_t*)smem;
  const int tid = threadIdx.x, wave = tid >> 6, lane = tid & 63;
  const int j = lane & 15;
  for (int tile = blockIdx.x; tile < NTOK / 64; tile += gridDim.x) {
    const int m0 = tile * 64;
    for (int batch = 0; batch < 10; ++batch) {
      float x[4][4]; int pm[4], ph[4];
#pragma unroll
      for (int u = 0; u < 4; ++u) {
        const int pi = ((batch * 4 + u) * 4 + wave) * 4 + (lane >> 4);
        const int tok = pi / 10; ph[u] = pi - tok * 10; pm[u] = m0 + tok;
        const bf16_t* ptr = p.proj + (size_t)pm[u] * DIN + 1920 + ph[u] * 64;
        x[u][0] = bf2f(ptr[j]); x[u][1] = bf2f(ptr[j + 16]); x[u][2] = bf2f(ptr[j + 32]); x[u][3] = bf2f(ptr[j + 48]);
      }
#pragma unroll
      for (int u = 0; u < 4; ++u) {
        const int m = pm[u], hc = ph[u];
        int bb, t, T; tok_info(m, bb, t, T);
        const f32x2 rr = *(const f32x2*)(p.rope + ((t >> 6) * 16 + j) * 2), rc = *(const f32x2*)(p.rope + ((t & 63) * 16 + j) * 2);
        const float* g = hc < 8 ? p.qn_g : p.kn_g;
        float ss = x[u][0] * x[u][0] + x[u][1] * x[u][1] + x[u][2] * x[u][2] + x[u][3] * x[u][3];
        ss += __shfl_xor(ss, 1); ss += __shfl_xor(ss, 2); ss += __shfl_xor(ss, 4); ss += __shfl_xor(ss, 8);
        const float rs = rsqrtf(ss * (1.f / 64.f) + 1e-6f) * (hc < 8 ? QSCALE : 1.f);
        const float y0 = x[u][0] * rs * g[j], y1 = x[u][1] * rs * g[j + 16], y2 = x[u][2] * rs * g[j + 32], y3 = x[u][3] * rs * g[j + 48];
        const float z0 = y0 * rr.x - y1 * rr.y, z1 = y0 * rr.y + y1 * rr.x;
        const float z2 = y2 * rc.x - y3 * rc.y, z3 = y2 * rc.y + y3 * rc.x;
        bf16_t* dst = hc < 8 ? p.proj + (size_t)m * DIN + 1920 + hc * 64 : p.Kc + ((size_t)(hc - 8) * NTOK + m) * 64;
        dst[j] = f2bf(z0); dst[j + 16] = f2bf(z1); dst[j + 32] = f2bf(z2); dst[j + 48] = f2bf(z3);
      }
    }
    __syncthreads();
    {
      const int tk = tid >> 2, part = tid & 3;
      const bf16_t* src = p.proj + (size_t)(m0 + tk) * DIN + 2560 + part * 32;
#pragma unroll
      for (int q4 = 0; q4 < 4; ++q4) {
        u32x4 w = *(const u32x4*)(src + q4 * 8);
        bf16_t* d_ = sT + (part * 32 + q4 * 8) * 66 + tk;
        d_[0 * 66] = (bf16_t)(w.x & 0xffff); d_[1 * 66] = (bf16_t)(w.x >> 16); d_[2 * 66] = (bf16_t)(w.y & 0xffff); d_[3 * 66] = (bf16_t)(w.y >> 16);
        d_[4 * 66] = (bf16_t)(w.z & 0xffff); d_[5 * 66] = (bf16_t)(w.z >> 16); d_[6 * 66] = (bf16_t)(w.w & 0xffff); d_[7 * 66] = (bf16_t)(w.w >> 16);
      }
    }
    __syncthreads();
    {
      const int c = tid >> 1, hf = tid & 1;
      const bf16_t* row = sT + c * 66 + hf * 32;
      bf16_t* dst = p.Vt + (size_t)c * NTOK + m0 + hf * 32;
#pragma unroll
      for (int q4 = 0; q4 < 4; ++q4) {
        u32x4 w;
        w.x = (uint32_t)row[q4 * 8 + 0] | ((uint32_t)row[q4 * 8 + 1] << 16);
        w.y = (uint32_t)row[q4 * 8 + 2] | ((uint32_t)row[q4 * 8 + 3] << 16);
        w.z = (uint32_t)row[q4 * 8 + 4] | ((uint32_t)row[q4 * 8 + 5] << 16);
        w.w = (uint32_t)row[q4 * 8 + 6] | ((uint32_t)row[q4 * 8 + 7] << 16);
        *(u32x4*)(dst + q4 * 8) = w;
      }
    }
    __syncthreads();
  }
}

__device__ void phase_shift(const P& p) {
  for (int idx = blockIdx.x * NTHR + threadIdx.x; idx < (NTOK / 64) * 224; idx += gridDim.x * NTHR) {
    const int mi = idx / 224, ch = idx - mi * 224, col = ch * 8, m = (mi >> 1) * 128 + (mi & 1) * 127;
    int bb, t, T; tok_info(m, bb, t, T);
    const bf16_t* q = p.proj + (size_t)m * DIN + col;
    const u32x4 c = *(const u32x4*)q;
    u32x4 pv = (u32x4){0u, 0u, 0u, 0u}, nx = (u32x4){0u, 0u, 0u, 0u};
    if (t > 0) pv = *(const u32x4*)(q - DIN);
    if (t < T - 1) nx = *(const u32x4*)(q + DIN);
    const f32x4 m0 = *(const f32x4*)(p.mu + col), m1 = *(const f32x4*)(p.mu + col + 4);
    float o[8];
#pragma unroll
    for (int w = 0; w < 4; ++w) {
      const float c0 = bflo(c[w]), c1 = bfhi(c[w]);
      const float mu0 = w < 2 ? m0[2 * w] : m1[2 * w - 4], mu1 = w < 2 ? m0[2 * w + 1] : m1[2 * w - 3];
      o[2 * w] = c0 + mu0 * (0.5f * (bflo(pv[w]) + bflo(nx[w])) - c0);
      o[2 * w + 1] = c1 + mu1 * (0.5f * (bfhi(pv[w]) + bfhi(nx[w])) - c1);
    }
    if (col >= 1536 && col < 1664) {
#pragma unroll
      for (int e = 0; e < 8; ++e) { const float ex = __expf(2.f * o[e]); o[e] = 1.f - 2.f / (ex + 1.f); }
    }
    u32x4 r; r.x = cvtpk(o[0], o[1]); r.y = cvtpk(o[2], o[3]); r.z = cvtpk(o[4], o[5]); r.w = cvtpk(o[6], o[7]);
    if (col < 1024) *(u32x4*)(p.ps_rk + (size_t)m * 1024 + col) = r;
    else *(u32x4*)(p.ps_vwa + (size_t)m * 768 + (col - 1024)) = r;
  }
}

__device__ void phase_lorafrag(const P& p) {
  for (int idx = blockIdx.x * NTHR + threadIdx.x; idx < 65536; idx += gridDim.x * NTHR) {
    int j = idx & 7, lane = (idx >> 3) & 63, ks = (idx >> 9) & 1, i = (idx >> 10) & 3, hh = (idx >> 12) & 7, d = idx >> 15;
    int l = 32 * ks + 8 * (lane >> 4) + j, n = hh * 64 + 16 * i + (lane & 15);
    p.w2f[idx] = f2bf(p.w2[(size_t)(d * 64 + l) * 512 + n]);
    p.a2f[idx] = f2bf(p.a2[(size_t)(d * 64 + l) * 512 + n]);
  }
}

#define SC_CHUNK_BYTES 13568
#define SC_AF 0
#define SC_RF 2048
#define SC_LAK 4096
#define SC_TM 5120
#define SC_MRK 6144
#define SC_VMF 7168
#define SC_BKF 9216
#define SC_GC 13312
#define SC_WAVE_BYTES 5376
__device__ __forceinline__ float dpp_shr1(float x) { return __int_as_float(__builtin_amdgcn_update_dpp(0, __float_as_int(x), 0x111, 0xf, 0xf, true)); }
__device__ __forceinline__ float dpp_shr2(float x) { return __int_as_float(__builtin_amdgcn_update_dpp(0, __float_as_int(x), 0x112, 0xf, 0xf, true)); }
__device__ __forceinline__ float dpp_shr4(float x) { return __int_as_float(__builtin_amdgcn_update_dpp(0, __float_as_int(x), 0x114, 0xf, 0xf, true)); }
__device__ __forceinline__ float dpp_shr8(float x) { return __int_as_float(__builtin_amdgcn_update_dpp(0, __float_as_int(x), 0x118, 0xf, 0xf, true)); }
__device__ __forceinline__ void wave_lds_fence() { __builtin_amdgcn_fence(__ATOMIC_RELEASE, "wavefront"); __builtin_amdgcn_wave_barrier(); __builtin_amdgcn_fence(__ATOMIC_ACQUIRE, "wavefront"); }
__device__ __forceinline__ f32x4 ld_shift4(const bf16_t* proj, const float* mu, int m, bool hp, bool hn, int col) {
  const bf16_t* q = proj + (size_t)m * DIN + col;
  u32x2 c = *(const u32x2*)q;
  u32x2 pv = (u32x2){0u, 0u}, nx = (u32x2){0u, 0u};
  if (hp) pv = *(const u32x2*)(q - DIN);
  if (hn) nx = *(const u32x2*)(q + DIN);
  f32x4 m4 = *(const f32x4*)(mu + col);
  f32x4 o;
  float c0 = bflo(c.x), c1 = bfhi(c.x), c2 = bflo(c.y), c3 = bfhi(c.y);
  o[0] = c0 + m4[0] * (0.5f * (bflo(pv.x) + bflo(nx.x)) - c0);
  o[1] = c1 + m4[1] * (0.5f * (bfhi(pv.x) + bfhi(nx.x)) - c1);
  o[2] = c2 + m4[2] * (0.5f * (bflo(pv.y) + bflo(nx.y)) - c2);
  o[3] = c3 + m4[3] * (0.5f * (bfhi(pv.y) + bfhi(nx.y)) - c3);
  return o;
}
__device__ __forceinline__ bf16x8 mk_frag(f32x4 a, f32x4 b) {
  union { bf16x8 v; uint32_t u[4]; } f;
  f.u[0] = cvtpk(a[0], a[1]); f.u[1] = cvtpk(a[2], a[3]); f.u[2] = cvtpk(b[0], b[1]); f.u[3] = cvtpk(b[2], b[3]);
  return f.v;
}
#define MFMA16(a, b, c) __builtin_amdgcn_mfma_f32_16x16x32_bf16((a), (b), (c), 0, 0, 0)

#define SCAN_H 3
#define SCAN_R 5
#define SCAN_GROUP_BYTES (4 * SC_CHUNK_BYTES)
#define SCAN_SPIN_CAP (1u << 22)
__device__ void phase_scan(const P& p, char* smem) {
  const int tid = threadIdx.x, lane = tid & 63, wave = tid >> 6, t = lane & 15, q = lane >> 4;
  char* wsc = smem + 4 * SC_CHUNK_BYTES + wave * SC_WAVE_BYTES;
  bf16_t* sT0 = (bf16_t*)wsc;
  bf16_t* sT1 = (bf16_t*)(wsc + 2176);
  float* LT = (float*)(wsc + 4352);
  float* cst = (float*)(smem + 4 * SC_CHUNK_BYTES + 4 * SC_WAVE_BYTES);
  const f32x4 z4 = (f32x4){0.f, 0.f, 0.f, 0.f};
  const int HH = (int)gridDim.x >= 96 * (1 + SCAN_H) ? SCAN_H : ((int)gridDim.x / 96 - 1 < 1 ? 1 : (int)gridDim.x / 96 - 1);
  if ((int)blockIdx.x >= 96 + 96 * HH) return;
  const bool consumer = blockIdx.x < 96;
  const int cid = consumer ? blockIdx.x : (blockIdx.x - 96) % 96;
  const int hj = consumer ? 0 : (blockIdx.x - 96) / 96;
  int d, h, T, mbase;
  if (cid < 32) { d = cid >> 4; int bs = (cid & 15) >> 3; h = cid & 7; T = 8192; mbase = 16384 + bs * 8192; }
  else { int c2 = cid - 32; d = c2 >> 5; int b = (c2 & 31) >> 3; h = c2 & 7; T = 4096; mbase = b * 4096; }
  const int ngroups = T / 64;
  unsigned* ready = p.sflag + cid * 128;
  unsigned* progress = p.sflag + 96 * 128 + cid * 16;
  char* ring = p.ring + (size_t)cid * SCAN_R * SCAN_GROUP_BYTES;
  if (!consumer) {
    __syncthreads();
    for (int i = tid; i < 320; i += NTHR) {
      const int w_ = i >> 6, n = i & 63;
      cst[i] = w_ == 0 ? p.w0[d * 512 + h * 64 + n] : w_ == 1 ? p.a0[d * 512 + h * 64 + n] : w_ == 2 ? p.k_k[h * 64 + n] : w_ == 3 ? p.k_a[h * 64 + n] : p.r_k[h * 64 + n];
    }
    u32x4 Rv[2], Rw[2], Ra[2]; u32x2 Rr[4], Rk[4];
#define SCAN_LOAD_RAW(M_) { const bf16_t* pv_ = p.ps_vwa + (size_t)(M_) * 768; const bf16_t* pr_ = p.ps_rk + (size_t)(M_) * 1024; \
      Rv[0] = *(const u32x4*)(pv_ + h * 64 + 16 * q); Rv[1] = *(const u32x4*)(pv_ + h * 64 + 16 * q + 8); \
      Rw[0] = *(const u32x4*)(pv_ + 512 + d * 64 + 8 * q); Rw[1] = *(const u32x4*)(pv_ + 512 + d * 64 + 32 + 8 * q); \
      Ra[0] = *(const u32x4*)(pv_ + 640 + d * 64 + 8 * q); Ra[1] = *(const u32x4*)(pv_ + 640 + d * 64 + 32 + 8 * q); \
      _Pragma("unroll") for (int i_ = 0; i_ < 4; ++i_) { Rr[i_] = *(const u32x2*)(pr_ + h * 64 + 16 * i_ + 4 * q); Rk[i_] = *(const u32x2*)(pr_ + 512 + h * 64 + 16 * i_ + 4 * q); } }
    {
      const int st = (hj * 4 + wave) * 16 + t;
      const int tt = d ? T - 1 - st : st;
      SCAN_LOAD_RAW(mbase + tt);
    }
    for (int g = hj; g < ngroups; g += HH) {
      if (tid == 0 && g >= SCAN_R) {
        unsigned sp = 0;
        while (__hip_atomic_load(progress, __ATOMIC_RELAXED, __HIP_MEMORY_SCOPE_AGENT) < (unsigned)(g - SCAN_R + 1)) { __builtin_amdgcn_s_sleep(2); if (++sp > SCAN_SPIN_CAP) break; }
      }
      __syncthreads();
      {
        char* slot = smem + wave * SC_CHUNK_BYTES;
        const int st = (g * 4 + wave) * 16 + t;
        const int tt = d ? T - 1 - st : st;
        const int m = mbase + tt;
        f32x4 wlv[4], alv[4];
        {
          typedef const __attribute__((address_space(1))) bf16x8* gfrag_t;
          const size_t fo0 = ((size_t)(((d * 8 + h) * 4) * 2 * 64 + lane)) * 8;
          gfrag_t wg_ = (gfrag_t)(p.w2f + fo0), ag_ = (gfrag_t)(p.a2f + fo0);
          bf16x8 wf_[8], af_[8];
#pragma unroll
          for (int u = 0; u < 8; ++u) { wf_[u] = wg_[u * 64]; af_[u] = ag_[u * 64]; }
          __builtin_amdgcn_sched_barrier(0);
#pragma unroll
          for (int i = 0; i < 4; ++i) {
            wlv[i] = *(const f32x4*)(cst + 0 * 64 + 16 * i + 4 * q);
            alv[i] = *(const f32x4*)(cst + 1 * 64 + 16 * i + 4 * q);
#pragma unroll
            for (int ks = 0; ks < 2; ++ks) {
              wlv[i] = MFMA16(wf_[i * 2 + ks], __builtin_bit_cast(bf16x8, Rw[ks]), wlv[i]);
              alv[i] = MFMA16(af_[i * 2 + ks], __builtin_bit_cast(bf16x8, Ra[ks]), alv[i]);
            }
          }
        }
        __builtin_amdgcn_sched_barrier(0);
        *(u32x2*)(sT0 + t * 68 + 16 * q) = (u32x2){Rv[0].x, Rv[0].y};
        *(u32x2*)(sT0 + t * 68 + 16 * q + 4) = (u32x2){Rv[0].z, Rv[0].w};
        *(u32x2*)(sT0 + t * 68 + 16 * q + 8) = (u32x2){Rv[1].x, Rv[1].y};
        *(u32x2*)(sT0 + t * 68 + 16 * q + 12) = (u32x2){Rv[1].z, Rv[1].w};
        wave_lds_fence();
#pragma unroll
        for (int w2_ = 0; w2_ < 4; ++w2_) {
          uint32_t v0 = sT0[(4 * q + 0) * 68 + 16 * w2_ + t], v1 = sT0[(4 * q + 1) * 68 + 16 * w2_ + t];
          uint32_t v2 = sT0[(4 * q + 2) * 68 + 16 * w2_ + t], v3 = sT0[(4 * q + 3) * 68 + 16 * w2_ + t];
          u32x2 o; o.x = v0 | (v1 << 16); o.y = v2 | (v3 << 16);
          *(u32x2*)(slot + SC_VMF + (w2_ * 64 + lane) * 8) = o;
        }
        wave_lds_fence();
        float ssq = 0.f;
#pragma unroll
        for (int i = 0; i < 4; ++i) {
          const f32x4 kk4 = *(const f32x4*)(cst + 2 * 64 + 16 * i + 4 * q);
          float kv;
          kv = bflo(Rk[i].x) * kk4[0]; ssq += kv * kv; kv = bfhi(Rk[i].x) * kk4[1]; ssq += kv * kv;
          kv = bflo(Rk[i].y) * kk4[2]; ssq += kv * kv; kv = bfhi(Rk[i].y) * kk4[3]; ssq += kv * kv;
        }
        ssq += __shfl_xor(ssq, 16); ssq += __shfl_xor(ssq, 32);
        const float inv = 1.f / fmaxf(sqrtf(ssq), 1e-12f);
        float cs = 0.f;
#pragma unroll
        for (int i = 0; i < 4; ++i) {
          __builtin_amdgcn_sched_barrier(0);
          const f32x4 wl = wlv[i], al = alv[i];
          const f32x4 kk4 = *(const f32x4*)(cst + 2 * 64 + 16 * i + 4 * q);
          const f32x4 ka4 = *(const f32x4*)(cst + 3 * 64 + 16 * i + 4 * q);
          const f32x4 rk4 = *(const f32x4*)(cst + 4 * 64 + 16 * i + 4 * q);
          f32x4 rS, kSi;
          rS[0] = bflo(Rr[i].x); rS[1] = bfhi(Rr[i].x); rS[2] = bflo(Rr[i].y); rS[3] = bfhi(Rr[i].y);
          kSi[0] = bflo(Rk[i].x); kSi[1] = bfhi(Rk[i].x); kSi[2] = bflo(Rk[i].y); kSi[3] = bfhi(Rk[i].y);
          f32x4 gc4, At, Bt, Kt, Rt, Bh, Kh;
#pragma unroll
          for (int e = 0; e < 4; ++e) {
            const float lw = -0.60653066f * __builtin_amdgcn_rcpf(1.f + __expf(-wl[e]));
            const float alp = __builtin_amdgcn_rcpf(1.f + __expf(-al[e]));
            float cum = lw;
            cum += dpp_shr1(cum); cum += dpp_shr2(cum); cum += dpp_shr4(cum); cum += dpp_shr8(cum);
            const float ep = __expf(cum);
            const float em = __builtin_amdgcn_rcpf(ep);
            float epv = dpp_shr1(ep); epv = (t == 0) ? 1.f : epv;
            const float ep15 = __shfl(ep, (lane & 48) | 15);
            const float er = ep15 * em;
            const float kk = kSi[e] * kk4[e] * inv;
            const float kdv = kSi[e] * (1.f + (alp - 1.f) * ka4[e]);
            const float bb_ = kk * alp;
            At[e] = -kk * epv; Bt[e] = bb_ * em; Kt[e] = kdv * em; Rt[e] = rS[e] * ep;
            Bh[e] = bb_ * er; Kh[e] = kdv * er;
            gc4[e] = ep15;
            cs += rS[e] * rk4[e] * kdv;
          }
          if (t == 15) *(f32x4*)(slot + SC_GC + (16 * i + 4 * q) * 4) = gc4;
          const int fo2 = ((i >> 1) * 64 + lane) * 16 + (i & 1) * 8;
          u32x2 o;
          o.x = cvtpk(At[0], At[1]); o.y = cvtpk(At[2], At[3]); *(u32x2*)(slot + SC_AF + fo2) = o;
          o.x = cvtpk(Rt[0], Rt[1]); o.y = cvtpk(Rt[2], Rt[3]); *(u32x2*)(slot + SC_RF + fo2) = o;
          o.x = cvtpk(Bt[0], Bt[1]); o.y = cvtpk(Bt[2], Bt[3]); *(u32x2*)(slot + SC_BKF + fo2) = o;
          o.x = cvtpk(Kt[0], Kt[1]); o.y = cvtpk(Kt[2], Kt[3]); *(u32x2*)(slot + SC_BKF + 2048 + fo2) = o;
          o.x = cvtpk(Bh[0], Bh[1]); o.y = cvtpk(Bh[2], Bh[3]); *(u32x2*)(sT0 + t * 68 + 16 * i + 4 * q) = o;
          o.x = cvtpk(Kh[0], Kh[1]); o.y = cvtpk(Kh[2], Kh[3]); *(u32x2*)(sT1 + t * 68 + 16 * i + 4 * q) = o;
        }
        __builtin_amdgcn_sched_barrier(0);
        cs += __shfl_xor(cs, 16); cs += __shfl_xor(cs, 32);
        if (q == 0) p.cd[((size_t)d * NTOK + m) * 8 + h] = 0.5f * cs;
        wave_lds_fence();
        union { bf16x8 v; uint32_t u[4]; } Afu[2], Bfu[2], Kfu[2], Rfu[2];
#pragma unroll
        for (int ks = 0; ks < 2; ++ks) {
          Afu[ks].v = *(const bf16x8*)(slot + SC_AF + (ks * 64 + lane) * 16);
          Rfu[ks].v = *(const bf16x8*)(slot + SC_RF + (ks * 64 + lane) * 16);
          Bfu[ks].v = *(const bf16x8*)(slot + SC_BKF + (ks * 64 + lane) * 16);
          Kfu[ks].v = *(const bf16x8*)(slot + SC_BKF + 2048 + (ks * 64 + lane) * 16);
        }
        wave_lds_fence();
        f32x4 Lab = MFMA16(Afu[1].v, Bfu[1].v, MFMA16(Afu[0].v, Bfu[0].v, z4));
        f32x4 LakT = MFMA16(Kfu[1].v, Afu[1].v, MFMA16(Kfu[0].v, Afu[0].v, z4));
        f32x4 MrbT = MFMA16(Bfu[1].v, Rfu[1].v, MFMA16(Bfu[0].v, Rfu[0].v, z4));
        f32x4 MrkT = MFMA16(Kfu[1].v, Rfu[1].v, MFMA16(Kfu[0].v, Rfu[0].v, z4));
#pragma unroll
        for (int e = 0; e < 4; ++e) {
          const int row = 4 * q + e;
          if (!(t < row)) Lab[e] = 0.f;
          if (!(row < t)) LakT[e] = 0.f;
          if (!(row <= t)) { MrbT[e] = 0.f; MrkT[e] = 0.f; }
        }
        *(f32x4*)(LT + t * 16 + 4 * q) = Lab;
        {
          union { bf16x8 v; uint32_t u[4]; } f;
          f.u[0] = 0u; f.u[1] = 0u; f.u[2] = cvtpk(LakT[0], LakT[1]); f.u[3] = cvtpk(LakT[2], LakT[3]);
          *(bf16x8*)(slot + SC_LAK + lane * 16) = f.v;
          f.u[0] = cvtpk(MrbT[0], MrbT[1]); f.u[1] = cvtpk(MrbT[2], MrbT[3]); f.u[2] = cvtpk(MrkT[0], MrkT[1]); f.u[3] = cvtpk(MrkT[2], MrkT[3]);
          *(bf16x8*)(slot + SC_MRK + lane * 16) = f.v;
        }
        wave_lds_fence();
        {
          float x[16];
#pragma unroll
          for (int c = 15; c >= 0; --c) {
            float acc = (c == t) ? 1.f : 0.f;
            asm volatile("" ::: "memory");
#pragma unroll
            for (int s2 = c + 1; s2 < 16; ++s2) acc += x[s2] * LT[c * 16 + s2];
            x[c] = acc;
          }
          float s0 = q == 0 ? x[0] : q == 1 ? x[4] : q == 2 ? x[8] : x[12];
          float s1 = q == 0 ? x[1] : q == 1 ? x[5] : q == 2 ? x[9] : x[13];
          float s2_ = q == 0 ? x[2] : q == 1 ? x[6] : q == 2 ? x[10] : x[14];
          float s3 = q == 0 ? x[3] : q == 1 ? x[7] : q == 2 ? x[11] : x[15];
          union { bf16x8 v; uint32_t u[4]; } f;
          f.u[0] = cvtpk(s0, s1); f.u[1] = cvtpk(s2_, s3); f.u[2] = 0u; f.u[3] = 0u;
          *(bf16x8*)(slot + SC_TM + lane * 16) = f.v;
        }
#pragma unroll
        for (int i = 0; i < 4; ++i) {
          uint32_t b0 = sT0[(4 * q + 0) * 68 + 16 * i + t], b1 = sT0[(4 * q + 1) * 68 + 16 * i + t];
          uint32_t b2 = sT0[(4 * q + 2) * 68 + 16 * i + t], b3 = sT0[(4 * q + 3) * 68 + 16 * i + t];
          uint32_t k0 = sT1[(4 * q + 0) * 68 + 16 * i + t], k1 = sT1[(4 * q + 1) * 68 + 16 * i + t];
          uint32_t k2 = sT1[(4 * q + 2) * 68 + 16 * i + t], k3 = sT1[(4 * q + 3) * 68 + 16 * i + t];
          u32x4 o; o.x = b0 | (b1 << 16); o.y = b2 | (b3 << 16); o.z = k0 | (k1 << 16); o.w = k2 | (k3 << 16);
          *(u32x4*)(slot + SC_BKF + (i * 64 + lane) * 16) = o;
        }
      }
      if (g + HH < ngroups) {
        const int st = ((g + HH) * 4 + wave) * 16 + t;
        const int tt = d ? T - 1 - st : st;
        SCAN_LOAD_RAW(mbase + tt);
      }
      __syncthreads();
      {
        char* dst = ring + (size_t)(g % SCAN_R) * SCAN_GROUP_BYTES;
        const __amdgpu_buffer_rsrc_t rs = __builtin_amdgcn_make_buffer_rsrc(dst, 0, SCAN_GROUP_BYTES, 0x00020000);
        for (int i = tid; i < SCAN_GROUP_BYTES / 16; i += NTHR) __builtin_amdgcn_raw_buffer_store_b128(*(const u32x4*)(smem + i * 16), rs, (unsigned)(i * 16), 0,   16);
        asm volatile("s_waitcnt vmcnt(0)" ::: "memory");
        __syncthreads();
        if (tid == 0) __hip_atomic_store(ready + g, 1u, __ATOMIC_RELAXED, __HIP_MEMORY_SCOPE_AGENT);
      }
    }
  } else {
    __builtin_amdgcn_s_setprio(3);
    f32x4 Zt[4];
#pragma unroll
    for (int i = 0; i < 4; ++i) Zt[i] = z4;
    __shared__ int sc_ok;
    u32x4 pre[14];
#define SCAN_SLOT_LOAD(G_) { const __amdgpu_buffer_rsrc_t rs_ = __builtin_amdgcn_make_buffer_rsrc(ring + (size_t)((G_) % SCAN_R) * SCAN_GROUP_BYTES, 0, SCAN_GROUP_BYTES, 0x00020000); \
      _Pragma("unroll") for (int i = 0; i < 14; ++i) { const int c = tid + 256 * i; if (c < SCAN_GROUP_BYTES / 16) pre[i] = __builtin_amdgcn_raw_buffer_load_b128(rs_, (unsigned)(c * 16), 0,   16); } }
#define SCAN_WAIT_READY(G_) { if (tid == 0) { unsigned sp = 0; while (__hip_atomic_load(ready + (G_), __ATOMIC_RELAXED, __HIP_MEMORY_SCOPE_AGENT) == 0u) { __builtin_amdgcn_s_sleep(2); if (++sp > SCAN_SPIN_CAP) break; } } __syncthreads(); }
    SCAN_WAIT_READY(0);
    SCAN_SLOT_LOAD(0);
    bool have = true;
    if (tid == 0) sc_ok = (ngroups > 1) && (__hip_atomic_load(ready + 1, __ATOMIC_RELAXED, __HIP_MEMORY_SCOPE_AGENT) != 0u);
    __syncthreads();
    bool ok1 = sc_ok != 0;
    for (int g = 0; g < ngroups; ++g) {
      if (!have) { SCAN_WAIT_READY(g); SCAN_SLOT_LOAD(g); }
#pragma unroll
      for (int i = 0; i < 14; ++i) { const int c = tid + 256 * i; if (c < SCAN_GROUP_BYTES / 16) *(u32x4*)(smem + c * 16) = pre[i]; }
      __syncthreads();
      have = (g + 1 < ngroups) && ok1;
      if (have) SCAN_SLOT_LOAD(g + 1);
      unsigned fl2 = 0u;
      if (tid == 0 && g + 2 < ngroups) fl2 = __hip_atomic_load(ready + g + 2, __ATOMIC_RELAXED, __HIP_MEMORY_SCOPE_AGENT);
#pragma unroll 1
      for (int cs_ = 0; cs_ < 4; ++cs_) {
        const char* slot = smem + cs_ * SC_CHUNK_BYTES;
        bf16x8 Zb[2];
        Zb[0] = mk_frag(Zt[0], Zt[1]); Zb[1] = mk_frag(Zt[2], Zt[3]);
        const u32x2 vm = *(const u32x2*)(slot + SC_VMF + (wave * 64 + lane) * 8);
        union { bf16x8 v; uint32_t u[4]; } VB, XB, UB;
        VB.u[0] = 0u; VB.u[1] = 0u; VB.u[2] = vm.x; VB.u[3] = vm.y;
        const bf16x8 af0 = *(const bf16x8*)(slot + SC_AF + lane * 16), af1 = *(const bf16x8*)(slot + SC_AF + (64 + lane) * 16);
        const bf16x8 rf0 = *(const bf16x8*)(slot + SC_RF + lane * 16), rf1 = *(const bf16x8*)(slot + SC_RF + (64 + lane) * 16);
        const bf16x8 lakf = *(const bf16x8*)(slot + SC_LAK + lane * 16);
        const bf16x8 tmf = *(const bf16x8*)(slot + SC_TM + lane * 16);
        const bf16x8 mrkf = *(const bf16x8*)(slot + SC_MRK + lane * 16);
        f32x4 X = MFMA16(lakf, VB.v, z4);
        X = MFMA16(af0, Zb[0], X);
        X = MFMA16(af1, Zb[1], X);
        XB.u[0] = cvtpk(X[0], X[1]); XB.u[1] = cvtpk(X[2], X[3]); XB.u[2] = vm.x; XB.u[3] = vm.y;
        f32x4 U = MFMA16(tmf, XB.v, z4);
        UB.u[0] = cvtpk(U[0], U[1]); UB.u[1] = cvtpk(U[2], U[3]); UB.u[2] = vm.x; UB.u[3] = vm.y;
        f32x4 Y = MFMA16(rf0, Zb[0], z4);
        Y = MFMA16(rf1, Zb[1], Y);
        Y = MFMA16(mrkf, UB.v, Y);
#pragma unroll
        for (int i = 0; i < 4; ++i) {
          const f32x4 gc = *(const f32x4*)(slot + SC_GC + (16 * i + 4 * q) * 4);
          const bf16x8 bk = *(const bf16x8*)(slot + SC_BKF + (i * 64 + lane) * 16);
          f32x4 init; init[0] = gc[0] * Zt[i][0]; init[1] = gc[1] * Zt[i][1]; init[2] = gc[2] * Zt[i][2]; init[3] = gc[3] * Zt[i][3];
          Zt[i] = MFMA16(bk, UB.v, init);
        }
#pragma unroll
        for (int e = 0; e < 4; ++e) {
          const int st = (g * 4 + cs_) * 16 + 4 * q + e;
          const int tt = d ? T - 1 - st : st;
          p.yd[((size_t)d * NTOK + mbase + tt) * 512 + h * 64 + 16 * wave + t] = f2bf(Y[e]);
        }
      }
      if (tid == 0) { sc_ok = (fl2 != 0u); __hip_atomic_store(progress, (unsigned)(g + 1), __ATOMIC_RELAXED, __HIP_MEMORY_SCOPE_AGENT); }
      __syncthreads();
      ok1 = sc_ok != 0;
    }
    __builtin_amdgcn_s_setprio(0);
  }
  __syncthreads();
}

__device__ void phase_attn(const P& p, char* smem) {
  bf16_t* Ks = (bf16_t*)smem;
  bf16_t* Vs = (bf16_t*)(smem + 64 * 144);
  __shared__ int item_s;
  const int tid = threadIdx.x, lane = tid & 63, wave = tid >> 6, l31 = lane & 31, h = lane >> 5;
  bf16_t* Qw = (bf16_t*)(smem + 36864) + wave * 4608;
  for (;;) {
    __syncthreads();
    if (tid == 0) item_s = atomicAdd(p.ctr, 1);
    __syncthreads();
    const int item = item_s;
    if (item >= 1024) break;
    int mbase, T, kvh, tile;
    if (item < 512) { int bs = item >> 8; kvh = (item >> 7) & 1; tile = item & 127; T = 8192; mbase = 16384 + bs * 8192; }
    else { int it = item - 512; int b = it >> 7; kvh = (it >> 6) & 1; tile = it & 63; T = 4096; mbase = b * 4096; }
    const int hq = kvh * 4 + wave;
    const int mq0 = mbase + tile * 64;
    {
      const bf16_t* qsrc = p.proj + (size_t)mq0 * DIN + 1920 + hq * 64;
#pragma unroll
      for (int jj = 0; jj < 8; ++jj) {
        const int c = lane + 64 * jj, r = c >> 3, ch = c & 7;
        *(u32x4*)(Qw + r * 72 + ch * 8) = *(const u32x4*)(qsrc + (size_t)r * DIN + ch * 8);
      }
    }
    f32x16 O[2][2];
#pragma unroll
    for (int qs = 0; qs < 2; ++qs)
#pragma unroll
      for (int dt = 0; dt < 2; ++dt)
#pragma unroll
        for (int i = 0; i < 16; ++i) O[qs][dt][i] = 0.f;
    float mrun[2] = {-1e30f, -1e30f};
    f32x2 lsum2[2] = {(f32x2){0.f, 0.f}, (f32x2){0.f, 0.f}};
    const bf16_t* Kg = p.Kc + ((size_t)kvh * NTOK + mbase) * 64;
    const bf16_t* Vg = p.Vt + (size_t)(kvh * 64) * NTOK + mbase;
    u32x4 rk[2], rv[2];
    const int nt = T / 64;
    const int tr = tid >> 3, tch = tid & 7;
    const bf16_t* kp0 = Kg + tr * 64 + tch * 8;
    const bf16_t* vp0 = Vg + (size_t)tr * NTOK + tch * 8;
    const int vpos = (tch >> 1) * 16 + (tch & 1) * 4;
#define ATT_LOAD(KT) { rk[0] = *(const u32x4*)(kp0 + (size_t)(KT) * 4096); rk[1] = *(const u32x4*)(kp0 + (size_t)(KT) * 4096 + 32 * 64); \
        rv[0] = *(const u32x4*)(vp0 + (KT) * 64); rv[1] = *(const u32x4*)(vp0 + (size_t)32 * NTOK + (KT) * 64); }
#define ATT_STORE(BUF) { bf16_t* Kd = Ks + (BUF) * 9216; bf16_t* Vd = Vs + (BUF) * 9216; _Pragma("unroll") for (int jj = 0; jj < 2; ++jj) { const int r = tr + 32 * jj; \
        *(u32x4*)(Kd + r * 72 + tch * 8) = rk[jj]; *(u32x2*)(Vd + r * 72 + vpos) = (u32x2){rv[jj].x, rv[jj].y}; *(u32x2*)(Vd + r * 72 + vpos + 8) = (u32x2){rv[jj].z, rv[jj].w}; } }
    ATT_LOAD(0);
    ATT_STORE(0);
    if (nt > 1) ATT_LOAD(1);
    __syncthreads();
    for (int kt = 0; kt < nt; ++kt) {
      const int buf = kt & 1;
      if (kt + 1 < nt) ATT_STORE(buf ^ 1);
      if (kt + 2 < nt) ATT_LOAD(kt + 2);
      __builtin_amdgcn_sched_barrier(0);
      const bf16_t* Kb = Ks + buf * 9216;
      const bf16_t* Vb = Vs + buf * 9216;
      f32x16 S[2][2];
#pragma unroll
      for (int qs = 0; qs < 2; ++qs)
#pragma unroll
        for (int i = 0; i < 16; ++i) { S[qs][0][i] = 0.f; S[qs][1][i] = 0.f; }
#pragma unroll
      for (int ks = 0; ks < 4; ++ks) {
        const bf16x8 a0 = *(const bf16x8*)(Kb + l31 * 72 + ks * 16 + h * 8);
        const bf16x8 a1 = *(const bf16x8*)(Kb + (32 + l31) * 72 + ks * 16 + h * 8);
        const bf16x8 q0 = *(const bf16x8*)(Qw + l31 * 72 + ks * 16 + h * 8);
        const bf16x8 q1 = *(const bf16x8*)(Qw + (32 + l31) * 72 + ks * 16 + h * 8);
        S[0][0] = __builtin_amdgcn_mfma_f32_32x32x16_bf16(a0, q0, S[0][0], 0, 0, 0);
        S[0][1] = __builtin_amdgcn_mfma_f32_32x32x16_bf16(a1, q0, S[0][1], 0, 0, 0);
        S[1][0] = __builtin_amdgcn_mfma_f32_32x32x16_bf16(a0, q1, S[1][0], 0, 0, 0);
        S[1][1] = __builtin_amdgcn_mfma_f32_32x32x16_bf16(a1, q1, S[1][1], 0, 0, 0);
      }
      union { bf16x8 v; uint32_t u[4]; } Pf[2][4];
#pragma unroll
      for (int qs = 0; qs < 2; ++qs) {
        float mx = fmaxf(fmaxf(S[qs][0][0], S[qs][0][1]), S[qs][0][2]);
#pragma unroll
        for (int i = 3; i < 15; i += 2) mx = fmaxf(fmaxf(mx, S[qs][0][i]), S[qs][0][i + 1]);
        mx = fmaxf(fmaxf(mx, S[qs][0][15]), S[qs][1][0]);
#pragma unroll
        for (int i = 1; i < 15; i += 2) mx = fmaxf(fmaxf(mx, S[qs][1][i]), S[qs][1][i + 1]);
        mx = fmaxf(mx, S[qs][1][15]);
        if (__any(mx > mrun[qs] + 8.f)) {
          mx = fmaxf(mx, __shfl_xor(mx, 32));
          const float mnew = fmaxf(mrun[qs], mx);
          const float alpha = __builtin_amdgcn_exp2f(mrun[qs] - mnew);
          mrun[qs] = mnew;
          lsum2[qs] *= alpha;
          O[qs][0] *= alpha; O[qs][1] *= alpha;
        }
        const f32x2 mm = (f32x2){mrun[qs], mrun[qs]};
#pragma unroll
        for (int i = 0; i < 8; ++i) {
          const f32x2 v0 = (f32x2){S[qs][0][2 * i], S[qs][0][2 * i + 1]} - mm;
          const float e0 = __builtin_amdgcn_exp2f(v0.x), e1 = __builtin_amdgcn_exp2f(v0.y);
          lsum2[qs] += (f32x2){e0, e1};
          Pf[qs][i >> 2].u[i & 3] = cvtpk(e0, e1);
          const f32x2 v1 = (f32x2){S[qs][1][2 * i], S[qs][1][2 * i + 1]} - mm;
          const float g0 = __builtin_amdgcn_exp2f(v1.x), g1 = __builtin_amdgcn_exp2f(v1.y);
          lsum2[qs] += (f32x2){g0, g1};
          Pf[qs][2 + (i >> 2)].u[i & 3] = cvtpk(g0, g1);
        }
      }
#pragma unroll
      for (int sidx = 0; sidx < 4; ++sidx) {
        const bf16x8 A0 = *(const bf16x8*)(Vb + l31 * 72 + sidx * 16 + h * 8);
        const bf16x8 A1 = *(const bf16x8*)(Vb + (32 + l31) * 72 + sidx * 16 + h * 8);
        O[0][0] = __builtin_amdgcn_mfma_f32_32x32x16_bf16(A0, Pf[0][sidx].v, O[0][0], 0, 0, 0);
        O[0][1] = __builtin_amdgcn_mfma_f32_32x32x16_bf16(A1, Pf[0][sidx].v, O[0][1], 0, 0, 0);
        O[1][0] = __builtin_amdgcn_mfma_f32_32x32x16_bf16(A0, Pf[1][sidx].v, O[1][0], 0, 0, 0);
        O[1][1] = __builtin_amdgcn_mfma_f32_32x32x16_bf16(A1, Pf[1][sidx].v, O[1][1], 0, 0, 0);
      }
      __syncthreads();
    }
    const float* g = p.ao_g + hq * 64;
#pragma unroll
    for (int qs = 0; qs < 2; ++qs) {
      float lsum = lsum2[qs].x + lsum2[qs].y;
      lsum += __shfl_xor(lsum, 32);
      const float inv = 1.f / lsum;
      float ss = 0.f;
#pragma unroll
      for (int i = 0; i < 16; ++i) { O[qs][0][i] *= inv; O[qs][1][i] *= inv; ss += O[qs][0][i] * O[qs][0][i] + O[qs][1][i] * O[qs][1][i]; }
      ss += __shfl_xor(ss, 32);
      const float rs = rsqrtf(ss * (1.f / 64.f) + 1e-6f);
      bf16_t* qrow = p.proj + (size_t)(mq0 + qs * 32 + l31) * DIN + 1920 + hq * 64;
#pragma unroll
      for (int dt = 0; dt < 2; ++dt)
#pragma unroll
        for (int gq = 0; gq < 4; ++gq) {
          const int d0 = dt * 32 + gq * 8 + h * 4;
          const f32x4 gg = *(const f32x4*)(g + d0);
          const float v0 = O[qs][dt][gq * 4 + 0] * rs * gg[0], v1 = O[qs][dt][gq * 4 + 1] * rs * gg[1];
          const float v2 = O[qs][dt][gq * 4 + 2] * rs * gg[2], v3 = O[qs][dt][gq * 4 + 3] * rs * gg[3];
          u32x2 o; o.x = cvtpk(v0, v1); o.y = cvtpk(v2, v3);
          *(u32x2*)(qrow + d0) = o;
        }
    }
  }
  __syncthreads();
}

__device__ void phase_attn_fast(const P& p, char* smem) {
  unsigned char* Ks8 = (unsigned char*)smem;
  bf16_t* Vs = (bf16_t*)(smem + 10240);
  __shared__ int item_s;
  const int tid = threadIdx.x, lane = tid & 63, wave = tid >> 6, l31 = lane & 31, h = lane >> 5;
  for (;;) {
    __syncthreads();
    if (tid == 0) item_s = atomicAdd(p.ctr, 1);
    __syncthreads();
    const int item = item_s;
    if (item >= 1024) break;
    int mbase, T, kvh, tile;
    if (item < 512) { int bs = item >> 8; kvh = (item >> 7) & 1; tile = item & 127; T = 8192; mbase = 16384 + bs * 8192; }
    else { int it = item - 512; int b = it >> 7; kvh = (it >> 6) & 1; tile = it & 63; T = 4096; mbase = b * 4096; }
    const int hq = kvh * 4 + wave;
    const int mq0 = mbase + tile * 64;
    i32x8 Qf[2];
#pragma unroll
    for (int qs = 0; qs < 2; ++qs) {
      const unsigned char* q8 = p.Q8 + ((size_t)(mq0 + qs * 32 + l31) * 8 + hq) * 64 + h * 32;
      const u32x4 qa = *(const u32x4*)q8, qb = *(const u32x4*)(q8 + 16);
      Qf[qs] = (i32x8){(int)qa.x, (int)qa.y, (int)qa.z, (int)qa.w, (int)qb.x, (int)qb.y, (int)qb.z, (int)qb.w};
    }
    f32x16 O[2][2];
#pragma unroll
    for (int qs = 0; qs < 2; ++qs)
#pragma unroll
      for (int dt = 0; dt < 2; ++dt)
#pragma unroll
        for (int i = 0; i < 16; ++i) O[qs][dt][i] = 0.f;
    float ls0 = 0.f, ls1 = 0.f;
    const unsigned char* kp8 = p.K8 + ((size_t)kvh * NTOK + mbase + (tid >> 2)) * 64 + (tid & 3) * 16;
    const bf16_t* Vg = p.Vt + (size_t)(kvh * 64) * NTOK + mbase;
    u32x4 rk8, rv[2];
    const int nt = T / 64;
    const int tr = tid >> 3, tch = tid & 7;
    const bf16_t* vp0 = Vg + (size_t)tr * NTOK + tch * 8;
    const int vpos = (tch >> 1) * 16 + (tch & 1) * 4;
#define ATF_LOAD(KT) { rk8 = *(const u32x4*)(kp8 + (size_t)(KT) * 4096); \
        rv[0] = *(const u32x4*)(vp0 + (KT) * 64); rv[1] = *(const u32x4*)(vp0 + (size_t)32 * NTOK + (KT) * 64); }
#define ATF_STORE(BUF) { *(u32x4*)(Ks8 + (BUF) * 5120 + (tid >> 2) * 80 + (tid & 3) * 16) = rk8; \
        bf16_t* Vd = Vs + (BUF) * 4608; _Pragma("unroll") for (int jj = 0; jj < 2; ++jj) { const int r = tr + 32 * jj; \
        *(u32x2*)(Vd + r * 72 + vpos) = (u32x2){rv[jj].x, rv[jj].y}; *(u32x2*)(Vd + r * 72 + vpos + 8) = (u32x2){rv[jj].z, rv[jj].w}; } }
    ATF_LOAD(0);
    ATF_STORE(0);
    if (nt > 1) ATF_LOAD(1);
    __syncthreads();
    for (int kt = 0; kt < nt; ++kt) {
      const int buf = kt & 1;
      if (kt + 1 < nt) ATF_STORE(buf ^ 1);
      if (kt + 2 < nt) ATF_LOAD(kt + 2);
      __builtin_amdgcn_sched_barrier(0);
      const unsigned char* Kb = Ks8 + buf * 5120;
      const bf16_t* Vb = Vs + buf * 4608;
      f32x16 S[2][2];
      {
        f32x16 zero16;
#pragma unroll
        for (int i = 0; i < 16; ++i) zero16[i] = 0.f;
#pragma unroll
        for (int ksub = 0; ksub < 2; ++ksub) {
          const u32x4 ka = *(const u32x4*)(Kb + (ksub * 32 + l31) * 80 + h * 32), kb = *(const u32x4*)(Kb + (ksub * 32 + l31) * 80 + h * 32 + 16);
          const i32x8 A8 = (i32x8){(int)ka.x, (int)ka.y, (int)ka.z, (int)ka.w, (int)kb.x, (int)kb.y, (int)kb.z, (int)kb.w};
          S[0][ksub] = __builtin_amdgcn_mfma_scale_f32_32x32x64_f8f6f4(A8, Qf[0], zero16, 0, 0, 0, 0x7F7F7F7F, 0, 0x7C7C7C7C);
          S[1][ksub] = __builtin_amdgcn_mfma_scale_f32_32x32x64_f8f6f4(A8, Qf[1], zero16, 0, 0, 0, 0x7F7F7F7F, 0, 0x7C7C7C7C);
        }
      }
      union { bf16x8 v; uint32_t u[4]; } Pf[2][4];
#define ATT_EXP(QS, LS) { _Pragma("unroll") for (int i = 0; i < 8; ++i) { \
          const float e0 = __builtin_amdgcn_exp2f(S[QS][0][2 * i]), e1 = __builtin_amdgcn_exp2f(S[QS][0][2 * i + 1]); \
          const float g0 = __builtin_amdgcn_exp2f(S[QS][1][2 * i]), g1 = __builtin_amdgcn_exp2f(S[QS][1][2 * i + 1]); \
          const uint32_t pe_ = cvtpk(e0, e1), pg_ = cvtpk(g0, g1); \
          LS = dot2bf(pg_, 0x3f803f80u, dot2bf(pe_, 0x3f803f80u, LS));     \
          Pf[QS][i >> 2].u[i & 3] = pe_; Pf[QS][2 + (i >> 2)].u[i & 3] = pg_; } }
      ATT_EXP(0, ls0); ATT_EXP(1, ls1);
#pragma unroll
      for (int sidx = 0; sidx < 4; ++sidx) {
        const bf16x8 A0 = *(const bf16x8*)(Vb + l31 * 72 + sidx * 16 + h * 8);
        const bf16x8 A1 = *(const bf16x8*)(Vb + (32 + l31) * 72 + sidx * 16 + h * 8);
        O[0][0] = __builtin_amdgcn_mfma_f32_32x32x16_bf16(A0, Pf[0][sidx].v, O[0][0], 0, 0, 0);
        O[0][1] = __builtin_amdgcn_mfma_f32_32x32x16_bf16(A1, Pf[0][sidx].v, O[0][1], 0, 0, 0);
        O[1][0] = __builtin_amdgcn_mfma_f32_32x32x16_bf16(A0, Pf[1][sidx].v, O[1][0], 0, 0, 0);
        O[1][1] = __builtin_amdgcn_mfma_f32_32x32x16_bf16(A1, Pf[1][sidx].v, O[1][1], 0, 0, 0);
      }
      __syncthreads();
    }
    const float* g = p.ao_g + hq * 64;
#pragma unroll
    for (int qs = 0; qs < 2; ++qs) {
      float lsum = qs ? ls1 : ls0;
      lsum += __shfl_xor(lsum, 32);
      const float inv = 1.f / lsum;
      float ss = 0.f;
#pragma unroll
      for (int i = 0; i < 16; ++i) { O[qs][0][i] *= inv; O[qs][1][i] *= inv; ss += O[qs][0][i] * O[qs][0][i] + O[qs][1][i] * O[qs][1][i]; }
      ss += __shfl_xor(ss, 32);
      const float rs = rsqrtf(ss * (1.f / 64.f) + 1e-6f);
      bf16_t* qrow = p.proj + (size_t)(mq0 + qs * 32 + l31) * DIN + 1920 + hq * 64;
#pragma unroll
      for (int dt = 0; dt < 2; ++dt)
#pragma unroll
        for (int gq = 0; gq < 4; ++gq) {
          const int d0 = dt * 32 + gq * 8 + h * 4;
          const f32x4 gg = *(const f32x4*)(g + d0);
          const float v0 = O[qs][dt][gq * 4 + 0] * rs * gg[0], v1 = O[qs][dt][gq * 4 + 1] * rs * gg[1];
          const float v2 = O[qs][dt][gq * 4 + 2] * rs * gg[2], v3 = O[qs][dt][gq * 4 + 3] * rs * gg[3];
          u32x2 o; o.x = cvtpk(v0, v1); o.y = cvtpk(v2, v3);
          *(u32x2*)(qrow + d0) = o;
        }
    }
  }
  __syncthreads();
}

__device__ void phase_attn_f8(const P& p, char* smem, const float coff) {
  unsigned char* Ks8 = (unsigned char*)smem;
  unsigned char* Vs8 = (unsigned char*)smem + 10240;
  __shared__ int item_s;
  const int tid = threadIdx.x, lane = tid & 63, wave = tid >> 6, l31 = lane & 31, h = lane >> 5;
  for (;;) {
    __syncthreads();
    if (tid == 0) item_s = atomicAdd(p.ctr, 1);
    __syncthreads();
    const int item = item_s;
    if (item >= 1024) break;
    int mbase, T, kvh, tile;
    if (item < 512) { int bs = item >> 8; kvh = (item >> 7) & 1; tile = item & 127; T = 8192; mbase = 16384 + bs * 8192; }
    else { int it = item - 512; int b = it >> 7; kvh = (it >> 6) & 1; tile = it & 63; T = 4096; mbase = b * 4096; }
    const int hq = kvh * 4 + wave;
    const int mq0 = mbase + tile * 64;
    i32x8 Qf[2];
#pragma unroll
    for (int qs = 0; qs < 2; ++qs) {
      const unsigned char* q8 = p.Q8 + ((size_t)(mq0 + qs * 32 + l31) * 8 + hq) * 64 + h * 32;
      const u32x4 qa = *(const u32x4*)q8, qb = *(const u32x4*)(q8 + 16);
      Qf[qs] = (i32x8){(int)qa.x, (int)qa.y, (int)qa.z, (int)qa.w, (int)qb.x, (int)qb.y, (int)qb.z, (int)qb.w};
    }
    f32x16 O[2][2], L[2];
#pragma unroll
    for (int qs = 0; qs < 2; ++qs) {
#pragma unroll
      for (int i = 0; i < 16; ++i) { O[qs][0][i] = 0.f; O[qs][1][i] = 0.f; L[qs][i] = 0.f; }
    }
    f32x16 cinit;
#pragma unroll
    for (int i = 0; i < 16; ++i) cinit[i] = -coff;
    const i32x8 ones8 = (i32x8){0x38383838, 0x38383838, 0x38383838, 0x38383838, 0x38383838, 0x38383838, 0x38383838, 0x38383838};
    const unsigned char* kp8 = p.K8 + ((size_t)kvh * NTOK + mbase + (tid >> 2)) * 64 + (tid & 3) * 16;
    const unsigned char* vp8 = p.V8t + (size_t)(kvh * 64 + (tid >> 2)) * NTOK + mbase + (tid & 3) * 16;
    u32x4 rk8, rv8;
    const int nt = T / 64;
#define AT8_LOAD(KT) { rk8 = *(const u32x4*)(kp8 + (size_t)(KT) * 4096); rv8 = *(const u32x4*)(vp8 + (KT) * 64); }
#define AT8_STORE(BUF) { *(u32x4*)(Ks8 + (BUF) * 5120 + (tid >> 2) * 80 + (tid & 3) * 16) = rk8; *(u32x4*)(Vs8 + (BUF) * 5120 + (tid >> 2) * 80 + (tid & 3) * 16) = rv8; }
    AT8_LOAD(0);
    AT8_STORE(0);
    if (nt > 1) AT8_LOAD(1);
    __syncthreads();
    for (int kt = 0; kt < nt; ++kt) {
      const int buf = kt & 1;
      if (kt + 1 < nt) AT8_STORE(buf ^ 1);
      if (kt + 2 < nt) AT8_LOAD(kt + 2);
      __builtin_amdgcn_sched_barrier(0);
      const unsigned char* Kb = Ks8 + buf * 5120;
      const unsigned char* Vb = Vs8 + buf * 5120;
      i32x8 Ak[2];
#pragma unroll
      for (int ksub = 0; ksub < 2; ++ksub) {
        const u32x4 ka = *(const u32x4*)(Kb + (ksub * 32 + l31) * 80 + h * 32), kb = *(const u32x4*)(Kb + (ksub * 32 + l31) * 80 + h * 32 + 16);
        Ak[ksub] = (i32x8){(int)ka.x, (int)ka.y, (int)ka.z, (int)ka.w, (int)kb.x, (int)kb.y, (int)kb.z, (int)kb.w};
      }
      i32x8 Pb[2];
#pragma unroll
      for (int qs = 0; qs < 2; ++qs) {
        const f32x16 S0 = __builtin_amdgcn_mfma_scale_f32_32x32x64_f8f6f4(Ak[0], Qf[qs], cinit, 0, 0, 0, 0x7F7F7F7F, 0, 0x7C7C7C7C);
        const f32x16 S1 = __builtin_amdgcn_mfma_scale_f32_32x32x64_f8f6f4(Ak[1], Qf[qs], cinit, 0, 0, 0, 0x7F7F7F7F, 0, 0x7C7C7C7C);
#pragma unroll
        for (int u = 0; u < 4; ++u) {
          const float e0 = __builtin_amdgcn_exp2f(S0[4 * u]), e1 = __builtin_amdgcn_exp2f(S0[4 * u + 1]), e2 = __builtin_amdgcn_exp2f(S0[4 * u + 2]), e3 = __builtin_amdgcn_exp2f(S0[4 * u + 3]);
          const float g0 = __builtin_amdgcn_exp2f(S1[4 * u]), g1 = __builtin_amdgcn_exp2f(S1[4 * u + 1]), g2 = __builtin_amdgcn_exp2f(S1[4 * u + 2]), g3 = __builtin_amdgcn_exp2f(S1[4 * u + 3]);
          Pb[qs][u] = __builtin_amdgcn_cvt_pk_fp8_f32(e2, e3, __builtin_amdgcn_cvt_pk_fp8_f32(e0, e1, 0, false), true);
          Pb[qs][4 + u] = __builtin_amdgcn_cvt_pk_fp8_f32(g2, g3, __builtin_amdgcn_cvt_pk_fp8_f32(g0, g1, 0, false), true);
        }
      }
#pragma unroll
      for (int dt = 0; dt < 2; ++dt) {
        const u32x4 va = *(const u32x4*)(Vb + (dt * 32 + l31) * 80 + h * 32), vb_ = *(const u32x4*)(Vb + (dt * 32 + l31) * 80 + h * 32 + 16);
        const i32x8 Av = (i32x8){(int)va.x, (int)va.y, (int)va.z, (int)va.w, (int)vb_.x, (int)vb_.y, (int)vb_.z, (int)vb_.w};
        O[0][dt] = __builtin_amdgcn_mfma_scale_f32_32x32x64_f8f6f4(Av, Pb[0], O[0][dt], 0, 0, 0, 0x7F7F7F7F, 0, 0x7F7F7F7F);
        O[1][dt] = __builtin_amdgcn_mfma_scale_f32_32x32x64_f8f6f4(Av, Pb[1], O[1][dt], 0, 0, 0, 0x7F7F7F7F, 0, 0x7F7F7F7F);
      }
      L[0] = __builtin_amdgcn_mfma_scale_f32_32x32x64_f8f6f4(ones8, Pb[0], L[0], 0, 0, 0, 0x7F7F7F7F, 0, 0x7F7F7F7F);
      L[1] = __builtin_amdgcn_mfma_scale_f32_32x32x64_f8f6f4(ones8, Pb[1], L[1], 0, 0, 0, 0x7F7F7F7F, 0, 0x7F7F7F7F);
      __syncthreads();
    }
    const float* g = p.ao_g + hq * 64;
#pragma unroll
    for (int qs = 0; qs < 2; ++qs) {
      const float inv = 1.f / L[qs][0];
      float ss = 0.f;
#pragma unroll
      for (int i = 0; i < 16; ++i) { O[qs][0][i] *= inv; O[qs][1][i] *= inv; ss += O[qs][0][i] * O[qs][0][i] + O[qs][1][i] * O[qs][1][i]; }
      ss += __shfl_xor(ss, 32);
      const float rs = rsqrtf(ss * (1.f / 64.f) + 1e-6f);
      bf16_t* qrow = p.proj + (size_t)(mq0 + qs * 32 + l31) * DIN + 1920 + hq * 64;
#pragma unroll
      for (int dt = 0; dt < 2; ++dt)
#pragma unroll
        for (int gq = 0; gq < 4; ++gq) {
          const int d0 = dt * 32 + gq * 8 + h * 4;
          const f32x4 gg = *(const f32x4*)(g + d0);
          const float v0 = O[qs][dt][gq * 4 + 0] * rs * gg[0], v1 = O[qs][dt][gq * 4 + 1] * rs * gg[1];
          const float v2 = O[qs][dt][gq * 4 + 2] * rs * gg[2], v3 = O[qs][dt][gq * 4 + 3] * rs * gg[3];
          u32x2 o; o.x = cvtpk(v0, v1); o.y = cvtpk(v2, v3);
          *(u32x2*)(qrow + d0) = o;
        }
    }
  }
  __syncthreads();
}

__device__ void phase_post(const P& p, char* smem) {
  bf16_t* As = (bf16_t*)smem;
  bf16_t* Bs = (bf16_t*)(smem + 34816);
  const int tid = threadIdx.x, lane = tid & 63, wave = tid >> 6, wr = wave >> 1, wc = wave & 1, q4 = lane >> 4;
  for (int item = blockIdx.x; item < 1024; item += gridDim.x) {
    const int m0 = (item >> 2) * 128, n0 = (item & 3) * 128;
    __syncthreads();
#pragma unroll
    for (int j = 0; j < 8; ++j) {
      const int c = tid + 256 * j, row = c >> 4, kc = c & 15;
      const int m = m0 + row; int bb, t, T; tok_info(m, bb, t, T);
      const bf16_t* q = p.proj + (size_t)m * DIN + 1792 + kc * 8;
      const u32x4 cc = *(const u32x4*)q;
      u32x4 pv = (u32x4){0u, 0u, 0u, 0u}, nx = (u32x4){0u, 0u, 0u, 0u};
      if (t > 0) pv = *(const u32x4*)(q - DIN);
      if (t < T - 1) nx = *(const u32x4*)(q + DIN);
      const f32x4 mu0 = *(const f32x4*)(p.mu + 1792 + kc * 8), mu1 = *(const f32x4*)(p.mu + 1792 + kc * 8 + 4);
      u32x4 o;
#pragma unroll
      for (int w = 0; w < 4; ++w) {
        const float c0 = bflo(cc[w]), c1 = bfhi(cc[w]);
        const float m_0 = w < 2 ? mu0[2 * w] : mu1[2 * w - 4], m_1 = w < 2 ? mu0[2 * w + 1] : mu1[2 * w - 3];
        const float s0 = c0 + m_0 * (0.5f * (bflo(pv[w]) + bflo(nx[w])) - c0);
        const float s1 = c1 + m_1 * (0.5f * (bfhi(pv[w]) + bfhi(nx[w])) - c1);
        o[w] = cvtpk(__builtin_amdgcn_rcpf(1.f + __expf(-s0)), __builtin_amdgcn_rcpf(1.f + __expf(-s1)));
      }
      *(u32x4*)(As + row * 136 + kc * 8) = o;
      *(u32x4*)(Bs + row * 136 + kc * 8) = *(const u32x4*)(p.g2T + (size_t)(n0 + row) * 128 + kc * 8);
    }
    __syncthreads();
    f32x4 acc[4][4];
#pragma unroll
    for (int i = 0; i < 4; ++i)
#pragma unroll
      for (int j = 0; j < 4; ++j) acc[i][j] = (f32x4){0.f, 0.f, 0.f, 0.f};
#pragma unroll
    for (int ks = 0; ks < 4; ++ks) {
      bf16x8 af[4], bfr[4];
#pragma unroll
      for (int i = 0; i < 4; ++i) af[i] = *(const bf16x8*)(As + (wr * 64 + i * 16 + (lane & 15)) * 136 + ks * 32 + q4 * 8);
#pragma unroll
      for (int j = 0; j < 4; ++j) bfr[j] = *(const bf16x8*)(Bs + (wc * 64 + j * 16 + (lane & 15)) * 136 + ks * 32 + q4 * 8);
#pragma unroll
      for (int i = 0; i < 4; ++i)
#pragma unroll
        for (int j = 0; j < 4; ++j) acc[i][j] = MFMA16(bfr[j], af[i], acc[i][j]);
    }
    const int hd = (n0 >> 6) + wc;
#pragma unroll
    for (int i = 0; i < 4; ++i) {
      const int m = m0 + wr * 64 + i * 16 + (lane & 15);
      const int cb = n0 + wc * 64 + q4 * 4;
      float y[16]; float sum = 0.f;
#pragma unroll
      for (int j = 0; j < 4; ++j) {
        const u32x2 a = *(const u32x2*)(p.yd + (size_t)m * 512 + cb + j * 16);
        const u32x2 b = *(const u32x2*)(p.yd + ((size_t)NTOK + m) * 512 + cb + j * 16);
        y[4 * j] = bflo(a.x) + bflo(b.x); y[4 * j + 1] = bfhi(a.x) + bfhi(b.x); y[4 * j + 2] = bflo(a.y) + bflo(b.y); y[4 * j + 3] = bfhi(a.y) + bfhi(b.y);
        sum += (y[4 * j] + y[4 * j + 1]) + (y[4 * j + 2] + y[4 * j + 3]);
      }
      sum += __shfl_xor(sum, 16); sum += __shfl_xor(sum, 32);
      const float mean = sum * (1.f / 64.f);
      float vs_ = 0.f;
#pragma unroll
      for (int k = 0; k < 16; ++k) { y[k] -= mean; vs_ += y[k] * y[k]; }
      vs_ += __shfl_xor(vs_, 16); vs_ += __shfl_xor(vs_, 32);
      const float rstd = rsqrtf(vs_ * (1.f / 64.f) + 64e-5f);
      const float cc = p.cd[(size_t)m * 8 + hd] + p.cd[((size_t)NTOK + m) * 8 + hd];
#pragma unroll
      for (int j = 0; j < 4; ++j) {
        const int c = cb + j * 16;
        const f32x4 lw = *(const f32x4*)(p.ln_w + c), lb = *(const f32x4*)(p.ln_b + c);
        const u32x2 vv = *(const u32x2*)(p.ps_vwa + (size_t)m * 768 + c);
        const float v0 = bflo(vv.x), v1 = bfhi(vv.x), v2 = bflo(vv.y), v3 = bfhi(vv.y);
        const float o0 = (y[4 * j] * rstd * lw[0] + lb[0] + cc * v0) * acc[i][j][0];
        const float o1 = (y[4 * j + 1] * rstd * lw[1] + lb[1] + cc * v1) * acc[i][j][1];
        const float o2 = (y[4 * j + 2] * rstd * lw[2] + lb[2] + cc * v2) * acc[i][j][2];
        const float o3 = (y[4 * j + 3] * rstd * lw[3] + lb[3] + cc * v3) * acc[i][j][3];
        u32x2 o; o.x = cvtpk(o0, o1); o.y = cvtpk(o2, o3);
        *(u32x2*)(p.proj + (size_t)m * DIN + c) = o;
      }
    }
  }
  __syncthreads();
}

__device__ void phase_convert(const float* src, bf16_t* dst, size_t n) {
  size_t n4 = n / 4;
  for (size_t i = (size_t)blockIdx.x * NTHR + threadIdx.x; i < n4; i += (size_t)gridDim.x * NTHR) {
    float4 v = ((const float4*)src)[i];
    u32x2 o; o.x = pack2(v.x, v.y); o.y = pack2(v.z, v.w);
    ((u32x2*)dst)[i] = o;
  }
}

typedef float v16f __attribute__((ext_vector_type(16)));
typedef float v32f __attribute__((ext_vector_type(32)));
typedef unsigned v6u __attribute__((ext_vector_type(6)));
__device__ void phase_convert8(const P& p) {
  const int wave = threadIdx.x >> 6, lane = threadIdx.x & 63;
  for (int e = blockIdx.x * 4 + wave; e < 16384; e += gridDim.x * 4) {
    const float* src = p.u_tab + (size_t)e * DM + lane * 16;
    f32x4 x[4]; float am = 0.f;
#pragma unroll
    for (int j = 0; j < 4; ++j) { x[j] = *(const f32x4*)(src + 4 * j); am = fmaxf(am, fmaxf(fmaxf(fabsf(x[j][0]), fabsf(x[j][1])), fmaxf(fabsf(x[j][2]), fabsf(x[j][3])))); }
    const float st = bf2f(f2bf(am > 0.f ? am * (1.f / 7.f) : 1.f)), inv4 = 1.f / st;
    uint32_t w0 = 0u, w1 = 0u;
#pragma unroll
    for (int j = 0; j < 4; ++j)
#pragma unroll
      for (int e_ = 0; e_ < 4; ++e_) {
        int q = (int)rintf(x[j][e_] * inv4); q = q > 7 ? 7 : (q < -7 ? -7 : q);
        const uint32_t nb = (uint32_t)(q + 8);
        if (j < 2) w0 |= nb << (4 * (j * 4 + e_)); else w1 |= nb << (4 * ((j - 2) * 4 + e_));
      }
    *(u32x2*)(p.ut4 + (size_t)e * 640 + lane * 8) = (u32x2){w0, w1};
    *(bf16_t*)(p.ut4 + (size_t)e * 640 + 512 + lane * 2) = f2bf(st);
  }
  for (int rp = blockIdx.x * 4 + wave; rp < 8192; rp += gridDim.x * 4) {
    const int e = rp * 2 + (lane >> 5), l32 = lane & 31;
    const float* src = p.v_tab + (size_t)e * DM + l32 * 32;
    f32x4 x[8]; float am = 0.f;
#pragma unroll
    for (int j = 0; j < 8; ++j) { x[j] = *(const f32x4*)(src + 4 * j); am = fmaxf(am, fmaxf(fmaxf(fabsf(x[j][0]), fabsf(x[j][1])), fmaxf(fabsf(x[j][2]), fabsf(x[j][3])))); }
#pragma unroll
    for (int o = 16; o >= 1; o >>= 1) am = fmaxf(am, __shfl_xor(am, o));
    const float step = am > 0.f ? am * (1.f / 6.f) : 1.f, inv = 1.f / step;
    u32x4 w = (u32x4){0u, 0u, 0u, 0u};
#pragma unroll
    for (int j = 0; j < 8; ++j)
#pragma unroll
      for (int c = 0; c < 4; ++c) {
        const float a = x[j][c] * inv, m = fabsf(a);
        const unsigned code = (m < 0.25f ? 0u : m < 0.75f ? 1u : m < 1.25f ? 2u : m < 1.75f ? 3u : m < 2.5f ? 4u : m < 3.5f ? 5u : m < 5.f ? 6u : 7u) | (a < 0.f ? 8u : 0u);
        w[j >> 1] |= code << (4 * (4 * (j & 1) + c));
      }
    *(u32x4*)(p.vt8 + (size_t)e * 512 + l32 * 16) = w;
    if (l32 == 0) p.vstep[e] = step;
  }
}

__device__ __forceinline__ int f2key(float f) { int b_ = __float_as_int(f); return b_ ^ ((b_ >> 31) & 0x7fffffff); }
__device__ __forceinline__ float key2f(int k) { int b_ = k ^ ((k >> 31) & 0x7fffffff); return __int_as_float(b_); }
__device__ __forceinline__ void sort16_desc(int (&a)[16]) {
#pragma unroll
  for (int k = 2; k <= 16; k <<= 1)
#pragma unroll
    for (int j = k >> 1; j > 0; j >>= 1)
#pragma unroll
      for (int i = 0; i < 16; ++i) {
        const int l = i ^ j;
        if (l > i) {
          const bool up = ((i & k) == 0);
          const int hi_ = max(a[i], a[l]), lo_ = min(a[i], a[l]);
          a[i] = up ? hi_ : lo_; a[l] = up ? lo_ : hi_;
        }
      }
}
__device__ __forceinline__ void merge_top16(int (&best)[16], const int (&other)[16]) {
#pragma unroll
  for (int i = 0; i < 16; ++i) best[i] = max(best[i], other[15 - i]);
#pragma unroll
  for (int j = 8; j > 0; j >>= 1)
#pragma unroll
    for (int i = 0; i < 16; ++i) {
      const int l = i ^ j;
      if (l > i) { const int hi_ = max(best[i], best[l]), lo_ = min(best[i], best[l]); best[i] = hi_; best[l] = lo_; }
    }
}

__device__ void phase_peerq(const P& p, char* smem) {
  constexpr int K = 1024;
  bf16_t* As = (bf16_t*)smem;
  bf16_t* Bs = As + 128 * 72;
  bf16_t* Qs = (bf16_t*)smem;
  bf16_t* Ss = (bf16_t*)(smem + 34816);
  int* Ks = (int*)smem;
  const int tid = threadIdx.x, lane = tid & 63, wave = tid >> 6, wr = wave >> 1, wc = wave & 1;
  const int grp = blockIdx.x & 7, gidx = blockIdx.x >> 3, gsz = gridDim.x >> 3;
  const bool xcd_order = (gridDim.x & 7) == 0;
  const int ntl = xcd_order ? 32 * 16 : 256 * 16;
  for (int u = xcd_order ? gidx : (int)blockIdx.x; u < ntl; u += xcd_order ? gsz : (int)gridDim.x) {
    const int tm = xcd_order ? (u >> 4) * 8 + grp : u >> 4, hp = u & 15;
    const int m0 = tm * 128, n0 = hp * 128;
    f32x4 acc[4][4];
    gemm_mainloop_g<false, false>((const char*)p.h2, 2048, (const char*)p.wqT, m0, n0, smem, acc);
    __syncthreads();
#pragma unroll
    for (int i = 0; i < 4; ++i)
#pragma unroll
      for (int j = 0; j < 4; ++j) {
        const int mm = wr * 64 + i * 16 + (lane & 15), nn = wc * 64 + j * 16 + (lane >> 4) * 4;
        u32x2 o; o.x = cvtpk(acc[i][j][0], acc[i][j][1]); o.y = cvtpk(acc[i][j][2], acc[i][j][3]);
        *(u32x2*)(Qs + mm * 136 + nn) = o;
      }
    {
      const bf16_t* sk = p.skb + (hp & 1) * 16384;
#pragma unroll
      for (int j = 0; j < 8; ++j) {
        int c = tid + 256 * j, row = c >> 4, kc = c & 15;
        *(u32x4*)(Ss + row * 136 + kc * 8) = *(const u32x4*)(sk + row * 128 + kc * 8);
      }
    }
    __syncthreads();
#pragma unroll
    for (int i = 0; i < 4; ++i)
#pragma unroll
      for (int j = 0; j < 4; ++j) acc[i][j] = (f32x4){0.f, 0.f, 0.f, 0.f};
#pragma unroll
    for (int ks = 0; ks < 4; ++ks) {
      bf16x8 af[4], bfr[4];
#pragma unroll
      for (int i = 0; i < 4; ++i) af[i] = *(const bf16x8*)(Qs + (wr * 64 + i * 16 + (lane & 15)) * 136 + ks * 32 + (lane >> 4) * 8);
#pragma unroll
      for (int j = 0; j < 4; ++j) bfr[j] = *(const bf16x8*)(Ss + (wc * 64 + j * 16 + (lane & 15)) * 136 + ks * 32 + (lane >> 4) * 8);
#pragma unroll
      for (int i = 0; i < 4; ++i)
#pragma unroll
        for (int j = 0; j < 4; ++j) acc[i][j] = MFMA16(bfr[j], af[i], acc[i][j]);
    }
    __syncthreads();
#pragma unroll
    for (int i = 0; i < 4; ++i)
#pragma unroll
      for (int j = 0; j < 4; ++j) {
        const int mm = wr * 64 + i * 16 + (lane & 15), nn = wc * 64 + j * 16 + (lane >> 4) * 4;
#pragma unroll
        for (int r = 0; r < 4; ++r) Ks[mm * 129 + nn + r] = (f2key(acc[i][j][r]) & ~127) | (127 - (nn + r));
      }
    __syncthreads();
    {
      const int row = tid >> 1, half = tid & 1;
      const int* src = Ks + row * 129 + half * 64;
      int best[16];
#pragma unroll
      for (int k = 0; k < 16; ++k) best[k] = src[k];
      sort16_desc(best);
#pragma unroll
      for (int blk = 1; blk < 4; ++blk) {
        int cur[16];
#pragma unroll
        for (int k = 0; k < 16; ++k) cur[k] = src[blk * 16 + k];
        sort16_desc(cur);
        merge_top16(best, cur);
      }
      int oth[16];
#pragma unroll
      for (int k = 0; k < 16; ++k) oth[k] = __shfl_xor(best[k], 1);
      merge_top16(best, oth);
      if (half == 0) {
        int* dst = p.topl + ((size_t)(m0 + row) * 16 + hp) * 16;
#pragma unroll
        for (int k4 = 0; k4 < 4; ++k4) {
          u32x4 o; o.x = (uint32_t)best[k4 * 4]; o.y = (uint32_t)best[k4 * 4 + 1]; o.z = (uint32_t)best[k4 * 4 + 2]; o.w = (uint32_t)best[k4 * 4 + 3];
          *(u32x4*)(dst + k4 * 4) = o;
        }
      }
    }
    __syncthreads();
  }
  __syncthreads();
}

#define GW_BYTES 17408
__device__ void phase_gather(const P& p, char* smem) {
  const int wave = threadIdx.x >> 6, lane = threadIdx.x & 63;
  char* wb = smem + wave * GW_BYTES;
  int* lsA = (int*)wb;
  int* lsB = (int*)(wb + 4352);
  int* res_e = (int*)(wb + 8704);
  float* res_g = (float*)(wb + 8704 + 4096);
  float* coefs = (float*)(wb + 8704 + 8192);
  for (int grp = blockIdx.x * 4 + wave; grp < NTOK / 8; grp += gridDim.x * 4) {
    const int m8 = grp * 8;
    {
      const int tk = lane >> 3, hh = lane & 7;
      const int* src = p.topl + ((size_t)(m8 + tk) * 16 + hh * 2) * 16;
      int ka[16], kb[16];
#pragma unroll
      for (int k4 = 0; k4 < 4; ++k4) {
        u32x4 wa = *(const u32x4*)(src + k4 * 4), wb_ = *(const u32x4*)(src + 16 + k4 * 4);
        ka[k4 * 4] = (int)wa.x; ka[k4 * 4 + 1] = (int)wa.y; ka[k4 * 4 + 2] = (int)wa.z; ka[k4 * 4 + 3] = (int)wa.w;
        kb[k4 * 4] = (int)wb_.x; kb[k4 * 4 + 1] = (int)wb_.y; kb[k4 * 4 + 2] = (int)wb_.z; kb[k4 * 4 + 3] = (int)wb_.w;
      }
      float va[16], vb[16];
#pragma unroll
      for (int k = 0; k < 16; ++k) { lsA[lane * 17 + k] = ka[k]; lsB[lane * 17 + k] = kb[k]; va[k] = key2f(ka[k] & ~127); vb[k] = key2f(kb[k] & ~127); }
      int t2[16];
      {
        int c_[16];
        c_[0] = (f2key(va[0] + vb[0]) & ~255) | 0;
        c_[1] = (f2key(va[0] + vb[1]) & ~255) | 1;
        c_[2] = (f2key(va[0] + vb[2]) & ~255) | 2;
        c_[3] = (f2key(va[0] + vb[3]) & ~255) | 3;
        c_[4] = (f2key(va[0] + vb[4]) & ~255) | 4;
        c_[5] = (f2key(va[0] + vb[5]) & ~255) | 5;
        c_[6] = (f2key(va[0] + vb[6]) & ~255) | 6;
        c_[7] = (f2key(va[0] + vb[7]) & ~255) | 7;
        c_[8] = (f2key(va[0] + vb[8]) & ~255) | 8;
        c_[9] = (f2key(va[0] + vb[9]) & ~255) | 9;
        c_[10] = (f2key(va[0] + vb[10]) & ~255) | 10;
        c_[11] = (f2key(va[0] + vb[11]) & ~255) | 11;
        c_[12] = (f2key(va[0] + vb[12]) & ~255) | 12;
        c_[13] = (f2key(va[0] + vb[13]) & ~255) | 13;
        c_[14] = (f2key(va[0] + vb[14]) & ~255) | 14;
        c_[15] = (f2key(va[0] + vb[15]) & ~255) | 15;
        sort16_desc(c_);
#pragma unroll
        for (int k = 0; k < 16; ++k) t2[k] = c_[k];
      }
      {
        int c_[16];
        c_[0] = (f2key(va[1] + vb[0]) & ~255) | 16;
        c_[1] = (f2key(va[1] + vb[1]) & ~255) | 17;
        c_[2] = (f2key(va[1] + vb[2]) & ~255) | 18;
        c_[3] = (f2key(va[1] + vb[3]) & ~255) | 19;
        c_[4] = (f2key(va[1] + vb[4]) & ~255) | 20;
        c_[5] = (f2key(va[1] + vb[5]) & ~255) | 21;
        c_[6] = (f2key(va[1] + vb[6]) & ~255) | 22;
        c_[7] = (f2key(va[1] + vb[7]) & ~255) | 23;
        c_[8] = (f2key(va[2] + vb[0]) & ~255) | 32;
        c_[9] = (f2key(va[2] + vb[1]) & ~255) | 33;
        c_[10] = (f2key(va[2] + vb[2]) & ~255) | 34;
        c_[11] = (f2key(va[2] + vb[3]) & ~255) | 35;
        c_[12] = (f2key(va[2] + vb[4]) & ~255) | 36;
        c_[13] = (f2key(va[3] + vb[0]) & ~255) | 48;
        c_[14] = (f2key(va[3] + vb[1]) & ~255) | 49;
        c_[15] = (f2key(va[3] + vb[2]) & ~255) | 50;
        sort16_desc(c_);
        merge_top16(t2, c_);
      }
      {
        int c_[16];
        c_[0] = (f2key(va[3] + vb[3]) & ~255) | 51;
        c_[1] = (f2key(va[4] + vb[0]) & ~255) | 64;
        c_[2] = (f2key(va[4] + vb[1]) & ~255) | 65;
        c_[3] = (f2key(va[4] + vb[2]) & ~255) | 66;
        c_[4] = (f2key(va[5] + vb[0]) & ~255) | 80;
        c_[5] = (f2key(va[5] + vb[1]) & ~255) | 81;
        c_[6] = (f2key(va[6] + vb[0]) & ~255) | 96;
        c_[7] = (f2key(va[6] + vb[1]) & ~255) | 97;
        c_[8] = (f2key(va[7] + vb[0]) & ~255) | 112;
        c_[9] = (f2key(va[7] + vb[1]) & ~255) | 113;
        c_[10] = (f2key(va[8] + vb[0]) & ~255) | 128;
        c_[11] = (f2key(va[9] + vb[0]) & ~255) | 144;
        c_[12] = (f2key(va[10] + vb[0]) & ~255) | 160;
        c_[13] = (f2key(va[11] + vb[0]) & ~255) | 176;
        c_[14] = (f2key(va[12] + vb[0]) & ~255) | 192;
        c_[15] = (f2key(va[13] + vb[0]) & ~255) | 208;
        sort16_desc(c_);
        merge_top16(t2, c_);
      }
      {
        int c_[16];
        c_[0] = (f2key(va[14] + vb[0]) & ~255) | 224;
        c_[1] = (f2key(va[15] + vb[0]) & ~255) | 240;
        c_[2] = (int)0x80000000;
        c_[3] = (int)0x80000000;
        c_[4] = (int)0x80000000;
        c_[5] = (int)0x80000000;
        c_[6] = (int)0x80000000;
        c_[7] = (int)0x80000000;
        c_[8] = (int)0x80000000;
        c_[9] = (int)0x80000000;
        c_[10] = (int)0x80000000;
        c_[11] = (int)0x80000000;
        c_[12] = (int)0x80000000;
        c_[13] = (int)0x80000000;
        c_[14] = (int)0x80000000;
        c_[15] = (int)0x80000000;
        sort16_desc(c_);
        merge_top16(t2, c_);
      }
      float sv[16]; float sum = 0.f;
      const float mx = key2f(t2[0] & ~255);
#pragma unroll
      for (int k = 0; k < 16; ++k) { sv[k] = __expf(key2f(t2[k] & ~255) - mx); sum += sv[k]; }
      const float is = 1.f / sum;
#pragma unroll
      for (int k = 0; k < 16; ++k) {
        const int code = t2[k] & 255;
        const int ia = 127 - (lsA[lane * 17 + (code >> 4)] & 127), ib = 127 - (lsB[lane * 17 + (code & 15)] & 127);
        res_e[tk * 128 + hh * 16 + k] = ia * 128 + ib;
        res_g[tk * 128 + hh * 16 + k] = sv[k] * is;
      }
    }
    wave_lds_fence();
#pragma unroll 1
    for (int tk = 0; tk < 8; ++tk) {
      const int m = m8 + tk;
      int bb, t_, T_; tok_info(m, bb, t_, T_);
      int hq[4];
      { const u32x4 hw_ = *(const u32x4*)(p.hq8 + (size_t)m * DM + lane * 16); hq[0] = (int)hw_.x; hq[1] = (int)hw_.y; hq[2] = (int)hw_.z; hq[3] = (int)hw_.w; }
      const float hstep = p.hstep[m];
      const int* re = res_e + tk * 128;
      const float* rg = res_g + tk * 128;
      const int he0 = (int)__builtin_amdgcn_perm((uint32_t)hq[1], (uint32_t)hq[0], 0x06040200u), ho0 = (int)__builtin_amdgcn_perm((uint32_t)hq[1], (uint32_t)hq[0], 0x07050301u);
      const int he1 = (int)__builtin_amdgcn_perm((uint32_t)hq[3], (uint32_t)hq[2], 0x06040200u), ho1 = (int)__builtin_amdgcn_perm((uint32_t)hq[3], (uint32_t)hq[2], 0x07050301u);
      int hsum = __builtin_amdgcn_sdot4(hq[0], 0x01010101, 0, false);
      hsum = __builtin_amdgcn_sdot4(hq[1], 0x01010101, hsum, false); hsum = __builtin_amdgcn_sdot4(hq[2], 0x01010101, hsum, false); hsum = __builtin_amdgcn_sdot4(hq[3], 0x01010101, hsum, false);
      const int hoff = 8 * hsum;
      u32x2 ud[2][16]; bf16_t us[2][16];
#define GU_LOAD(SET, B_) { _Pragma("unroll") for (int s2 = 0; s2 < 16; ++s2) { const unsigned char* urow = p.ut4 + (size_t)re[(B_) * 16 + s2] * 640; \
        ud[SET][s2] = *(const u32x2*)(urow + lane * 8); us[SET][s2] = *(const bf16_t*)(urow + 512 + lane * 2); } }
#define GU_DOT(SET) { _Pragma("unroll") for (int s2 = 0; s2 < 16; ++s2) { const u32x2 u0 = ud[SET][s2]; \
        int d = __builtin_amdgcn_sdot4((int)(u0.x & 0x0f0f0f0fu), he0, 0, false); d = __builtin_amdgcn_sdot4((int)((u0.x >> 4) & 0x0f0f0f0fu), ho0, d, false); \
        d = __builtin_amdgcn_sdot4((int)(u0.y & 0x0f0f0f0fu), he1, d, false); d = __builtin_amdgcn_sdot4((int)((u0.y >> 4) & 0x0f0f0f0fu), ho1, d, false); \
        part[s2] = bf2f(us[SET][s2]) * (float)(d - hoff); } }
      GU_LOAD(0, 0);
#pragma unroll 1
      for (int b2 = 0; b2 < 4; ++b2) {
#pragma unroll
       for (int par = 0; par < 2; ++par) {
        const int b = b2 * 2 + par;
        float part[16];
        if (par == 0) { GU_LOAD(1, b + 1); GU_DOT(0); }
        else { if (b + 1 < 8) GU_LOAD(0, b + 1); GU_DOT(1); }
        {
          const bool up = (lane & 32) != 0;
#pragma unroll
          for (int k = 0; k < 8; ++k) { float a_ = part[k], b_ = part[k + 8]; float send = up ? a_ : b_, keep = up ? b_ : a_; part[k] = keep + __shfl_xor(send, 32); }
        }
        {
          const bool up = (lane & 16) != 0;
#pragma unroll
          for (int k = 0; k < 4; ++k) { float a_ = part[k], b_ = part[k + 4]; float send = up ? a_ : b_, keep = up ? b_ : a_; part[k] = keep + __shfl_xor(send, 16); }
        }
        {
          const bool up = (lane & 8) != 0;
#pragma unroll
          for (int k = 0; k < 2; ++k) { float a_ = part[k], b_ = part[k + 2]; float send = up ? a_ : b_, keep = up ? b_ : a_; part[k] = keep + __shfl_xor(send, 8); }
        }
        float totf;
        {
          const bool up = (lane & 4) != 0;
          float a_ = part[0], b_ = part[1]; float send = up ? a_ : b_, keep = up ? b_ : a_; totf = keep + __shfl_xor(send, 4);
        }
        totf += __shfl_xor(totf, 2); totf += __shfl_xor(totf, 1);
        const int slot = b * 16 + (lane >> 2);
        const int e = re[slot];
        const float tot = totf * hstep;
        const float act = 0.5f * tot * (1.f + erff(tot * 0.70710678f));
        if ((lane & 3) == 0) coefs[slot] = rg[slot] * act * p.vstep[e];
       }
      }
      wave_lds_fence();
      const int l32 = lane & 31, hf = lane >> 5;
      v32f acc;
#pragma unroll
      for (int i = 0; i < 32; ++i) acc[i] = 0.f;
#define V4_DEC(W, D, B) { const f32x2 d_ = __builtin_amdgcn_cvt_scalef32_pk_f32_fp4(W, 1.0f, B); acc[8 * (D) + 2 * (B)] += d_.x * cf; acc[8 * (D) + 2 * (B) + 1] += d_.y * cf; }
#define V4_DEC4(W, D) V4_DEC(W, D, 0) V4_DEC(W, D, 1) V4_DEC(W, D, 2) V4_DEC(W, D, 3)
#pragma unroll 4
      for (int s2 = 0; s2 < 128; s2 += 2) {
        const int e = re[s2 + hf];
        const float cf = coefs[s2 + hf];
        const u32x4 w4 = *(const u32x4*)(p.vt8 + (size_t)e * 512 + l32 * 16);
        V4_DEC4(w4.x, 0) V4_DEC4(w4.y, 1) V4_DEC4(w4.z, 2) V4_DEC4(w4.w, 3)
      }
      wave_lds_fence();
#pragma unroll
      for (int i = 0; i < 32; ++i) acc[i] += __shfl_xor(acc[i], 32);
      float* orow = p.out + (size_t)m * DM + l32 * 32 + hf * 16;
      const float* gt2 = p.mod + bb * 6144 + 5120 + l32 * 32 + hf * 16;
#pragma unroll
      for (int j = 0; j < 4; ++j) {
        f32x4 xa = *(const f32x4*)(orow + 4 * j);
        const f32x4 ga = *(const f32x4*)(gt2 + 4 * j);
#pragma unroll
        for (int k = 0; k < 4; ++k) xa[k] += ga[k] * (hf ? acc[16 + 4 * j + k] : acc[4 * j + k]);
        *(f32x4*)(orow + 4 * j) = xa;
      }
    }
    wave_lds_fence();
  }
}

#define XB_TMO      128
#define XB_XCNT(j)  (256  + 64 * (j))
#define XB_XSUB(j)  (1280 + 64 * (j))
#define XB_XGEN(j)  (2304 + 64 * (j))
#define XB_TOP      3328
#define XB_TOPGEN   3392
#define XCD_BAR_WORDS 3456
#define XB_SPIN_CAP (1u << 23)
__device__ __forceinline__ unsigned xb_ld(unsigned* p_) { return __hip_atomic_load(p_, __ATOMIC_RELAXED, __HIP_MEMORY_SCOPE_AGENT); }
__device__ __forceinline__ unsigned xb_add(unsigned* p_, unsigned v) { return __hip_atomic_fetch_add(p_, v, __ATOMIC_RELAXED, __HIP_MEMORY_SCOPE_AGENT); }
__device__ __forceinline__ unsigned xb_xcc_id() { return (unsigned)__builtin_amdgcn_s_getreg((3 << 11) | 20) & 0xFu; }
#define XB_SPIN(cond, bar) do { unsigned _sp = 0; while (cond) { __builtin_amdgcn_s_sleep(1); \
    if ((++_sp & 255u) == 0u) { if (xb_ld(&(bar)[XB_TMO])) break; if (_sp > XB_SPIN_CAP) { atomicAdd(&(bar)[XB_TMO], 1u); break; } } } } while (0)
struct XcdBarrier { unsigned* bar; unsigned x; volatile LAS unsigned* st; };
__device__ __forceinline__ XcdBarrier xcd_barrier_post(unsigned* bar, volatile LAS unsigned* st) {
  XcdBarrier b; b.bar = bar; b.x = xb_xcc_id(); b.st = st;
  if (threadIdx.x == 0) (void)xb_add(&bar[XB_XCNT(b.x)], 1u);
  return b;
}
__device__ __forceinline__ void xcd_barrier_complete(unsigned* bar, unsigned x, unsigned& nloc, unsigned& nx) {
  const unsigned G = gridDim.x * gridDim.y * gridDim.z;
  unsigned sum, cnt, mine, sp = 0u;
  for (;;) {
    sum = 0u; cnt = 0u; mine = 0u;
#pragma unroll
    for (unsigned j = 0; j < 16; ++j) { const unsigned c = xb_ld(&bar[XB_XCNT(j)]); sum += c; cnt += (c > 0u) ? 1u : 0u; mine = (j == x) ? c : mine; }
    if (sum == G) break;
    __builtin_amdgcn_s_sleep(1);
    if ((++sp & 255u) == 0u) { if (xb_ld(&bar[XB_TMO])) break; if (sp > XB_SPIN_CAP) { atomicAdd(&bar[XB_TMO], 1u); break; } }
  }
  nloc = mine > 0u ? mine : 1u; nx = cnt > 0u ? cnt : 1u;
}
__device__ __forceinline__ void xcd_barrier(const XcdBarrier& b) {
  asm volatile("s_waitcnt vmcnt(0)" ::: "memory");
  __syncthreads();
  if (threadIdx.x == 0) {
    unsigned* bar = b.bar;
    __builtin_amdgcn_s_waitcnt(0);
    unsigned nloc = b.st[0], nx = b.st[1];
    if (nloc == 0u) { xcd_barrier_complete(bar, b.x, nloc, nx); b.st[0] = nloc; b.st[1] = nx; }
    const unsigned old = xb_add(&bar[XB_XSUB(b.x)], 1u);
    const unsigned gen = old / nloc;
    if (old + 1u == (gen + 1u) * nloc) {
      __builtin_amdgcn_fence(__ATOMIC_RELEASE, "agent");
      asm volatile("s_waitcnt vmcnt(0)" ::: "memory");
      const unsigned og = xb_add(&bar[XB_TOP], 1u);
      const unsigned tg = og / nx;
      if (og + 1u == (tg + 1u) * nx) xb_add(&bar[XB_TOPGEN], 1u);
      else XB_SPIN(xb_ld(&bar[XB_TOPGEN]) == tg, bar);
      __builtin_amdgcn_fence(__ATOMIC_ACQUIRE, "agent");
      xb_add(&bar[XB_XGEN(b.x)], 1u);
      asm volatile("s_waitcnt vmcnt(0)" ::: "memory");
    } else {
      XB_SPIN(xb_ld(&bar[XB_XGEN(b.x)]) == gen, bar);
      __builtin_amdgcn_fence(__ATOMIC_ACQUIRE, "agent");
      asm volatile("s_waitcnt vmcnt(0)" ::: "memory");
    }
  }
  __syncthreads();
}

__global__ void __launch_bounds__(NTHR, 2) mega(P p) {
  __shared__ __attribute__((aligned(16))) char smem[77056];
  cg::grid_group grid = cg::this_grid();
  __shared__ __attribute__((aligned(16))) unsigned xb_words[4];
  if (threadIdx.x == 0) { xb_words[0] = 0u; xb_words[1] = 0u; xb_words[2] = 0u; xb_words[3] = 0u; }
  __syncthreads();
  XcdBarrier xb = xcd_barrier_post(p.bar, (volatile LAS unsigned*)xb_words);
  float* fs = (float*)smem;
  if (blockIdx.x == 0 && threadIdx.x == 0) { p.ctr[0] = 0; p.ctr[1] = 0; }
  phase_mod(p, fs);
  phase_wq8(p.w_in, 2688, p.w_in8, p.w_in_s, fs);
  phase_transpose(p.w_out, p.w_outT, 1024, 1024, fs);
  phase_transpose(p.wq, p.wqT, 1024, 2048, fs);
  phase_lorafrag(p);
  phase_transpose(p.g2, p.g2T, 128, 512, fs);
  for (int i = blockIdx.x * NTHR + threadIdx.x; i < 2048; i += gridDim.x * NTHR) {
    float sn, cs; sincosf((float)(i >> 4) * powf(10000.f, -(float)(i & 15) / 16.f), &sn, &cs);
    p.rope[2 * i] = cs; p.rope[2 * i + 1] = sn;
  }
  for (int i = blockIdx.x * NTHR + threadIdx.x; i < 32768; i += gridDim.x * NTHR) p.skb[i] = f2bf(p.subk[i]);
  if (p.never) grid.sync();
  xcd_barrier(xb);
  phase_norm(p, 1);
  xcd_barrier(xb);
  phase_gemm<0>(p, smem, 0, NTOK);
  xcd_barrier(xb);
  phase_shift(p);
  xcd_barrier(xb);
  phase_scan(p, smem);
  {
    float gq = fabsf(p.qn_g[threadIdx.x & 63]), gk = fabsf(p.kn_g[threadIdx.x & 63]);
#pragma unroll
    for (int o = 32; o >= 1; o >>= 1) { gq = fmaxf(gq, __shfl_xor(gq, o)); gk = fmaxf(gk, __shfl_xor(gk, o)); }
    const float bmax = 64.f * QSCALE * 1.02f * gq * gk;
    if (bmax * 1.13f < 16.f) phase_attn_f8(p, smem, fmaxf(bmax * 1.13f - 8.5f, 0.f));
    else if (bmax < 100.f) phase_attn_fast(p, smem);
    else phase_attn(p, smem);
  }
  xcd_barrier(xb);
  phase_post(p, smem);
  xcd_barrier(xb);
  phase_gemm<1>(p, smem, 0, NTOK);
  xcd_barrier(xb);
  phase_norm(p, 2);
  phase_convert8(p);
  xcd_barrier(xb);
  phase_peerq(p, smem);
  xcd_barrier(xb);
  phase_gather(p, smem);
}

extern "C" void kernel_launch(void* const* d_in, const int* in_sizes, int n_in, void* d_out, int out_size, void* d_ws, size_t ws_size, hipStream_t stream) {
  P p{};
  const float* const* in = (const float* const*)d_in;
  p.x_prompt = in[0]; p.x_sample = in[1]; p.c_prompt = in[2]; p.c_sample = in[3]; p.ada_w = in[4]; p.ada_b = in[5]; p.norm1_g = in[6]; p.norm2_g = in[7];
  p.w_in = in[8]; p.mu = in[9]; p.w0 = in[10]; p.w2 = in[11]; p.a0 = in[12]; p.a2 = in[13]; p.g2 = in[14]; p.k_k = in[15]; p.k_a = in[16]; p.r_k = in[17];
  p.ln_w = in[18]; p.ln_b = in[19]; p.qn_g = in[20]; p.kn_g = in[21]; p.ao_g = in[22]; p.w_out = in[23]; p.wq = in[24]; p.subk = in[25]; p.u_tab = in[26]; p.v_tab = in[27];
  p.out = (float*)d_out;
  char* ws = (char*)d_ws;
  const size_t MiB = 1048576;
  p.w_inT = (bf16_t*)(ws + 0);
  p.w_outT = (bf16_t*)(ws + 6 * MiB);
  p.wqT = (bf16_t*)(ws + 8 * MiB);
  p.mod = (float*)(ws + 12 * MiB);
  p.ctr = (int*)(ws + 12 * MiB + 512 * 1024);
  p.bar = (unsigned*)(ws + 12 * MiB + 640 * 1024);
  p.sflag = (unsigned*)(ws + 12 * MiB + 704 * 1024);
  p.Q8 = (unsigned char*)(ws + 275 * MiB);
  p.V8t = (unsigned char*)(ws + 295 * MiB);
  p.K8 = (unsigned char*)(ws + 291 * MiB);
  p.ring = ws + 248 * MiB;
  p.cd = (float*)(ws + 13 * MiB);
  p.w2f = (bf16_t*)(ws + 15 * MiB);
  p.a2f = (bf16_t*)(ws + 15 * MiB + 256 * 1024);
  p.skb = (bf16_t*)(ws + 15 * MiB + 512 * 1024);
  p.g2T = (bf16_t*)(ws + 15 * MiB + 768 * 1024);
  p.rope = (float*)(ws + 15 * MiB + 896 * 1024);
  p.w_in_s = (float*)(ws + 15 * MiB + 912 * 1024);
  p.wq_s = (float*)(ws + 15 * MiB + 924 * 1024);
  p.w_in8 = (unsigned char*)(ws + 0);
  p.wq8 = (unsigned char*)(ws + 8 * MiB);
  p.topl = (int*)(ws + 80 * MiB);
  p.hq8 = (unsigned char*)(ws + 112 * MiB);
  p.hstep = (float*)(ws + 144 * MiB);
  p.hs1 = (float*)(ws + 12 * MiB + 256 * 1024);
  p.ut8 = (unsigned char*)(ws + 16 * MiB);
  p.ut4 = (unsigned char*)(ws + 16 * MiB);
  p.vt8 = (unsigned char*)(ws + 32 * MiB);
  p.ustep = (float*)(ws + 15 * MiB + 640 * 1024);
  p.vstep = (float*)(ws + 15 * MiB + 704 * 1024);
  p.proj = (bf16_t*)(ws + 16 * MiB);
  p.h2 = (bf16_t*)(ws + 184 * MiB);
  p.h = (bf16_t*)d_out;
  p.h8 = (unsigned char*)d_out + 64 * MiB;
  p.yd = (bf16_t*)((char*)d_out + 64 * MiB);
  p.Kc = (bf16_t*)((char*)d_out + 48 * MiB);
  p.Vt = (bf16_t*)((char*)d_out + 56 * MiB);
  p.ps_vwa = (bf16_t*)d_out;
  p.ps_rk = (bf16_t*)(ws + 184 * MiB);
  p.ut = (bf16_t*)(ws + 16 * MiB);
  p.vt = (bf16_t*)(ws + 48 * MiB);
  p.eidx = (int*)(ws + 80 * MiB);
  p.gate = (float*)(ws + 96 * MiB);
  p.qp = (bf16_t*)(ws + 112 * MiB);

  static int grid_blocks = 0;
  if (!grid_blocks) {
    int dev = 0, cus = 0, per_cu = 0;
    (void)hipGetDevice(&dev);
    (void)hipDeviceGetAttribute(&cus, hipDeviceAttributeMultiprocessorCount, dev);
    (void)hipOccupancyMaxActiveBlocksPerMultiprocessor(&per_cu, mega, NTHR, 0);
    if (per_cu < 1) per_cu = 1;
    grid_blocks = cus * per_cu;
  }
  (void)hipMemsetAsync(p.bar, 0, 192 * 1024, stream);
  void* args[] = {&p};
  hipError_t e = hipLaunchCooperativeKernel((void*)mega, dim3(grid_blocks), dim3(NTHR), args, 0, stream);
  if (e != hipSuccess) fprintf(stderr, "cooperative launch failed: %s (grid %d)\n", hipGetErrorString(e), grid_blocks);
}
```

```cpp
#include <hip/hip_runtime.h>
#include <hip/hip_cooperative_groups.h>
#include <stdint.h>
#include <stdio.h>
namespace cg = cooperative_groups;

typedef unsigned short bf16_t;
typedef short bf16x8 __attribute__((ext_vector_type(8)));
#define LAS __attribute__((address_space(3)))
typedef int i32x4 __attribute__((ext_vector_type(4)));
typedef int i32x8 __attribute__((ext_vector_type(8)));
typedef float f32x4 __attribute__((ext_vector_type(4)));
typedef unsigned u32x4 __attribute__((ext_vector_type(4)));
typedef unsigned u32x2 __attribute__((ext_vector_type(2)));
typedef float f32x16 __attribute__((ext_vector_type(16)));

#define NTOK 32768
#define DM 1024
#define DIN 2688
#define NTHR 256

struct P {
  const float *x_prompt, *x_sample, *c_prompt, *c_sample, *ada_w, *ada_b, *norm1_g, *norm2_g, *w_in, *mu, *w0, *w2, *a0, *a2, *g2,
      *k_k, *k_a, *r_k, *ln_w, *ln_b, *qn_g, *kn_g, *ao_g, *w_out, *wq, *subk, *u_tab, *v_tab;
  float* out;
  bf16_t *w_inT, *w_outT, *wqT;
  float *mod, *cd;
  bf16_t *proj, *h2, *h, *yd, *ut, *vt, *qp;
  int* eidx;
  float* gate;
  int* ctr;
  bf16_t *Kc, *Vt, *w2f, *a2f, *skb;
  unsigned char *Q8, *K8, *V8t;
  int* topl;
  unsigned* bar;
  bf16_t *ps_rk, *ps_vwa, *g2T;
  float* rope;
  unsigned char *ut8, *vt8, *h8, *hq8, *w_in8, *wq8, *ut4;
  float *hs1, *hstep, *w_in_s, *wq_s;
  unsigned* sflag;
  char* ring;
  long long never;
  float *ustep, *vstep;
};

__device__ __forceinline__ bf16_t f2bf(float f) {
  uint32_t u = __float_as_uint(f);
  u += 0x7fffu + ((u >> 16) & 1u);
  return (bf16_t)(u >> 16);
}
__device__ __forceinline__ float bf2f(bf16_t b) { return __uint_as_float(((uint32_t)b) << 16); }
__device__ __forceinline__ float bflo(uint32_t w) { return __uint_as_float(w << 16); }
__device__ __forceinline__ float bfhi(uint32_t w) { return __uint_as_float(w & 0xffff0000u); }
__device__ __forceinline__ uint32_t pack2(float lo, float hi) { typedef float f2_ __attribute__((ext_vector_type(2))); typedef __bf16 b2_ __attribute__((ext_vector_type(2))); f2_ v = {lo, hi}; return __builtin_bit_cast(uint32_t, __builtin_convertvector(v, b2_)); }
typedef float f32x2 __attribute__((ext_vector_type(2)));
typedef __bf16 bf16x2n __attribute__((ext_vector_type(2)));
__device__ __forceinline__ uint32_t cvtpk(float lo, float hi) { f32x2 v = {lo, hi}; return __builtin_bit_cast(uint32_t, __builtin_convertvector(v, bf16x2n)); }
__device__ __forceinline__ float dot2bf(uint32_t a, uint32_t b_, float c) {
  return __builtin_amdgcn_fdot2_f32_bf16(__builtin_bit_cast(bf16x2n, a), __builtin_bit_cast(bf16x2n, b_), c, false);
}
__device__ __forceinline__ float sigmoidf_(float x) { return 1.f / (1.f + __expf(-x)); }
__device__ __forceinline__ float wave_sum(float v) {
#pragma unroll
  for (int o = 32; o >= 1; o >>= 1) v += __shfl_xor(v, o);
  return v;
}
__device__ __forceinline__ void tok_info(int m, int& bb, int& t, int& T) {
  if (m < 16384) { bb = m >> 12; t = m & 4095; T = 4096; }
  else { int mm = m - 16384; bb = 4 + (mm >> 13); t = mm & 8191; T = 8192; }
}
__device__ __forceinline__ float shifted(const bf16_t* proj, const float* mu, int m, int t, int T, int col) {
  float mu_ = mu[col];
  float c = bf2f(proj[(size_t)m * DIN + col]);
  float pv = t > 0 ? bf2f(proj[(size_t)(m - 1) * DIN + col]) : 0.f;
  float nx = t < T - 1 ? bf2f(proj[(size_t)(m + 1) * DIN + col]) : 0.f;
  return c + mu_ * (0.5f * (pv + nx) - c);
}

__device__ void phase_mod(const P& p, float* smem) {
  float* sc = smem;
  float* red = smem + 6144;
  const int tid = threadIdx.x;
  if (blockIdx.x >= 384) return;
  for (int i = tid; i < 6 * 1024; i += NTHR) {
    int bb = i >> 10, k = i & 1023;
    float c = bb < 4 ? p.c_prompt[bb * 1024 + k] : p.c_sample[(bb - 4) * 1024 + k];
    sc[i] = c / (1.f + __expf(-c));
  }
  __syncthreads();
  const int c = tid & 15, kg = tid >> 4;
  const int col = blockIdx.x * 16 + c;
  float a0 = 0, a1 = 0, a2 = 0, a3 = 0, a4 = 0, a5 = 0;
#pragma unroll 8
  for (int it = 0; it < 64; ++it) {
    const int k = it * 16 + kg;
    const float w = p.ada_w[(size_t)k * 6144 + col];
    a0 += sc[k] * w; a1 += sc[1024 + k] * w; a2 += sc[2048 + k] * w;
    a3 += sc[3072 + k] * w; a4 += sc[4096 + k] * w; a5 += sc[5120 + k] * w;
  }
  red[(kg * 6 + 0) * 16 + c] = a0; red[(kg * 6 + 1) * 16 + c] = a1; red[(kg * 6 + 2) * 16 + c] = a2;
  red[(kg * 6 + 3) * 16 + c] = a3; red[(kg * 6 + 4) * 16 + c] = a4; red[(kg * 6 + 5) * 16 + c] = a5;
  __syncthreads();
  if (tid < 96) {
    const int bb = tid >> 4, cc = tid & 15;
    float s_ = 0.f;
#pragma unroll
    for (int g = 0; g < 16; ++g) s_ += red[(g * 6 + bb) * 16 + cc];
    p.mod[bb * 6144 + blockIdx.x * 16 + cc] = s_ + p.ada_b[blockIdx.x * 16 + cc];
  }
  __syncthreads();
}

__device__ void phase_transpose(const float* in, bf16_t* out, int K, int N, float* smem) {
  int ntk = K / 64, ntn = N / 64;
  for (int tile = blockIdx.x; tile < ntk * ntn; tile += gridDim.x) {
    int k0 = (tile / ntn) * 64, n0 = (tile % ntn) * 64;
    int c = threadIdx.x & 63, r0 = threadIdx.x >> 6;
    __syncthreads();
    for (int r = r0; r < 64; r += 4) smem[r * 65 + c] = in[(size_t)(k0 + r) * N + n0 + c];
    __syncthreads();
    for (int r = r0; r < 64; r += 4) out[(size_t)(n0 + r) * K + k0 + c] = f2bf(smem[c * 65 + r]);
  }
  __syncthreads();
}

__device__ void phase_norm(const P& p, int which) {
  int wave = threadIdx.x >> 6, lane = threadIdx.x & 63;
  const float* g = which == 1 ? p.norm1_g : p.norm2_g;
  unsigned char* dst8 = which == 1 ? p.h8 : p.hq8;
  float* dsts = which == 1 ? p.hs1 : p.hstep;
  for (int m = blockIdx.x * 4 + wave; m < NTOK; m += gridDim.x * 4) {
    int bb, t, T; tok_info(m, bb, t, T);
    const float* src = which == 1 ? (m < 16384 ? p.x_prompt + (size_t)m * DM : p.x_sample + (size_t)(m - 16384) * DM) : p.out + (size_t)m * DM;
    const float* sc = p.mod + bb * 6144 + (which == 1 ? 1024 : 4096);
    const float* sh = p.mod + bb * 6144 + (which == 1 ? 0 : 3072);
    f32x4 v[4]; float ss = 0.f;
#pragma unroll
    for (int j = 0; j < 4; ++j) { v[j] = ((const f32x4*)src)[lane + 64 * j]; ss += v[j][0] * v[j][0] + v[j][1] * v[j][1] + v[j][2] * v[j][2] + v[j][3] * v[j][3]; }
    ss = wave_sum(ss);
    const float rs = rsqrtf(ss * (1.f / 1024.f) + 1e-6f);
    float am = 0.f;
#pragma unroll
    for (int j = 0; j < 4; ++j) {
      const int c = (lane + 64 * j) * 4;
      const f32x4 gg = *(const f32x4*)(g + c), s4 = *(const f32x4*)(sc + c), h4 = *(const f32x4*)(sh + c);
#pragma unroll
      for (int e = 0; e < 4; ++e) { v[j][e] = v[j][e] * rs * gg[e] * (1.f + s4[e]) + h4[e]; am = fmaxf(am, fabsf(v[j][e])); }
    }
    if (which == 2) {
#pragma unroll
      for (int j = 0; j < 4; ++j) { u32x2 o; o.x = cvtpk(v[j][0], v[j][1]); o.y = cvtpk(v[j][2], v[j][3]); *(u32x2*)(p.h2 + (size_t)m * DM + (lane + 64 * j) * 4) = o; }
    }
#pragma unroll
    for (int o = 32; o >= 1; o >>= 1) am = fmaxf(am, __shfl_xor(am, o));
    const float step = am > 0.f ? am * (1.f / 127.f) : 1.f, inv = 1.f / step;
#pragma unroll
    for (int j = 0; j < 4; ++j) {
      const int q0 = (int)rintf(v[j][0] * inv), q1 = (int)rintf(v[j][1] * inv), q2 = (int)rintf(v[j][2] * inv), q3 = (int)rintf(v[j][3] * inv);
      *(uint32_t*)(dst8 + (size_t)m * DM + (lane + 64 * j) * 4) = (uint32_t)(q0 & 0xff) | ((uint32_t)(q1 & 0xff) << 8) | ((uint32_t)(q2 & 0xff) << 16) | ((uint32_t)(q3 & 0xff) << 24);
    }
    if (lane == 0) dsts[m] = step;
  }
}

__device__ void phase_wq8(const float* w, int N, unsigned char* out8, float* scale, float* smem) {
  const int K = 1024;
  float* red = smem;
  float* sstep = smem + 256;
  int* tile = (int*)(smem + 320);
  const int tid = threadIdx.x, c = tid & 63, kq = tid >> 6;
  for (int blk = blockIdx.x; blk < N / 64; blk += gridDim.x) {
    const int n0 = blk * 64;
    float am = 0.f;
    for (int k = kq; k < K; k += 4) am = fmaxf(am, fabsf(w[(size_t)k * N + n0 + c]));
    __syncthreads();
    red[kq * 64 + c] = am;
    __syncthreads();
    if (tid < 64) {
      const float a4 = fmaxf(fmaxf(red[tid], red[64 + tid]), fmaxf(red[128 + tid], red[192 + tid]));
      const float st = a4 > 0.f ? a4 * (1.f / 127.f) : 1.f;
      sstep[tid] = st; scale[n0 + tid] = st;
    }
    __syncthreads();
    const float inv = 1.f / sstep[c];
    for (int k0 = 0; k0 < K; k0 += 64) {
#pragma unroll
      for (int i = 0; i < 16; ++i) { const int k = kq + 4 * i; tile[k * 65 + c] = (int)rintf(w[(size_t)(k0 + k) * N + n0 + c] * inv); }
      __syncthreads();
      {
        const int r = tid >> 2, part = tid & 3;
        u32x4 o;
#pragma unroll
        for (int wd = 0; wd < 4; ++wd) {
          const int kb = part * 16 + wd * 4;
          o[wd] = (uint32_t)(tile[kb * 65 + r] & 0xff) | ((uint32_t)(tile[(kb + 1) * 65 + r] & 0xff) << 8) | ((uint32_t)(tile[(kb + 2) * 65 + r] & 0xff) << 16) | ((uint32_t)(tile[(kb + 3) * 65 + r] & 0xff) << 24);
        }
        *(u32x4*)(out8 + (size_t)(n0 + r) * K + k0 + part * 16) = o;
      }
      __syncthreads();
    }
  }
}

#define QSCALE 0.18033688f
#define GG_BUF_BYTES 32768
template <bool I8, bool AMAP, typename ACC>
__device__ __forceinline__ void gemm_mainloop_g(const char* __restrict__ A, const int ldab, const char* __restrict__ Bt, const int m0, const int n0, char* sm, ACC (&acc)[4][4]) {
  constexpr int NK = I8 ? 8 : 16, ldbb = I8 ? 1024 : 2048;
  const int tid = threadIdx.x, lane = tid & 63, wave = tid >> 6, wr = wave >> 1, wc = wave & 1;
#pragma unroll
  for (int i = 0; i < 4; ++i)
#pragma unroll
    for (int j = 0; j < 4; ++j) { acc[i][j][0] = 0; acc[i][j][1] = 0; acc[i][j][2] = 0; acc[i][j][3] = 0; }
  const int srow = wave * 8 + (lane >> 3), sch = (lane & 7) ^ (4 * (wave & 1) + (lane >> 4));
  const char* Ag = A + (size_t)(m0 + srow) * ldab + sch * 16;
  const char* Bg = Bt + (size_t)(n0 + srow) * ldbb + sch * 16;
  const int fr = lane & 15, fq = lane >> 4;
  const int aoff0 = (wr * 64 + fr) * 128 + ((fq ^ (fr >> 1)) * 16), boff0 = (wc * 64 + fr) * 128 + ((fq ^ (fr >> 1)) * 16);
#define GG_STAGE(BUF, KT) { const int k0_ = (KT) * 128; const int ka_ = AMAP ? (k0_ < 1024 ? k0_ : k0_ + 2816) : k0_; \
    const unsigned lb_ = __builtin_amdgcn_readfirstlane(lds0 + (unsigned)((BUF) * GG_BUF_BYTES)); unsigned m0s_; \
    const char* a0_ = Ag + ka_; const char* a1_ = a0_ + (size_t)32 * ldab; const char* a2_ = a0_ + (size_t)64 * ldab; const char* a3_ = a0_ + (size_t)96 * ldab; \
    const char* b0_ = Bg + k0_; const char* b1_ = b0_ + (size_t)32 * ldbb; const char* b2_ = b0_ + (size_t)64 * ldbb; const char* b3_ = b0_ + (size_t)96 * ldbb; \
    asm volatile("s_mov_b32 %0, m0\n\t" \
                 "s_mov_b32 m0, %1\n\ts_nop 0\n\tglobal_load_lds_dwordx4 %2, off\n\t" \
                 "s_add_u32 m0, %1, 0x4000\n\ts_nop 0\n\tglobal_load_lds_dwordx4 %6, off\n\t" \
                 "s_add_u32 m0, %1, 0x1000\n\ts_nop 0\n\tglobal_load_lds_dwordx4 %3, off\n\t" \
                 "s_add_u32 m0, %1, 0x5000\n\ts_nop 0\n\tglobal_load_lds_dwordx4 %7, off\n\t" \
                 "s_add_u32 m0, %1, 0x2000\n\ts_nop 0\n\tglobal_load_lds_dwordx4 %4, off\n\t" \
                 "s_add_u32 m0, %1, 0x6000\n\ts_nop 0\n\tglobal_load_lds_dwordx4 %8, off\n\t" \
                 "s_add_u32 m0, %1, 0x3000\n\ts_nop 0\n\tglobal_load_lds_dwordx4 %5, off\n\t" \
                 "s_add_u32 m0, %1, 0x7000\n\ts_nop 0\n\tglobal_load_lds_dwordx4 %9, off\n\t" \
                 "s_mov_b32 m0, %0" \
                 : "=&s"(m0s_) : "s"(lb_), "v"(a0_), "v"(a1_), "v"(a2_), "v"(a3_), "v"(b0_), "v"(b1_), "v"(b2_), "v"(b3_) : "memory", "scc"); }
  const unsigned lds0 = (unsigned)(size_t)(LAS char*)sm + (unsigned)(wave * 1024);
  GG_STAGE(0, 0);
  asm volatile("s_waitcnt vmcnt(0)" ::: "memory");
  __syncthreads();
  for (int kt = 0; kt < NK; ++kt) {
    const int buf = kt & 1;
    if (kt + 1 < NK) GG_STAGE(buf ^ 1, kt + 1);
    const char* As = sm + buf * GG_BUF_BYTES;
    const char* Bs = As + 16384;
#pragma unroll
    for (int ks = 0; ks < 2; ++ks) {
      u32x4 af[4], bfr[4];
#pragma unroll
      for (int i = 0; i < 4; ++i) af[i] = *(const u32x4*)(As + ((aoff0 + i * 2048) ^ (ks * 64)));
#pragma unroll
      for (int j = 0; j < 4; ++j) bfr[j] = *(const u32x4*)(Bs + ((boff0 + j * 2048) ^ (ks * 64)));
#pragma unroll
      for (int i = 0; i < 4; ++i)
#pragma unroll
        for (int j = 0; j < 4; ++j) {
          if constexpr (I8) acc[i][j] = __builtin_amdgcn_mfma_i32_16x16x64_i8(__builtin_bit_cast(i32x4, bfr[j]), __builtin_bit_cast(i32x4, af[i]), acc[i][j], 0, 0, 0);
          else acc[i][j] = __builtin_amdgcn_mfma_f32_16x16x32_bf16(__builtin_bit_cast(bf16x8, bfr[j]), __builtin_bit_cast(bf16x8, af[i]), acc[i][j], 0, 0, 0);
        }
    }
    asm volatile("s_waitcnt vmcnt(0)" ::: "memory");
    __syncthreads();
  }
}

template <int MODE>
__device__ void phase_gemm(const P& p, char* smem, int mrow0, int Mrows) {
  constexpr int N = MODE == 0 ? 2688 : MODE == 1 ? 1024 : 2048;
  constexpr int lda = MODE == 1 ? DIN : 1024;
  const bf16_t* A = MODE == 0 ? p.h : MODE == 1 ? p.proj : p.h2;
  const bf16_t* Bt = MODE == 0 ? p.w_inT : MODE == 1 ? p.w_outT : p.wqT;
  const int tid = threadIdx.x, lane = tid & 63, wave = tid >> 6, wr = wave >> 1, wc = wave & 1;
  const int nN = N / 128, nM = Mrows / 128;
  const int grp = blockIdx.x & 7, gidx = blockIdx.x >> 3, gsz = gridDim.x >> 3;
  const bool xcd_order = (gridDim.x & 7) == 0 && (nM & 7) == 0;
  const int ntl = xcd_order ? (nM >> 3) * nN : nM * nN;
  for (int u = xcd_order ? gidx : (int)blockIdx.x; u < ntl; u += xcd_order ? gsz : (int)gridDim.x) {
    const int tm = xcd_order ? (u / nN) * 8 + grp : u / nN, tn = u % nN;
    const int m0 = mrow0 + tm * 128, n0 = tn * 128;
    f32x4 acc[4][4];
    if (MODE == 0) {
      i32x4 ai[4][4];
      gemm_mainloop_g<true, false>((const char*)p.h8, 1024, (const char*)p.w_in8, m0, n0, smem, ai);
#pragma unroll
      for (int i = 0; i < 4; ++i) {
        const float sa = p.hs1[m0 + wr * 64 + i * 16 + (lane & 15)];
#pragma unroll
        for (int j = 0; j < 4; ++j) {
          const f32x4 sb = *(const f32x4*)(p.w_in_s + n0 + wc * 64 + j * 16 + (lane >> 4) * 4);
          acc[i][j][0] = (float)ai[i][j][0] * sa * sb[0]; acc[i][j][1] = (float)ai[i][j][1] * sa * sb[1];
          acc[i][j][2] = (float)ai[i][j][2] * sa * sb[2]; acc[i][j][3] = (float)ai[i][j][3] * sa * sb[3];
        }
      }
    } else gemm_mainloop_g<false, MODE == 1>((const char*)A, lda * 2, (const char*)Bt, m0, n0, smem, acc);
    int bb, t_, T_; tok_info(m0, bb, t_, T_);
    if (MODE == 0) {
      bf16_t* stg = (bf16_t*)smem;
#pragma unroll
      for (int i = 0; i < 4; ++i)
#pragma unroll
        for (int j = 0; j < 4; ++j) {
          const f32x4 a = acc[i][j];
          u32x2 o; o.x = pack2(a[0], a[1]); o.y = pack2(a[2], a[3]);
          *(u32x2*)(stg + (wr * 64 + i * 16 + (lane & 15)) * 136 + wc * 64 + j * 16 + (lane >> 4) * 4) = o;
        }
      __syncthreads();
      if (tn >= 15 && tn < 20) {
        const int row = tid >> 1, hh = tid & 1;
        int b2, t, T2; tok_info(m0 + row, b2, t, T2);
        bf16_t* sp = stg + row * 136 + hh * 64;
        float ss = 0.f;
#pragma unroll
        for (int k = 0; k < 8; ++k) {
          const u32x4 w = *(const u32x4*)(sp + k * 8);
          ss += bflo(w.x) * bflo(w.x) + bfhi(w.x) * bfhi(w.x) + bflo(w.y) * bflo(w.y) + bfhi(w.y) * bfhi(w.y)
              + bflo(w.z) * bflo(w.z) + bfhi(w.z) * bfhi(w.z) + bflo(w.w) * bflo(w.w) + bfhi(w.w) * bfhi(w.w);
        }
        const float rs = rsqrtf(ss * (1.f / 64.f) + 1e-6f) * (tn < 19 ? QSCALE : 1.f);
        const float* g = tn < 19 ? p.qn_g : p.kn_g;
#pragma unroll
        for (int hf = 0; hf < 2; ++hf) {
          const float* rp = p.rope + (hf == 0 ? (t >> 6) : (t & 63)) * 32;
          float x[32];
#pragma unroll
          for (int k = 0; k < 4; ++k) {
            const u32x4 w = *(const u32x4*)(sp + hf * 32 + k * 8);
            x[8 * k + 0] = bflo(w.x); x[8 * k + 1] = bfhi(w.x); x[8 * k + 2] = bflo(w.y); x[8 * k + 3] = bfhi(w.y);
            x[8 * k + 4] = bflo(w.z); x[8 * k + 5] = bfhi(w.z); x[8 * k + 6] = bflo(w.w); x[8 * k + 7] = bfhi(w.w);
          }
#pragma unroll
          for (int j = 0; j < 16; ++j) {
            const f32x2 rr = *(const f32x2*)(rp + 2 * j);
            const float y0 = x[j] * rs * g[hf * 32 + j], y1 = x[j + 16] * rs * g[hf * 32 + j + 16];
            x[j] = y0 * rr.x - y1 * rr.y; x[j + 16] = y0 * rr.y + y1 * rr.x;
          }
#pragma unroll
          for (int k = 0; k < 4; ++k) {
            u32x4 w; w.x = cvtpk(x[8 * k], x[8 * k + 1]); w.y = cvtpk(x[8 * k + 2], x[8 * k + 3]); w.z = cvtpk(x[8 * k + 4], x[8 * k + 5]); w.w = cvtpk(x[8 * k + 6], x[8 * k + 7]);
            *(u32x4*)(sp + hf * 32 + k * 8) = w;
          }
          {
            const float f8s = tn < 19 ? 8.f : 1.f;
            unsigned char* d8 = tn < 19 ? p.Q8 + ((size_t)(m0 + row) * 8 + (tn - 15) * 2 + hh) * 64 + hf * 32 : p.K8 + ((size_t)hh * NTOK + m0 + row) * 64 + hf * 32;
            u32x4 wa, wb;
#define F8PK(A, B, C, D) (uint32_t)__builtin_amdgcn_cvt_pk_fp8_f32((C) * f8s, (D) * f8s, __builtin_amdgcn_cvt_pk_fp8_f32((A) * f8s, (B) * f8s, 0, false), true)
            wa.x = F8PK(x[0], x[1], x[2], x[3]); wa.y = F8PK(x[4], x[5], x[6], x[7]); wa.z = F8PK(x[8], x[9], x[10], x[11]); wa.w = F8PK(x[12], x[13], x[14], x[15]);
            wb.x = F8PK(x[16], x[17], x[18], x[19]); wb.y = F8PK(x[20], x[21], x[22], x[23]); wb.z = F8PK(x[24], x[25], x[26], x[27]); wb.w = F8PK(x[28], x[29], x[30], x[31]);
            *(u32x4*)d8 = wa; *(u32x4*)(d8 + 16) = wb;
          }
          __builtin_amdgcn_sched_barrier(0);
        }
        __syncthreads();
      }
      if (tn < 14) {
        const int ch = tid & 15, col = n0 + ch * 8;
        const f32x4 mA = *(const f32x4*)(p.mu + col), mB = *(const f32x4*)(p.mu + col + 4);
#pragma unroll
        for (int k = 0; k < 8; ++k) {
          const int row = (tid >> 4) + 16 * k;
          const u32x4 c = *(const u32x4*)(stg + row * 136 + ch * 8);
          if (row < 2 || row > 125) *(u32x4*)(p.proj + (size_t)(m0 + row) * DIN + col) = c;
          if (row > 0 && row < 127) {
            const u32x4 pv = *(const u32x4*)(stg + (row - 1) * 136 + ch * 8), nx = *(const u32x4*)(stg + (row + 1) * 136 + ch * 8);
            float o[8];
#pragma unroll
            for (int w = 0; w < 4; ++w) {
              const float c0 = bflo(c[w]), c1 = bfhi(c[w]);
              const float mu0 = w < 2 ? mA[2 * w] : mB[2 * w - 4], mu1 = w < 2 ? mA[2 * w + 1] : mB[2 * w - 3];
              o[2 * w] = c0 + mu0 * (0.5f * (bflo(pv[w]) + bflo(nx[w])) - c0);
              o[2 * w + 1] = c1 + mu1 * (0.5f * (bfhi(pv[w]) + bfhi(nx[w])) - c1);
            }
            if (tn == 12) {
#pragma unroll
              for (int e = 0; e < 8; ++e) { const float ex = __expf(2.f * o[e]); o[e] = 1.f - 2.f / (ex + 1.f); }
            }
            u32x4 r; r.x = cvtpk(o[0], o[1]); r.y = cvtpk(o[2], o[3]); r.z = cvtpk(o[4], o[5]); r.w = cvtpk(o[6], o[7]);
            if (tn < 8) *(u32x4*)(p.ps_rk + (size_t)(m0 + row) * 1024 + col) = r;
            else *(u32x4*)(p.ps_vwa + (size_t)(m0 + row) * 768 + (col - 1024)) = r;
          }
        }
      } else if (tn < 19) {
#pragma unroll
        for (int k = 0; k < 8; ++k) {
          const int c = tid + 256 * k, row = c >> 4, ch = c & 15;
          *(u32x4*)(p.proj + (size_t)(m0 + row) * DIN + n0 + ch * 8) = *(const u32x4*)(stg + row * 136 + ch * 8);
        }
      } else if (tn == 19) {
#pragma unroll
        for (int k = 0; k < 8; ++k) {
          const int c = tid + 256 * k, row = c >> 4, ch = c & 15;
          *(u32x4*)(p.Kc + ((size_t)(ch >> 3) * NTOK + m0 + row) * 64 + (ch & 7) * 8) = *(const u32x4*)(stg + row * 136 + ch * 8);
        }
      } else {
        const int c = tid >> 1, hf = tid & 1;
        const bf16_t* col = stg + (hf * 64) * 136 + c;
        bf16_t* dst = p.Vt + (size_t)c * NTOK + m0 + hf * 64;
#pragma unroll
        for (int q4 = 0; q4 < 8; ++q4) {
          u32x4 w;
          w.x = (uint32_t)col[(q4 * 8 + 0) * 136] | ((uint32_t)col[(q4 * 8 + 1) * 136] << 16);
          w.y = (uint32_t)col[(q4 * 8 + 2) * 136] | ((uint32_t)col[(q4 * 8 + 3) * 136] << 16);
          w.z = (uint32_t)col[(q4 * 8 + 4) * 136] | ((uint32_t)col[(q4 * 8 + 5) * 136] << 16);
          w.w = (uint32_t)col[(q4 * 8 + 6) * 136] | ((uint32_t)col[(q4 * 8 + 7) * 136] << 16);
          *(u32x4*)(dst + q4 * 8) = w;
        }
        unsigned char* d8 = p.V8t + (size_t)c * NTOK + m0 + hf * 64;
#pragma unroll
        for (int g4 = 0; g4 < 4; ++g4) {
          u32x4 w8;
#pragma unroll
          for (int u = 0; u < 4; ++u) {
            const int dw = g4 * 4 + u, kb = 32 * ((dw >> 2) & 1) + 4 * (dw >> 3) + 8 * (dw & 3);
            const float f0 = bf2f(col[(kb + 0) * 136]), f1 = bf2f(col[(kb + 1) * 136]), f2 = bf2f(col[(kb + 2) * 136]), f3 = bf2f(col[(kb + 3) * 136]);
            w8[u] = (uint32_t)__builtin_amdgcn_cvt_pk_fp8_f32(f2, f3, __builtin_amdgcn_cvt_pk_fp8_f32(f0, f1, 0, false), true);
          }
          *(u32x4*)(d8 + g4 * 16) = w8;
        }
      }
      __syncthreads();
    } else if (MODE == 1) {
      float* stg = (float*)smem;
#pragma unroll
      for (int i = 0; i < 4; ++i)
#pragma unroll
        for (int j = 0; j < 4; ++j) *(f32x4*)(stg + (wr * 64 + i * 16 + (lane & 15)) * 132 + wc * 64 + j * 16 + (lane >> 4) * 4) = acc[i][j];
      __syncthreads();
#pragma unroll
      for (int k = 0; k < 16; ++k) {
        const int c = tid + 256 * k, row = c >> 5, ch = c & 31;
        const int m = m0 + row, n = n0 + ch * 4;
        const float* xs = m < 16384 ? p.x_prompt + (size_t)m * DM : p.x_sample + (size_t)(m - 16384) * DM;
        const f32x4 xv = *(const f32x4*)(xs + n), gt = *(const f32x4*)(p.mod + bb * 6144 + 2048 + n), a = *(const f32x4*)(stg + row * 132 + ch * 4);
        f32x4 o; o[0] = xv[0] + gt[0] * a[0]; o[1] = xv[1] + gt[1] * a[1]; o[2] = xv[2] + gt[2] * a[2]; o[3] = xv[3] + gt[3] * a[3];
        *(f32x4*)(p.out + (size_t)m * DM + n) = o;
      }
      __syncthreads();
    }
  }
  __syncthreads();
}

__device__ void phase_shift(const P& p) {
  for (int idx = blockIdx.x * NTHR + threadIdx.x; idx < (NTOK / 64) * 224; idx += gridDim.x * NTHR) {
    const int mi = idx / 224, ch = idx - mi * 224, col = ch * 8, m = (mi >> 1) * 128 + (mi & 1) * 127;
    int bb, t, T; tok_info(m, bb, t, T);
    const bf16_t* q = p.proj + (size_t)m * DIN + col;
    const u32x4 c = *(const u32x4*)q;
    u32x4 pv = (u32x4){0u, 0u, 0u, 0u}, nx = (u32x4){0u, 0u, 0u, 0u};
    if (t > 0) pv = *(const u32x4*)(q - DIN);
    if (t < T - 1) nx = *(const u32x4*)(q + DIN);
    const f32x4 m0 = *(const f32x4*)(p.mu + col), m1 = *(const f32x4*)(p.mu + col + 4);
    float o[8];
#pragma unroll
    for (int w = 0; w < 4; ++w) {
      const float c0 = bflo(c[w]), c1 = bfhi(c[w]);
      const float mu0 = w < 2 ? m0[2 * w] : m1[2 * w - 4], mu1 = w < 2 ? m0[2 * w + 1] : m1[2 * w - 3];
      o[2 * w] = c0 + mu0 * (0.5f * (bflo(pv[w]) + bflo(nx[w])) - c0);
      o[2 * w + 1] = c1 + mu1 * (0.5f * (bfhi(pv[w]) + bfhi(nx[w])) - c1);
    }
    if (col >= 1536 && col < 1664) {
#pragma unroll
      for (int e = 0; e < 8; ++e) { const float ex = __expf(2.f * o[e]); o[e] = 1.f - 2.f / (ex + 1.f); }
    }
    u32x4 r; r.x = cvtpk(o[0], o[1]); r.y = cvtpk(o[2], o[3]); r.z = cvtpk(o[4], o[5]); r.w = cvtpk(o[6], o[7]);
    if (col < 1024) *(u32x4*)(p.ps_rk + (size_t)m * 1024 + col) = r;
    else *(u32x4*)(p.ps_vwa + (size_t)m * 768 + (col - 1024)) = r;
  }
}

__device__ void phase_lorafrag(const P& p) {
  for (int idx = blockIdx.x * NTHR + threadIdx.x; idx < 65536; idx += gridDim.x * NTHR) {
    int j = idx & 7, lane = (idx >> 3) & 63, ks = (idx >> 9) & 1, i = (idx >> 10) & 3, hh = (idx >> 12) & 7, d = idx >> 15;
    int l = 32 * ks + 8 * (lane >> 4) + j, n = hh * 64 + 16 * i + (lane & 15);
    p.w2f[idx] = f2bf(p.w2[(size_t)(d * 64 + l) * 512 + n]);
    p.a2f[idx] = f2bf(p.a2[(size_t)(d * 64 + l) * 512 + n]);
  }
}

#define SC_CHUNK_BYTES 13568
#define SC_AF 0
#define SC_RF 2048
#define SC_LAK 4096
#define SC_TM 5120
#define SC_MRK 6144
#define SC_VMF 7168
#define SC_BKF 9216
#define SC_GC 13312
#define SC_WAVE_BYTES 5376
__device__ __forceinline__ float dpp_shr1(float x) { return __int_as_float(__builtin_amdgcn_update_dpp(0, __float_as_int(x), 0x111, 0xf, 0xf, true)); }
__device__ __forceinline__ float dpp_shr2(float x) { return __int_as_float(__builtin_amdgcn_update_dpp(0, __float_as_int(x), 0x112, 0xf, 0xf, true)); }
__device__ __forceinline__ float dpp_shr4(float x) { return __int_as_float(__builtin_amdgcn_update_dpp(0, __float_as_int(x), 0x114, 0xf, 0xf, true)); }
__device__ __forceinline__ float dpp_shr8(float x) { return __int_as_float(__builtin_amdgcn_update_dpp(0, __float_as_int(x), 0x118, 0xf, 0xf, true)); }
__device__ __forceinline__ void wave_lds_fence() { __builtin_amdgcn_fence(__ATOMIC_RELEASE, "wavefront"); __builtin_amdgcn_wave_barrier(); __builtin_amdgcn_fence(__ATOMIC_ACQUIRE, "wavefront"); }
__device__ __forceinline__ f32x4 ld_shift4(const bf16_t* proj, const float* mu, int m, bool hp, bool hn, int col) {
  const bf16_t* q = proj + (size_t)m * DIN + col;
  u32x2 c = *(const u32x2*)q;
  u32x2 pv = (u32x2){0u, 0u}, nx = (u32x2){0u, 0u};
  if (hp) pv = *(const u32x2*)(q - DIN);
  if (hn) nx = *(const u32x2*)(q + DIN);
  f32x4 m4 = *(const f32x4*)(mu + col);
  f32x4 o;
  float c0 = bflo(c.x), c1 = bfhi(c.x), c2 = bflo(c.y), c3 = bfhi(c.y);
  o[0] = c0 + m4[0] * (0.5f * (bflo(pv.x) + bflo(nx.x)) - c0);
  o[1] = c1 + m4[1] * (0.5f * (bfhi(pv.x) + bfhi(nx.x)) - c1);
  o[2] = c2 + m4[2] * (0.5f * (bflo(pv.y) + bflo(nx.y)) - c2);
  o[3] = c3 + m4[3] * (0.5f * (bfhi(pv.y) + bfhi(nx.y)) - c3);
  return o;
}
__device__ __forceinline__ bf16x8 mk_frag(f32x4 a, f32x4 b) {
  union { bf16x8 v; uint32_t u[4]; } f;
  f.u[0] = cvtpk(a[0], a[1]); f.u[1] = cvtpk(a[2], a[3]); f.u[2] = cvtpk(b[0], b[1]); f.u[3] = cvtpk(b[2], b[3]);
  return f.v;
}
#define MFMA16(a, b, c) __builtin_amdgcn_mfma_f32_16x16x32_bf16((a), (b), (c), 0, 0, 0)

#define SCAN_H 2
#define SCAN_R 5
#define SCAN_GROUP_BYTES (4 * SC_CHUNK_BYTES)
#define SCAN_SPIN_CAP (1u << 22)
__device__ void phase_scan(const P& p, char* smem) {
  const int tid = threadIdx.x, lane = tid & 63, wave = tid >> 6, t = lane & 15, q = lane >> 4;
  char* wsc = smem + 4 * SC_CHUNK_BYTES + wave * SC_WAVE_BYTES;
  bf16_t* sT0 = (bf16_t*)wsc;
  bf16_t* sT1 = (bf16_t*)(wsc + 2176);
  float* LT = (float*)(wsc + 4352);
  float* cst = (float*)(smem + 4 * SC_CHUNK_BYTES + 4 * SC_WAVE_BYTES);
  const f32x4 z4 = (f32x4){0.f, 0.f, 0.f, 0.f};
  const int HH = (int)gridDim.x >= 96 * (1 + SCAN_H) ? SCAN_H : ((int)gridDim.x / 96 - 1 < 1 ? 1 : (int)gridDim.x / 96 - 1);
  if ((int)blockIdx.x >= 96 + 96 * HH) return;
  const bool consumer = blockIdx.x < 96;
  const int cid = consumer ? blockIdx.x : (blockIdx.x - 96) % 96;
  const int hj = consumer ? 0 : (blockIdx.x - 96) / 96;
  int d, h, T, mbase;
  if (cid < 32) { d = cid >> 4; int bs = (cid & 15) >> 3; h = cid & 7; T = 8192; mbase = 16384 + bs * 8192; }
  else { int c2 = cid - 32; d = c2 >> 5; int b = (c2 & 31) >> 3; h = c2 & 7; T = 4096; mbase = b * 4096; }
  const int ngroups = T / 64;
  unsigned* ready = p.sflag + cid * 128;
  unsigned* progress = p.sflag + 96 * 128 + cid * 16;
  char* ring = p.ring + (size_t)cid * SCAN_R * SCAN_GROUP_BYTES;
  if (!consumer) {
    __syncthreads();
    for (int i = tid; i < 320; i += NTHR) {
      const int w_ = i >> 6, n = i & 63;
      cst[i] = w_ == 0 ? p.w0[d * 512 + h * 64 + n] : w_ == 1 ? p.a0[d * 512 + h * 64 + n] : w_ == 2 ? p.k_k[h * 64 + n] : w_ == 3 ? p.k_a[h * 64 + n] : p.r_k[h * 64 + n];
    }
    u32x4 Rv[2], Rw[2], Ra[2]; u32x2 Rr[4], Rk[4];
#define SCAN_LOAD_RAW(M_) { const bf16_t* pv_ = p.ps_vwa + (size_t)(M_) * 768; const bf16_t* pr_ = p.ps_rk + (size_t)(M_) * 1024; \
      Rv[0] = *(const u32x4*)(pv_ + h * 64 + 16 * q); Rv[1] = *(const u32x4*)(pv_ + h * 64 + 16 * q + 8); \
      Rw[0] = *(const u32x4*)(pv_ + 512 + d * 64 + 8 * q); Rw[1] = *(const u32x4*)(pv_ + 512 + d * 64 + 32 + 8 * q); \
      Ra[0] = *(const u32x4*)(pv_ + 640 + d * 64 + 8 * q); Ra[1] = *(const u32x4*)(pv_ + 640 + d * 64 + 32 + 8 * q); \
      _Pragma("unroll") for (int i_ = 0; i_ < 4; ++i_) { Rr[i_] = *(const u32x2*)(pr_ + h * 64 + 16 * i_ + 4 * q); Rk[i_] = *(const u32x2*)(pr_ + 512 + h * 64 + 16 * i_ + 4 * q); } }
    {
      const int st = (hj * 4 + wave) * 16 + t;
      const int tt = d ? T - 1 - st : st;
      SCAN_LOAD_RAW(mbase + tt);
    }
    for (int g = hj; g < ngroups; g += HH) {
      if (tid == 0 && g >= SCAN_R) {
        unsigned sp = 0;
        while (__hip_atomic_load(progress, __ATOMIC_RELAXED, __HIP_MEMORY_SCOPE_AGENT) < (unsigned)(g - SCAN_R + 1)) { __builtin_amdgcn_s_sleep(2); if (++sp > SCAN_SPIN_CAP) break; }
      }
      __syncthreads();
      {
        char* slot = smem + wave * SC_CHUNK_BYTES;
        const int st = (g * 4 + wave) * 16 + t;
        const int tt = d ? T - 1 - st : st;
        const int m = mbase + tt;
        f32x4 wlv[4], alv[4];
        {
          typedef const __attribute__((address_space(1))) bf16x8* gfrag_t;
          const size_t fo0 = ((size_t)(((d * 8 + h) * 4) * 2 * 64 + lane)) * 8;
          gfrag_t wg_ = (gfrag_t)(p.w2f + fo0), ag_ = (gfrag_t)(p.a2f + fo0);
          bf16x8 wf_[8], af_[8];
#pragma unroll
          for (int u = 0; u < 8; ++u) { wf_[u] = wg_[u * 64]; af_[u] = ag_[u * 64]; }
          __builtin_amdgcn_sched_barrier(0);
#pragma unroll
          for (int i = 0; i < 4; ++i) {
            wlv[i] = *(const f32x4*)(cst + 0 * 64 + 16 * i + 4 * q);
            alv[i] = *(const f32x4*)(cst + 1 * 64 + 16 * i + 4 * q);
#pragma unroll
            for (int ks = 0; ks < 2; ++ks) {
              wlv[i] = MFMA16(wf_[i * 2 + ks], __builtin_bit_cast(bf16x8, Rw[ks]), wlv[i]);
              alv[i] = MFMA16(af_[i * 2 + ks], __builtin_bit_cast(bf16x8, Ra[ks]), alv[i]);
            }
          }
        }
        __builtin_amdgcn_sched_barrier(0);
        *(u32x2*)(sT0 + t * 68 + 16 * q) = (u32x2){Rv[0].x, Rv[0].y};
        *(u32x2*)(sT0 + t * 68 + 16 * q + 4) = (u32x2){Rv[0].z, Rv[0].w};
        *(u32x2*)(sT0 + t * 68 + 16 * q + 8) = (u32x2){Rv[1].x, Rv[1].y};
        *(u32x2*)(sT0 + t * 68 + 16 * q + 12) = (u32x2){Rv[1].z, Rv[1].w};
        wave_lds_fence();
#pragma unroll
        for (int w2_ = 0; w2_ < 4; ++w2_) {
          uint32_t v0 = sT0[(4 * q + 0) * 68 + 16 * w2_ + t], v1 = sT0[(4 * q + 1) * 68 + 16 * w2_ + t];
          uint32_t v2 = sT0[(4 * q + 2) * 68 + 16 * w2_ + t], v3 = sT0[(4 * q + 3) * 68 + 16 * w2_ + t];
          u32x2 o; o.x = v0 | (v1 << 16); o.y = v2 | (v3 << 16);
          *(u32x2*)(slot + SC_VMF + (w2_ * 64 + lane) * 8) = o;
        }
        wave_lds_fence();
        float ssq = 0.f;
#pragma unroll
        for (int i = 0; i < 4; ++i) {
          const f32x4 kk4 = *(const f32x4*)(cst + 2 * 64 + 16 * i + 4 * q);
          float kv;
          kv = bflo(Rk[i].x) * kk4[0]; ssq += kv * kv; kv = bfhi(Rk[i].x) * kk4[1]; ssq += kv * kv;
          kv = bflo(Rk[i].y) * kk4[2]; ssq += kv * kv; kv = bfhi(Rk[i].y) * kk4[3]; ssq += kv * kv;
        }
        ssq += __shfl_xor(ssq, 16); ssq += __shfl_xor(ssq, 32);
        const float inv = 1.f / fmaxf(sqrtf(ssq), 1e-12f);
        float cs = 0.f;
#pragma unroll
        for (int i = 0; i < 4; ++i) {
          __builtin_amdgcn_sched_barrier(0);
          const f32x4 wl = wlv[i], al = alv[i];
          const f32x4 kk4 = *(const f32x4*)(cst + 2 * 64 + 16 * i + 4 * q);
          const f32x4 ka4 = *(const f32x4*)(cst + 3 * 64 + 16 * i + 4 * q);
          const f32x4 rk4 = *(const f32x4*)(cst + 4 * 64 + 16 * i + 4 * q);
          f32x4 rS, kSi;
          rS[0] = bflo(Rr[i].x); rS[1] = bfhi(Rr[i].x); rS[2] = bflo(Rr[i].y); rS[3] = bfhi(Rr[i].y);
          kSi[0] = bflo(Rk[i].x); kSi[1] = bfhi(Rk[i].x); kSi[2] = bflo(Rk[i].y); kSi[3] = bfhi(Rk[i].y);
          f32x4 gc4, At, Bt, Kt, Rt, Bh, Kh;
#pragma unroll
          for (int e = 0; e < 4; ++e) {
            const float lw = -0.60653066f * __builtin_amdgcn_rcpf(1.f + __expf(-wl[e]));
            const float alp = __builtin_amdgcn_rcpf(1.f + __expf(-al[e]));
            float cum = lw;
            cum += dpp_shr1(cum); cum += dpp_shr2(cum); cum += dpp_shr4(cum); cum += dpp_shr8(cum);
            const float ep = __expf(cum);
            const float em = __builtin_amdgcn_rcpf(ep);
            float epv = dpp_shr1(ep); epv = (t == 0) ? 1.f : epv;
            const float ep15 = __shfl(ep, (lane & 48) | 15);
            const float er = ep15 * em;
            const float kk = kSi[e] * kk4[e] * inv;
            const float kdv = kSi[e] * (1.f + (alp - 1.f) * ka4[e]);
            const float bb_ = kk * alp;
            At[e] = -kk * epv; Bt[e] = bb_ * em; Kt[e] = kdv * em; Rt[e] = rS[e] * ep;
            Bh[e] = bb_ * er; Kh[e] = kdv * er;
            gc4[e] = ep15;
            cs += rS[e] * rk4[e] * kdv;
          }
          if (t == 15) *(f32x4*)(slot + SC_GC + (16 * i + 4 * q) * 4) = gc4;
          const int fo2 = ((i >> 1) * 64 + lane) * 16 + (i & 1) * 8;
          u32x2 o;
          o.x = cvtpk(At[0], At[1]); o.y = cvtpk(At[2], At[3]); *(u32x2*)(slot + SC_AF + fo2) = o;
          o.x = cvtpk(Rt[0], Rt[1]); o.y = cvtpk(Rt[2], Rt[3]); *(u32x2*)(slot + SC_RF + fo2) = o;
          o.x = cvtpk(Bt[0], Bt[1]); o.y = cvtpk(Bt[2], Bt[3]); *(u32x2*)(slot + SC_BKF + fo2) = o;
          o.x = cvtpk(Kt[0], Kt[1]); o.y = cvtpk(Kt[2], Kt[3]); *(u32x2*)(slot + SC_BKF + 2048 + fo2) = o;
          o.x = cvtpk(Bh[0], Bh[1]); o.y = cvtpk(Bh[2], Bh[3]); *(u32x2*)(sT0 + t * 68 + 16 * i + 4 * q) = o;
          o.x = cvtpk(Kh[0], Kh[1]); o.y = cvtpk(Kh[2], Kh[3]); *(u32x2*)(sT1 + t * 68 + 16 * i + 4 * q) = o;
        }
        __builtin_amdgcn_sched_barrier(0);
        cs += __shfl_xor(cs, 16); cs += __shfl_xor(cs, 32);
        if (q == 0) p.cd[((size_t)d * NTOK + m) * 8 + h] = 0.5f * cs;
        wave_lds_fence();
        union { bf16x8 v; uint32_t u[4]; } Afu[2], Bfu[2], Kfu[2], Rfu[2];
#pragma unroll
        for (int ks = 0; ks < 2; ++ks) {
          Afu[ks].v = *(const bf16x8*)(slot + SC_AF + (ks * 64 + lane) * 16);
          Rfu[ks].v = *(const bf16x8*)(slot + SC_RF + (ks * 64 + lane) * 16);
          Bfu[ks].v = *(const bf16x8*)(slot + SC_BKF + (ks * 64 + lane) * 16);
          Kfu[ks].v = *(const bf16x8*)(slot + SC_BKF + 2048 + (ks * 64 + lane) * 16);
        }
        wave_lds_fence();
        f32x4 Lab = MFMA16(Afu[1].v, Bfu[1].v, MFMA16(Afu[0].v, Bfu[0].v, z4));
        f32x4 LakT = MFMA16(Kfu[1].v, Afu[1].v, MFMA16(Kfu[0].v, Afu[0].v, z4));
        f32x4 MrbT = MFMA16(Bfu[1].v, Rfu[1].v, MFMA16(Bfu[0].v, Rfu[0].v, z4));
        f32x4 MrkT = MFMA16(Kfu[1].v, Rfu[1].v, MFMA16(Kfu[0].v, Rfu[0].v, z4));
#pragma unroll
        for (int e = 0; e < 4; ++e) {
          const int row = 4 * q + e;
          if (!(t < row)) Lab[e] = 0.f;
          if (!(row < t)) LakT[e] = 0.f;
          if (!(row <= t)) { MrbT[e] = 0.f; MrkT[e] = 0.f; }
        }
        *(f32x4*)(LT + t * 16 + 4 * q) = Lab;
        {
          union { bf16x8 v; uint32_t u[4]; } f;
          f.u[0] = 0u; f.u[1] = 0u; f.u[2] = cvtpk(LakT[0], LakT[1]); f.u[3] = cvtpk(LakT[2], LakT[3]);
          *(bf16x8*)(slot + SC_LAK + lane * 16) = f.v;
          f.u[0] = cvtpk(MrbT[0], MrbT[1]); f.u[1] = cvtpk(MrbT[2], MrbT[3]); f.u[2] = cvtpk(MrkT[0], MrkT[1]); f.u[3] = cvtpk(MrkT[2], MrkT[3]);
          *(bf16x8*)(slot + SC_MRK + lane * 16) = f.v;
        }
        wave_lds_fence();
        {
          float x[16];
#pragma unroll
          for (int c = 15; c >= 0; --c) {
            float acc = (c == t) ? 1.f : 0.f;
            asm volatile("" ::: "memory");
#pragma unroll
            for (int s2 = c + 1; s2 < 16; ++s2) acc += x[s2] * LT[c * 16 + s2];
            x[c] = acc;
          }
          float s0 = q == 0 ? x[0] : q == 1 ? x[4] : q == 2 ? x[8] : x[12];
          float s1 = q == 0 ? x[1] : q == 1 ? x[5] : q == 2 ? x[9] : x[13];
          float s2_ = q == 0 ? x[2] : q == 1 ? x[6] : q == 2 ? x[10] : x[14];
          float s3 = q == 0 ? x[3] : q == 1 ? x[7] : q == 2 ? x[11] : x[15];
          union { bf16x8 v; uint32_t u[4]; } f;
          f.u[0] = cvtpk(s0, s1); f.u[1] = cvtpk(s2_, s3); f.u[2] = 0u; f.u[3] = 0u;
          *(bf16x8*)(slot + SC_TM + lane * 16) = f.v;
        }
#pragma unroll
        for (int i = 0; i < 4; ++i) {
          uint32_t b0 = sT0[(4 * q + 0) * 68 + 16 * i + t], b1 = sT0[(4 * q + 1) * 68 + 16 * i + t];
          uint32_t b2 = sT0[(4 * q + 2) * 68 + 16 * i + t], b3 = sT0[(4 * q + 3) * 68 + 16 * i + t];
          uint32_t k0 = sT1[(4 * q + 0) * 68 + 16 * i + t], k1 = sT1[(4 * q + 1) * 68 + 16 * i + t];
          uint32_t k2 = sT1[(4 * q + 2) * 68 + 16 * i + t], k3 = sT1[(4 * q + 3) * 68 + 16 * i + t];
          u32x4 o; o.x = b0 | (b1 << 16); o.y = b2 | (b3 << 16); o.z = k0 | (k1 << 16); o.w = k2 | (k3 << 16);
          *(u32x4*)(slot + SC_BKF + (i * 64 + lane) * 16) = o;
        }
      }
      if (g + HH < ngroups) {
        const int st = ((g + HH) * 4 + wave) * 16 + t;
        const int tt = d ? T - 1 - st : st;
        SCAN_LOAD_RAW(mbase + tt);
      }
      __syncthreads();
      {
        char* dst = ring + (size_t)(g % SCAN_R) * SCAN_GROUP_BYTES;
        const __amdgpu_buffer_rsrc_t rs = __builtin_amdgcn_make_buffer_rsrc(dst, 0, SCAN_GROUP_BYTES, 0x00020000);
        for (int i = tid; i < SCAN_GROUP_BYTES / 16; i += NTHR) __builtin_amdgcn_raw_buffer_store_b128(*(const u32x4*)(smem + i * 16), rs, (unsigned)(i * 16), 0,   16);
        asm volatile("s_waitcnt vmcnt(0)" ::: "memory");
        __syncthreads();
        if (tid == 0) __hip_atomic_store(ready + g, 1u, __ATOMIC_RELAXED, __HIP_MEMORY_SCOPE_AGENT);
      }
    }
  } else {
    f32x4 Zt[4];
#pragma unroll
    for (int i = 0; i < 4; ++i) Zt[i] = z4;
    __shared__ int sc_ok;
    u32x4 pre[14];
#define SCAN_SLOT_LOAD(G_) { const __amdgpu_buffer_rsrc_t rs_ = __builtin_amdgcn_make_buffer_rsrc(ring + (size_t)((G_) % SCAN_R) * SCAN_GROUP_BYTES, 0, SCAN_GROUP_BYTES, 0x00020000); \
      _Pragma("unroll") for (int i = 0; i < 14; ++i) { const int c = tid + 256 * i; if (c < SCAN_GROUP_BYTES / 16) pre[i] = __builtin_amdgcn_raw_buffer_load_b128(rs_, (unsigned)(c * 16), 0,   16); } }
#define SCAN_WAIT_READY(G_) { if (tid == 0) { unsigned sp = 0; while (__hip_atomic_load(ready + (G_), __ATOMIC_RELAXED, __HIP_MEMORY_SCOPE_AGENT) == 0u) { __builtin_amdgcn_s_sleep(2); if (++sp > SCAN_SPIN_CAP) break; } } __syncthreads(); }
    SCAN_WAIT_READY(0);
    SCAN_SLOT_LOAD(0);
    bool have = true;
    if (tid == 0) sc_ok = (ngroups > 1) && (__hip_atomic_load(ready + 1, __ATOMIC_RELAXED, __HIP_MEMORY_SCOPE_AGENT) != 0u);
    __syncthreads();
    bool ok1 = sc_ok != 0;
    for (int g = 0; g < ngroups; ++g) {
      if (!have) { SCAN_WAIT_READY(g); SCAN_SLOT_LOAD(g); }
#pragma unroll
      for (int i = 0; i < 14; ++i) { const int c = tid + 256 * i; if (c < SCAN_GROUP_BYTES / 16) *(u32x4*)(smem + c * 16) = pre[i]; }
      __syncthreads();
      have = (g + 1 < ngroups) && ok1;
      if (have) SCAN_SLOT_LOAD(g + 1);
      unsigned fl2 = 0u;
      if (tid == 0 && g + 2 < ngroups) fl2 = __hip_atomic_load(ready + g + 2, __ATOMIC_RELAXED, __HIP_MEMORY_SCOPE_AGENT);
#pragma unroll 1
      for (int cs_ = 0; cs_ < 4; ++cs_) {
        const char* slot = smem + cs_ * SC_CHUNK_BYTES;
        bf16x8 Zb[2];
        Zb[0] = mk_frag(Zt[0], Zt[1]); Zb[1] = mk_frag(Zt[2], Zt[3]);
        const u32x2 vm = *(const u32x2*)(slot + SC_VMF + (wave * 64 + lane) * 8);
        union { bf16x8 v; uint32_t u[4]; } VB, XB, UB;
        VB.u[0] = 0u; VB.u[1] = 0u; VB.u[2] = vm.x; VB.u[3] = vm.y;
        const bf16x8 af0 = *(const bf16x8*)(slot + SC_AF + lane * 16), af1 = *(const bf16x8*)(slot + SC_AF + (64 + lane) * 16);
        const bf16x8 rf0 = *(const bf16x8*)(slot + SC_RF + lane * 16), rf1 = *(const bf16x8*)(slot + SC_RF + (64 + lane) * 16);
        const bf16x8 lakf = *(const bf16x8*)(slot + SC_LAK + lane * 16);
        const bf16x8 tmf = *(const bf16x8*)(slot + SC_TM + lane * 16);
        const bf16x8 mrkf = *(const bf16x8*)(slot + SC_MRK + lane * 16);
        f32x4 X = MFMA16(lakf, VB.v, z4);
        X = MFMA16(af0, Zb[0], X);
        X = MFMA16(af1, Zb[1], X);
        XB.u[0] = cvtpk(X[0], X[1]); XB.u[1] = cvtpk(X[2], X[3]); XB.u[2] = vm.x; XB.u[3] = vm.y;
        f32x4 U = MFMA16(tmf, XB.v, z4);
        UB.u[0] = cvtpk(U[0], U[1]); UB.u[1] = cvtpk(U[2], U[3]); UB.u[2] = vm.x; UB.u[3] = vm.y;
        f32x4 Y = MFMA16(rf0, Zb[0], z4);
        Y = MFMA16(rf1, Zb[1], Y);
        Y = MFMA16(mrkf, UB.v, Y);
#pragma unroll
        for (int i = 0; i < 4; ++i) {
          const f32x4 gc = *(const f32x4*)(slot + SC_GC + (16 * i + 4 * q) * 4);
          const bf16x8 bk = *(const bf16x8*)(slot + SC_BKF + (i * 64 + lane) * 16);
          f32x4 init; init[0] = gc[0] * Zt[i][0]; init[1] = gc[1] * Zt[i][1]; init[2] = gc[2] * Zt[i][2]; init[3] = gc[3] * Zt[i][3];
          Zt[i] = MFMA16(bk, UB.v, init);
        }
#pragma unroll
        for (int e = 0; e < 4; ++e) {
          const int st = (g * 4 + cs_) * 16 + 4 * q + e;
          const int tt = d ? T - 1 - st : st;
          p.yd[((size_t)d * NTOK + mbase + tt) * 512 + h * 64 + 16 * wave + t] = f2bf(Y[e]);
        }
      }
      if (tid == 0) { sc_ok = (fl2 != 0u); __hip_atomic_store(progress, (unsigned)(g + 1), __ATOMIC_RELAXED, __HIP_MEMORY_SCOPE_AGENT); }
      __syncthreads();
      ok1 = sc_ok != 0;
    }
  }
  __syncthreads();
}

__device__ void phase_attn(const P& p, char* smem) {
  bf16_t* Ks = (bf16_t*)smem;
  bf16_t* Vs = (bf16_t*)(smem + 64 * 144);
  __shared__ int item_s;
  const int tid = threadIdx.x, lane = tid & 63, wave = tid >> 6, l31 = lane & 31, h = lane >> 5;
  bf16_t* Qw = (bf16_t*)(smem + 36864) + wave * 4608;
  for (;;) {
    __syncthreads();
    if (tid == 0) item_s = atomicAdd(p.ctr, 1);
    __syncthreads();
    const int item = item_s;
    if (item >= 1024) break;
    int mbase, T, kvh, tile;
    if (item < 512) { int bs = item >> 8; kvh = (item >> 7) & 1; tile = item & 127; T = 8192; mbase = 16384 + bs * 8192; }
    else { int it = item - 512; int b = it >> 7; kvh = (it >> 6) & 1; tile = it & 63; T = 4096; mbase = b * 4096; }
    const int hq = kvh * 4 + wave;
    const int mq0 = mbase + tile * 64;
    {
      const bf16_t* qsrc = p.proj + (size_t)mq0 * DIN + 1920 + hq * 64;
#pragma unroll
      for (int jj = 0; jj < 8; ++jj) {
        const int c = lane + 64 * jj, r = c >> 3, ch = c & 7;
        *(u32x4*)(Qw + r * 72 + ch * 8) = *(const u32x4*)(qsrc + (size_t)r * DIN + ch * 8);
      }
    }
    f32x16 O[2][2];
#pragma unroll
    for (int qs = 0; qs < 2; ++qs)
#pragma unroll
      for (int dt = 0; dt < 2; ++dt)
#pragma unroll
        for (int i = 0; i < 16; ++i) O[qs][dt][i] = 0.f;
    float mrun[2] = {-1e30f, -1e30f};
    f32x2 lsum2[2] = {(f32x2){0.f, 0.f}, (f32x2){0.f, 0.f}};
    const bf16_t* Kg = p.Kc + ((size_t)kvh * NTOK + mbase) * 64;
    const bf16_t* Vg = p.Vt + (size_t)(kvh * 64) * NTOK + mbase;
    u32x4 rk[2], rv[2];
    const int nt = T / 64;
    const int tr = tid >> 3, tch = tid & 7;
    const bf16_t* kp0 = Kg + tr * 64 + tch * 8;
    const bf16_t* vp0 = Vg + (size_t)tr * NTOK + tch * 8;
    const int vpos = (tch >> 1) * 16 + (tch & 1) * 4;
#define ATT_LOAD(KT) { rk[0] = *(const u32x4*)(kp0 + (size_t)(KT) * 4096); rk[1] = *(const u32x4*)(kp0 + (size_t)(KT) * 4096 + 32 * 64); \
        rv[0] = *(const u32x4*)(vp0 + (KT) * 64); rv[1] = *(const u32x4*)(vp0 + (size_t)32 * NTOK + (KT) * 64); }
#define ATT_STORE(BUF) { bf16_t* Kd = Ks + (BUF) * 9216; bf16_t* Vd = Vs + (BUF) * 9216; _Pragma("unroll") for (int jj = 0; jj < 2; ++jj) { const int r = tr + 32 * jj; \
        *(u32x4*)(Kd + r * 72 + tch * 8) = rk[jj]; *(u32x2*)(Vd + r * 72 + vpos) = (u32x2){rv[jj].x, rv[jj].y}; *(u32x2*)(Vd + r * 72 + vpos + 8) = (u32x2){rv[jj].z, rv[jj].w}; } }
    ATT_LOAD(0);
    ATT_STORE(0);
    if (nt > 1) ATT_LOAD(1);
    __syncthreads();
    for (int kt = 0; kt < nt; ++kt) {
      const int buf = kt & 1;
      if (kt + 1 < nt) ATT_STORE(buf ^ 1);
      if (kt + 2 < nt) ATT_LOAD(kt + 2);
      __builtin_amdgcn_sched_barrier(0);
      const bf16_t* Kb = Ks + buf * 9216;
      const bf16_t* Vb = Vs + buf * 9216;
      f32x16 S[2][2];
#pragma unroll
      for (int qs = 0; qs < 2; ++qs)
#pragma unroll
        for (int i = 0; i < 16; ++i) { S[qs][0][i] = 0.f; S[qs][1][i] = 0.f; }
#pragma unroll
      for (int ks = 0; ks < 4; ++ks) {
        const bf16x8 a0 = *(const bf16x8*)(Kb + l31 * 72 + ks * 16 + h * 8);
        const bf16x8 a1 = *(const bf16x8*)(Kb + (32 + l31) * 72 + ks * 16 + h * 8);
        const bf16x8 q0 = *(const bf16x8*)(Qw + l31 * 72 + ks * 16 + h * 8);
        const bf16x8 q1 = *(const bf16x8*)(Qw + (32 + l31) * 72 + ks * 16 + h * 8);
        S[0][0] = __builtin_amdgcn_mfma_f32_32x32x16_bf16(a0, q0, S[0][0], 0, 0, 0);
        S[0][1] = __builtin_amdgcn_mfma_f32_32x32x16_bf16(a1, q0, S[0][1], 0, 0, 0);
        S[1][0] = __builtin_amdgcn_mfma_f32_32x32x16_bf16(a0, q1, S[1][0], 0, 0, 0);
        S[1][1] = __builtin_amdgcn_mfma_f32_32x32x16_bf16(a1, q1, S[1][1], 0, 0, 0);
      }
      union { bf16x8 v; uint32_t u[4]; } Pf[2][4];
#pragma unroll
      for (int qs = 0; qs < 2; ++qs) {
        float mx = fmaxf(fmaxf(S[qs][0][0], S[qs][0][1]), S[qs][0][2]);
#pragma unroll
        for (int i = 3; i < 15; i += 2) mx = fmaxf(fmaxf(mx, S[qs][0][i]), S[qs][0][i + 1]);
        mx = fmaxf(fmaxf(mx, S[qs][0][15]), S[qs][1][0]);
#pragma unroll
        for (int i = 1; i < 15; i += 2) mx = fmaxf(fmaxf(mx, S[qs][1][i]), S[qs][1][i + 1]);
        mx = fmaxf(mx, S[qs][1][15]);
        if (__any(mx > mrun[qs] + 8.f)) {
          mx = fmaxf(mx, __shfl_xor(mx, 32));
          const float mnew = fmaxf(mrun[qs], mx);
          const float alpha = __builtin_amdgcn_exp2f(mrun[qs] - mnew);
          mrun[qs] = mnew;
          lsum2[qs] *= alpha;
          O[qs][0] *= alpha; O[qs][1] *= alpha;
        }
        const f32x2 mm = (f32x2){mrun[qs], mrun[qs]};
#pragma unroll
        for (int i = 0; i < 8; ++i) {
          const f32x2 v0 = (f32x2){S[qs][0][2 * i], S[qs][0][2 * i + 1]} - mm;
          const float e0 = __builtin_amdgcn_exp2f(v0.x), e1 = __builtin_amdgcn_exp2f(v0.y);
          lsum2[qs] += (f32x2){e0, e1};
          Pf[qs][i >> 2].u[i & 3] = cvtpk(e0, e1);
          const f32x2 v1 = (f32x2){S[qs][1][2 * i], S[qs][1][2 * i + 1]} - mm;
          const float g0 = __builtin_amdgcn_exp2f(v1.x), g1 = __builtin_amdgcn_exp2f(v1.y);
          lsum2[qs] += (f32x2){g0, g1};
          Pf[qs][2 + (i >> 2)].u[i & 3] = cvtpk(g0, g1);
        }
      }
#pragma unroll
      for (int sidx = 0; sidx < 4; ++sidx) {
        const bf16x8 A0 = *(const bf16x8*)(Vb + l31 * 72 + sidx * 16 + h * 8);
        const bf16x8 A1 = *(const bf16x8*)(Vb + (32 + l31) * 72 + sidx * 16 + h * 8);
        O[0][0] = __builtin_amdgcn_mfma_f32_32x32x16_bf16(A0, Pf[0][sidx].v, O[0][0], 0, 0, 0);
        O[0][1] = __builtin_amdgcn_mfma_f32_32x32x16_bf16(A1, Pf[0][sidx].v, O[0][1], 0, 0, 0);
        O[1][0] = __builtin_amdgcn_mfma_f32_32x32x16_bf16(A0, Pf[1][sidx].v, O[1][0], 0, 0, 0);
        O[1][1] = __builtin_amdgcn_mfma_f32_32x32x16_bf16(A1, Pf[1][sidx].v, O[1][1], 0, 0, 0);
      }
      __syncthreads();
    }
    const float* g = p.ao_g + hq * 64;
#pragma unroll
    for (int qs = 0; qs < 2; ++qs) {
      float lsum = lsum2[qs].x + lsum2[qs].y;
      lsum += __shfl_xor(lsum, 32);
      const float inv = 1.f / lsum;
      float ss = 0.f;
#pragma unroll
      for (int i = 0; i < 16; ++i) { O[qs][0][i] *= inv; O[qs][1][i] *= inv; ss += O[qs][0][i] * O[qs][0][i] + O[qs][1][i] * O[qs][1][i]; }
      ss += __shfl_xor(ss, 32);
      const float rs = rsqrtf(ss * (1.f / 64.f) + 1e-6f);
      bf16_t* qrow = p.proj + (size_t)(mq0 + qs * 32 + l31) * DIN + 1920 + hq * 64;
#pragma unroll
      for (int dt = 0; dt < 2; ++dt)
#pragma unroll
        for (int gq = 0; gq < 4; ++gq) {
          const int d0 = dt * 32 + gq * 8 + h * 4;
          const f32x4 gg = *(const f32x4*)(g + d0);
          const float v0 = O[qs][dt][gq * 4 + 0] * rs * gg[0], v1 = O[qs][dt][gq * 4 + 1] * rs * gg[1];
          const float v2 = O[qs][dt][gq * 4 + 2] * rs * gg[2], v3 = O[qs][dt][gq * 4 + 3] * rs * gg[3];
          u32x2 o; o.x = cvtpk(v0, v1); o.y = cvtpk(v2, v3);
          *(u32x2*)(qrow + d0) = o;
        }
    }
  }
  __syncthreads();
}

__device__ void phase_attn_fast(const P& p, char* smem) {
  unsigned char* Ks8 = (unsigned char*)smem;
  bf16_t* Vs = (bf16_t*)(smem + 10240);
  __shared__ int item_s;
  const int tid = threadIdx.x, lane = tid & 63, wave = tid >> 6, l31 = lane & 31, h = lane >> 5;
  for (;;) {
    __syncthreads();
    if (tid == 0) item_s = atomicAdd(p.ctr, 1);
    __syncthreads();
    const int item = item_s;
    if (item >= 1024) break;
    int mbase, T, kvh, tile;
    if (item < 512) { int bs = item >> 8; kvh = (item >> 7) & 1; tile = item & 127; T = 8192; mbase = 16384 + bs * 8192; }
    else { int it = item - 512; int b = it >> 7; kvh = (it >> 6) & 1; tile = it & 63; T = 4096; mbase = b * 4096; }
    const int hq = kvh * 4 + wave;
    const int mq0 = mbase + tile * 64;
    i32x8 Qf[2];
#pragma unroll
    for (int qs = 0; qs < 2; ++qs) {
      const unsigned char* q8 = p.Q8 + ((size_t)(mq0 + qs * 32 + l31) * 8 + hq) * 64 + h * 32;
      const u32x4 qa = *(const u32x4*)q8, qb = *(const u32x4*)(q8 + 16);
      Qf[qs] = (i32x8){(int)qa.x, (int)qa.y, (int)qa.z, (int)qa.w, (int)qb.x, (int)qb.y, (int)qb.z, (int)qb.w};
    }
    f32x16 O[2][2];
#pragma unroll
    for (int qs = 0; qs < 2; ++qs)
#pragma unroll
      for (int dt = 0; dt < 2; ++dt)
#pragma unroll
        for (int i = 0; i < 16; ++i) O[qs][dt][i] = 0.f;
    float ls0 = 0.f, ls1 = 0.f;
    const unsigned char* kp8 = p.K8 + ((size_t)kvh * NTOK + mbase + (tid >> 2)) * 64 + (tid & 3) * 16;
    const bf16_t* Vg = p.Vt + (size_t)(kvh * 64) * NTOK + mbase;
    u32x4 rk8, rv[2];
    const int nt = T / 64;
    const int tr = tid >> 3, tch = tid & 7;
    const bf16_t* vp0 = Vg + (size_t)tr * NTOK + tch * 8;
    const int vpos = (tch >> 1) * 16 + (tch & 1) * 4;
#define ATF_LOAD(KT) { rk8 = *(const u32x4*)(kp8 + (size_t)(KT) * 4096); \
        rv[0] = *(const u32x4*)(vp0 + (KT) * 64); rv[1] = *(const u32x4*)(vp0 + (size_t)32 * NTOK + (KT) * 64); }
#define ATF_STORE(BUF) { *(u32x4*)(Ks8 + (BUF) * 5120 + (tid >> 2) * 80 + (tid & 3) * 16) = rk8; \
        bf16_t* Vd = Vs + (BUF) * 4608; _Pragma("unroll") for (int jj = 0; jj < 2; ++jj) { const int r = tr + 32 * jj; \
        *(u32x2*)(Vd + r * 72 + vpos) = (u32x2){rv[jj].x, rv[jj].y}; *(u32x2*)(Vd + r * 72 + vpos + 8) = (u32x2){rv[jj].z, rv[jj].w}; } }
    ATF_LOAD(0);
    ATF_STORE(0);
    if (nt > 1) ATF_LOAD(1);
    __syncthreads();
    for (int kt = 0; kt < nt; ++kt) {
      const int buf = kt & 1;
      if (kt + 1 < nt) ATF_STORE(buf ^ 1);
      if (kt + 2 < nt) ATF_LOAD(kt + 2);
      __builtin_amdgcn_sched_barrier(0);
      const unsigned char* Kb = Ks8 + buf * 5120;
      const bf16_t* Vb = Vs + buf * 4608;
      f32x16 S[2][2];
      {
        f32x16 zero16;
#pragma unroll
        for (int i = 0; i < 16; ++i) zero16[i] = 0.f;
#pragma unroll
        for (int ksub = 0; ksub < 2; ++ksub) {
          const u32x4 ka = *(const u32x4*)(Kb + (ksub * 32 + l31) * 80 + h * 32), kb = *(const u32x4*)(Kb + (ksub * 32 + l31) * 80 + h * 32 + 16);
          const i32x8 A8 = (i32x8){(int)ka.x, (int)ka.y, (int)ka.z, (int)ka.w, (int)kb.x, (int)kb.y, (int)kb.z, (int)kb.w};
          S[0][ksub] = __builtin_amdgcn_mfma_scale_f32_32x32x64_f8f6f4(A8, Qf[0], zero16, 0, 0, 0, 0x7F7F7F7F, 0, 0x7C7C7C7C);
          S[1][ksub] = __builtin_amdgcn_mfma_scale_f32_32x32x64_f8f6f4(A8, Qf[1], zero16, 0, 0, 0, 0x7F7F7F7F, 0, 0x7C7C7C7C);
        }
      }
      union { bf16x8 v; uint32_t u[4]; } Pf[2][4];
#define ATT_EXP(QS, LS) { _Pragma("unroll") for (int i = 0; i < 8; ++i) { \
          const float e0 = __builtin_amdgcn_exp2f(S[QS][0][2 * i]), e1 = __builtin_amdgcn_exp2f(S[QS][0][2 * i + 1]); \
          const float g0 = __builtin_amdgcn_exp2f(S[QS][1][2 * i]), g1 = __builtin_amdgcn_exp2f(S[QS][1][2 * i + 1]); \
          const uint32_t pe_ = cvtpk(e0, e1), pg_ = cvtpk(g0, g1); \
          LS = dot2bf(pg_, 0x3f803f80u, dot2bf(pe_, 0x3f803f80u, LS));     \
          Pf[QS][i >> 2].u[i & 3] = pe_; Pf[QS][2 + (i >> 2)].u[i & 3] = pg_; } }
      ATT_EXP(0, ls0); ATT_EXP(1, ls1);
#pragma unroll
      for (int sidx = 0; sidx < 4; ++sidx) {
        const bf16x8 A0 = *(const bf16x8*)(Vb + l31 * 72 + sidx * 16 + h * 8);
        const bf16x8 A1 = *(const bf16x8*)(Vb + (32 + l31) * 72 + sidx * 16 + h * 8);
        O[0][0] = __builtin_amdgcn_mfma_f32_32x32x16_bf16(A0, Pf[0][sidx].v, O[0][0], 0, 0, 0);
        O[0][1] = __builtin_amdgcn_mfma_f32_32x32x16_bf16(A1, Pf[0][sidx].v, O[0][1], 0, 0, 0);
        O[1][0] = __builtin_amdgcn_mfma_f32_32x32x16_bf16(A0, Pf[1][sidx].v, O[1][0], 0, 0, 0);
        O[1][1] = __builtin_amdgcn_mfma_f32_32x32x16_bf16(A1, Pf[1][sidx].v, O[1][1], 0, 0, 0);
      }
      __syncthreads();
    }
    const float* g = p.ao_g + hq * 64;
#pragma unroll
    for (int qs = 0; qs < 2; ++qs) {
      float lsum = qs ? ls1 : ls0;
      lsum += __shfl_xor(lsum, 32);
      const float inv = 1.f / lsum;
      float ss = 0.f;
#pragma unroll
      for (int i = 0; i < 16; ++i) { O[qs][0][i] *= inv; O[qs][1][i] *= inv; ss += O[qs][0][i] * O[qs][0][i] + O[qs][1][i] * O[qs][1][i]; }
      ss += __shfl_xor(ss, 32);
      const float rs = rsqrtf(ss * (1.f / 64.f) + 1e-6f);
      bf16_t* qrow = p.proj + (size_t)(mq0 + qs * 32 + l31) * DIN + 1920 + hq * 64;
#pragma unroll
      for (int dt = 0; dt < 2; ++dt)
#pragma unroll
        for (int gq = 0; gq < 4; ++gq) {
          const int d0 = dt * 32 + gq * 8 + h * 4;
          const f32x4 gg = *(const f32x4*)(g + d0);
          const float v0 = O[qs][dt][gq * 4 + 0] * rs * gg[0], v1 = O[qs][dt][gq * 4 + 1] * rs * gg[1];
          const float v2 = O[qs][dt][gq * 4 + 2] * rs * gg[2], v3 = O[qs][dt][gq * 4 + 3] * rs * gg[3];
          u32x2 o; o.x = cvtpk(v0, v1); o.y = cvtpk(v2, v3);
          *(u32x2*)(qrow + d0) = o;
        }
    }
  }
  __syncthreads();
}

__device__ void phase_attn_f8(const P& p, char* smem, const float coff) {
  unsigned char* Ks8 = (unsigned char*)smem;
  unsigned char* Vs8 = (unsigned char*)smem + 10240;
  __shared__ int item_s;
  const int tid = threadIdx.x, lane = tid & 63, wave = tid >> 6, l31 = lane & 31, h = lane >> 5;
  for (;;) {
    __syncthreads();
    if (tid == 0) item_s = atomicAdd(p.ctr, 1);
    __syncthreads();
    const int item = item_s;
    if (item >= 1024) break;
    int mbase, T, kvh, tile;
    if (item < 512) { int bs = item >> 8; kvh = (item >> 7) & 1; tile = item & 127; T = 8192; mbase = 16384 + bs * 8192; }
    else { int it = item - 512; int b = it >> 7; kvh = (it >> 6) & 1; tile = it & 63; T = 4096; mbase = b * 4096; }
    const int hq = kvh * 4 + wave;
    const int mq0 = mbase + tile * 64;
    i32x8 Qf[2];
#pragma unroll
    for (int qs = 0; qs < 2; ++qs) {
      const unsigned char* q8 = p.Q8 + ((size_t)(mq0 + qs * 32 + l31) * 8 + hq) * 64 + h * 32;
      const u32x4 qa = *(const u32x4*)q8, qb = *(const u32x4*)(q8 + 16);
      Qf[qs] = (i32x8){(int)qa.x, (int)qa.y, (int)qa.z, (int)qa.w, (int)qb.x, (int)qb.y, (int)qb.z, (int)qb.w};
    }
    f32x16 O[2][2], L[2];
#pragma unroll
    for (int qs = 0; qs < 2; ++qs) {
#pragma unroll
      for (int i = 0; i < 16; ++i) { O[qs][0][i] = 0.f; O[qs][1][i] = 0.f; L[qs][i] = 0.f; }
    }
    f32x16 cinit;
#pragma unroll
    for (int i = 0; i < 16; ++i) cinit[i] = -coff;
    const i32x8 ones8 = (i32x8){0x38383838, 0x38383838, 0x38383838, 0x38383838, 0x38383838, 0x38383838, 0x38383838, 0x38383838};
    const unsigned char* kp8 = p.K8 + ((size_t)kvh * NTOK + mbase + (tid >> 2)) * 64 + (tid & 3) * 16;
    const unsigned char* vp8 = p.V8t + (size_t)(kvh * 64 + (tid >> 2)) * NTOK + mbase + (tid & 3) * 16;
    u32x4 rk8, rv8;
    const int nt = T / 64;
#define AT8_LOAD(KT) { rk8 = *(const u32x4*)(kp8 + (size_t)(KT) * 4096); rv8 = *(const u32x4*)(vp8 + (KT) * 64); }
#define AT8_STORE(BUF) { *(u32x4*)(Ks8 + (BUF) * 5120 + (tid >> 2) * 80 + (tid & 3) * 16) = rk8; *(u32x4*)(Vs8 + (BUF) * 5120 + (tid >> 2) * 80 + (tid & 3) * 16) = rv8; }
    AT8_LOAD(0);
    AT8_STORE(0);
    if (nt > 1) AT8_LOAD(1);
    __syncthreads();
    for (int kt = 0; kt < nt; ++kt) {
      const int buf = kt & 1;
      if (kt + 1 < nt) AT8_STORE(buf ^ 1);
      if (kt + 2 < nt) AT8_LOAD(kt + 2);
      __builtin_amdgcn_sched_barrier(0);
      const unsigned char* Kb = Ks8 + buf * 5120;
      const unsigned char* Vb = Vs8 + buf * 5120;
      i32x8 Ak[2];
#pragma unroll
      for (int ksub = 0; ksub < 2; ++ksub) {
        const u32x4 ka = *(const u32x4*)(Kb + (ksub * 32 + l31) * 80 + h * 32), kb = *(const u32x4*)(Kb + (ksub * 32 + l31) * 80 + h * 32 + 16);
        Ak[ksub] = (i32x8){(int)ka.x, (int)ka.y, (int)ka.z, (int)ka.w, (int)kb.x, (int)kb.y, (int)kb.z, (int)kb.w};
      }
      i32x8 Pb[2];
#pragma unroll
      for (int qs = 0; qs < 2; ++qs) {
        const f32x16 S0 = __builtin_amdgcn_mfma_scale_f32_32x32x64_f8f6f4(Ak[0], Qf[qs], cinit, 0, 0, 0, 0x7F7F7F7F, 0, 0x7C7C7C7C);
        const f32x16 S1 = __builtin_amdgcn_mfma_scale_f32_32x32x64_f8f6f4(Ak[1], Qf[qs], cinit, 0, 0, 0, 0x7F7F7F7F, 0, 0x7C7C7C7C);
#pragma unroll
        for (int u = 0; u < 4; ++u) {
          const float e0 = __builtin_amdgcn_exp2f(S0[4 * u]), e1 = __builtin_amdgcn_exp2f(S0[4 * u + 1]), e2 = __builtin_amdgcn_exp2f(S0[4 * u + 2]), e3 = __builtin_amdgcn_exp2f(S0[4 * u + 3]);
          const float g0 = __builtin_amdgcn_exp2f(S1[4 * u]), g1 = __builtin_amdgcn_exp2f(S1[4 * u + 1]), g2 = __builtin_amdgcn_exp2f(S1[4 * u + 2]), g3 = __builtin_amdgcn_exp2f(S1[4 * u + 3]);
          Pb[qs][u] = __builtin_amdgcn_cvt_pk_fp8_f32(e2, e3, __builtin_amdgcn_cvt_pk_fp8_f32(e0, e1, 0, false), true);
          Pb[qs][4 + u] = __builtin_amdgcn_cvt_pk_fp8_f32(g2, g3, __builtin_amdgcn_cvt_pk_fp8_f32(g0, g1, 0, false), true);
        }
      }
#pragma unroll
      for (int dt = 0; dt < 2; ++dt) {
        const u32x4 va = *(const u32x4*)(Vb + (dt * 32 + l31) * 80 + h * 32), vb_ = *(const u32x4*)(Vb + (dt * 32 + l31) * 80 + h * 32 + 16);
        const i32x8 Av = (i32x8){(int)va.x, (int)va.y, (int)va.z, (int)va.w, (int)vb_.x, (int)vb_.y, (int)vb_.z, (int)vb_.w};
        O[0][dt] = __builtin_amdgcn_mfma_scale_f32_32x32x64_f8f6f4(Av, Pb[0], O[0][dt], 0, 0, 0, 0x7F7F7F7F, 0, 0x7F7F7F7F);
        O[1][dt] = __builtin_amdgcn_mfma_scale_f32_32x32x64_f8f6f4(Av, Pb[1], O[1][dt], 0, 0, 0, 0x7F7F7F7F, 0, 0x7F7F7F7F);
      }
      L[0] = __builtin_amdgcn_mfma_scale_f32_32x32x64_f8f6f4(ones8, Pb[0], L[0], 0, 0, 0, 0x7F7F7F7F, 0, 0x7F7F7F7F);
      L[1] = __builtin_amdgcn_mfma_scale_f32_32x32x64_f8f6f4(ones8, Pb[1], L[1], 0, 0, 0, 0x7F7F7F7F, 0, 0x7F7F7F7F);
      __syncthreads();
    }
    const float* g = p.ao_g + hq * 64;
#pragma unroll
    for (int qs = 0; qs < 2; ++qs) {
      const float inv = 1.f / L[qs][0];
      float ss = 0.f;
#pragma unroll
      for (int i = 0; i < 16; ++i) { O[qs][0][i] *= inv; O[qs][1][i] *= inv; ss += O[qs][0][i] * O[qs][0][i] + O[qs][1][i] * O[qs][1][i]; }
      ss += __shfl_xor(ss, 32);
      const float rs = rsqrtf(ss * (1.f / 64.f) + 1e-6f);
      bf16_t* qrow = p.proj + (size_t)(mq0 + qs * 32 + l31) * DIN + 1920 + hq * 64;
#pragma unroll
      for (int dt = 0; dt < 2; ++dt)
#pragma unroll
        for (int gq = 0; gq < 4; ++gq) {
          const int d0 = dt * 32 + gq * 8 + h * 4;
          const f32x4 gg = *(const f32x4*)(g + d0);
          const float v0 = O[qs][dt][gq * 4 + 0] * rs * gg[0], v1 = O[qs][dt][gq * 4 + 1] * rs * gg[1];
          const float v2 = O[qs][dt][gq * 4 + 2] * rs * gg[2], v3 = O[qs][dt][gq * 4 + 3] * rs * gg[3];
          u32x2 o; o.x = cvtpk(v0, v1); o.y = cvtpk(v2, v3);
          *(u32x2*)(qrow + d0) = o;
        }
    }
  }
  __syncthreads();
}

__device__ void phase_post(const P& p, char* smem) {
  bf16_t* As = (bf16_t*)smem;
  bf16_t* Bs = (bf16_t*)(smem + 34816);
  const int tid = threadIdx.x, lane = tid & 63, wave = tid >> 6, wr = wave >> 1, wc = wave & 1, q4 = lane >> 4;
  for (int item = blockIdx.x; item < 1024; item += gridDim.x) {
    const int m0 = (item >> 2) * 128, n0 = (item & 3) * 128;
    __syncthreads();
#pragma unroll
    for (int j = 0; j < 8; ++j) {
      const int c = tid + 256 * j, row = c >> 4, kc = c & 15;
      const int m = m0 + row; int bb, t, T; tok_info(m, bb, t, T);
      const bf16_t* q = p.proj + (size_t)m * DIN + 1792 + kc * 8;
      const u32x4 cc = *(const u32x4*)q;
      u32x4 pv = (u32x4){0u, 0u, 0u, 0u}, nx = (u32x4){0u, 0u, 0u, 0u};
      if (t > 0) pv = *(const u32x4*)(q - DIN);
      if (t < T - 1) nx = *(const u32x4*)(q + DIN);
      const f32x4 mu0 = *(const f32x4*)(p.mu + 1792 + kc * 8), mu1 = *(const f32x4*)(p.mu + 1792 + kc * 8 + 4);
      u32x4 o;
#pragma unroll
      for (int w = 0; w < 4; ++w) {
        const float c0 = bflo(cc[w]), c1 = bfhi(cc[w]);
        const float m_0 = w < 2 ? mu0[2 * w] : mu1[2 * w - 4], m_1 = w < 2 ? mu0[2 * w + 1] : mu1[2 * w - 3];
        const float s0 = c0 + m_0 * (0.5f * (bflo(pv[w]) + bflo(nx[w])) - c0);
        const float s1 = c1 + m_1 * (0.5f * (bfhi(pv[w]) + bfhi(nx[w])) - c1);
        o[w] = cvtpk(__builtin_amdgcn_rcpf(1.f + __expf(-s0)), __builtin_amdgcn_rcpf(1.f + __expf(-s1)));
      }
      *(u32x4*)(As + row * 136 + kc * 8) = o;
      *(u32x4*)(Bs + row * 136 + kc * 8) = *(const u32x4*)(p.g2T + (size_t)(n0 + row) * 128 + kc * 8);
    }
    __syncthreads();
    f32x4 acc[4][4];
#pragma unroll
    for (int i = 0; i < 4; ++i)
#pragma unroll
      for (int j = 0; j < 4; ++j) acc[i][j] = (f32x4){0.f, 0.f, 0.f, 0.f};
#pragma unroll
    for (int ks = 0; ks < 4; ++ks) {
      bf16x8 af[4], bfr[4];
#pragma unroll
      for (int i = 0; i < 4; ++i) af[i] = *(const bf16x8*)(As + (wr * 64 + i * 16 + (lane & 15)) * 136 + ks * 32 + q4 * 8);
#pragma unroll
      for (int j = 0; j < 4; ++j) bfr[j] = *(const bf16x8*)(Bs + (wc * 64 + j * 16 + (lane & 15)) * 136 + ks * 32 + q4 * 8);
#pragma unroll
      for (int i = 0; i < 4; ++i)
#pragma unroll
        for (int j = 0; j < 4; ++j) acc[i][j] = MFMA16(bfr[j], af[i], acc[i][j]);
    }
    const int hd = (n0 >> 6) + wc;
#pragma unroll
    for (int i = 0; i < 4; ++i) {
      const int m = m0 + wr * 64 + i * 16 + (lane & 15);
      const int cb = n0 + wc * 64 + q4 * 4;
      float y[16]; float sum = 0.f;
#pragma unroll
      for (int j = 0; j < 4; ++j) {
        const u32x2 a = *(const u32x2*)(p.yd + (size_t)m * 512 + cb + j * 16);
        const u32x2 b = *(const u32x2*)(p.yd + ((size_t)NTOK + m) * 512 + cb + j * 16);
        y[4 * j] = bflo(a.x) + bflo(b.x); y[4 * j + 1] = bfhi(a.x) + bfhi(b.x); y[4 * j + 2] = bflo(a.y) + bflo(b.y); y[4 * j + 3] = bfhi(a.y) + bfhi(b.y);
        sum += (y[4 * j] + y[4 * j + 1]) + (y[4 * j + 2] + y[4 * j + 3]);
      }
      sum += __shfl_xor(sum, 16); sum += __shfl_xor(sum, 32);
      const float mean = sum * (1.f / 64.f);
      float vs_ = 0.f;
#pragma unroll
      for (int k = 0; k < 16; ++k) { y[k] -= mean; vs_ += y[k] * y[k]; }
      vs_ += __shfl_xor(vs_, 16); vs_ += __shfl_xor(vs_, 32);
      const float rstd = rsqrtf(vs_ * (1.f / 64.f) + 64e-5f);
      const float cc = p.cd[(size_t)m * 8 + hd] + p.cd[((size_t)NTOK + m) * 8 + hd];
#pragma unroll
      for (int j = 0; j < 4; ++j) {
        const int c = cb + j * 16;
        const f32x4 lw = *(const f32x4*)(p.ln_w + c), lb = *(const f32x4*)(p.ln_b + c);
        const u32x2 vv = *(const u32x2*)(p.ps_vwa + (size_t)m * 768 + c);
        const float v0 = bflo(vv.x), v1 = bfhi(vv.x), v2 = bflo(vv.y), v3 = bfhi(vv.y);
        const float o0 = (y[4 * j] * rstd * lw[0] + lb[0] + cc * v0) * acc[i][j][0];
        const float o1 = (y[4 * j + 1] * rstd * lw[1] + lb[1] + cc * v1) * acc[i][j][1];
        const float o2 = (y[4 * j + 2] * rstd * lw[2] + lb[2] + cc * v2) * acc[i][j][2];
        const float o3 = (y[4 * j + 3] * rstd * lw[3] + lb[3] + cc * v3) * acc[i][j][3];
        u32x2 o; o.x = cvtpk(o0, o1); o.y = cvtpk(o2, o3);
        *(u32x2*)(p.proj + (size_t)m * DIN + c) = o;
      }
    }
  }
  __syncthreads();
}

__device__ void phase_convert(const float* src, bf16_t* dst, size_t n) {
  size_t n4 = n / 4;
  for (size_t i = (size_t)blockIdx.x * NTHR + threadIdx.x; i < n4; i += (size_t)gridDim.x * NTHR) {
    float4 v = ((const float4*)src)[i];
    u32x2 o; o.x = pack2(v.x, v.y); o.y = pack2(v.z, v.w);
    ((u32x2*)dst)[i] = o;
  }
}

typedef float v16f __attribute__((ext_vector_type(16)));
typedef float v32f __attribute__((ext_vector_type(32)));
typedef unsigned v6u __attribute__((ext_vector_type(6)));
__device__ void phase_convert8(const P& p) {
  const int wave = threadIdx.x >> 6, lane = threadIdx.x & 63;
  for (int e = blockIdx.x * 4 + wave; e < 16384; e += gridDim.x * 4) {
    const float* src = p.u_tab + (size_t)e * DM + lane * 16;
    f32x4 x[4]; float am = 0.f;
#pragma unroll
    for (int j = 0; j < 4; ++j) { x[j] = *(const f32x4*)(src + 4 * j); am = fmaxf(am, fmaxf(fmaxf(fabsf(x[j][0]), fabsf(x[j][1])), fmaxf(fabsf(x[j][2]), fabsf(x[j][3])))); }
    const float st = bf2f(f2bf(am > 0.f ? am * (1.f / 7.f) : 1.f)), inv4 = 1.f / st;
    uint32_t w0 = 0u, w1 = 0u;
#pragma unroll
    for (int j = 0; j < 4; ++j)
#pragma unroll
      for (int e_ = 0; e_ < 4; ++e_) {
        int q = (int)rintf(x[j][e_] * inv4); q = q > 7 ? 7 : (q < -7 ? -7 : q);
        const uint32_t nb = (uint32_t)(q + 8);
        if (j < 2) w0 |= nb << (4 * (j * 4 + e_)); else w1 |= nb << (4 * ((j - 2) * 4 + e_));
      }
    *(u32x2*)(p.ut4 + (size_t)e * 640 + lane * 8) = (u32x2){w0, w1};
    *(bf16_t*)(p.ut4 + (size_t)e * 640 + 512 + lane * 2) = f2bf(st);
  }
  for (int rp = blockIdx.x * 4 + wave; rp < 8192; rp += gridDim.x * 4) {
    const int e = rp * 2 + (lane >> 5), l32 = lane & 31;
    const float* src = p.v_tab + (size_t)e * DM + l32 * 32;
    f32x4 x[8]; float am = 0.f;
#pragma unroll
    for (int j = 0; j < 8; ++j) { x[j] = *(const f32x4*)(src + 4 * j); am = fmaxf(am, fmaxf(fmaxf(fabsf(x[j][0]), fabsf(x[j][1])), fmaxf(fabsf(x[j][2]), fabsf(x[j][3])))); }
#pragma unroll
    for (int o = 16; o >= 1; o >>= 1) am = fmaxf(am, __shfl_xor(am, o));
    const float step = am > 0.f ? am * (1.f / 6.f) : 1.f, inv = 1.f / step;
    u32x4 w = (u32x4){0u, 0u, 0u, 0u};
#pragma unroll
    for (int j = 0; j < 8; ++j)
#pragma unroll
      for (int c = 0; c < 4; ++c) {
        const float a = x[j][c] * inv, m = fabsf(a);
        const unsigned code = (m < 0.25f ? 0u : m < 0.75f ? 1u : m < 1.25f ? 2u : m < 1.75f ? 3u : m < 2.5f ? 4u : m < 3.5f ? 5u : m < 5.f ? 6u : 7u) | (a < 0.f ? 8u : 0u);
        w[j >> 1] |= code << (4 * (4 * (j & 1) + c));
      }
    *(u32x4*)(p.vt8 + (size_t)e * 512 + l32 * 16) = w;
    if (l32 == 0) p.vstep[e] = step;
  }
}

__device__ __forceinline__ int f2key(float f) { int b_ = __float_as_int(f); return b_ ^ ((b_ >> 31) & 0x7fffffff); }
__device__ __forceinline__ float key2f(int k) { int b_ = k ^ ((k >> 31) & 0x7fffffff); return __int_as_float(b_); }
__device__ __forceinline__ void sort16_desc(int (&a)[16]) {
#pragma unroll
  for (int k = 2; k <= 16; k <<= 1)
#pragma unroll
    for (int j = k >> 1; j > 0; j >>= 1)
#pragma unroll
      for (int i = 0; i < 16; ++i) {
        const int l = i ^ j;
        if (l > i) {
          const bool up = ((i & k) == 0);
          const int hi_ = max(a[i], a[l]), lo_ = min(a[i], a[l]);
          a[i] = up ? hi_ : lo_; a[l] = up ? lo_ : hi_;
        }
      }
}
__device__ __forceinline__ void merge_top16(int (&best)[16], const int (&other)[16]) {
#pragma unroll
  for (int i = 0; i < 16; ++i) best[i] = max(best[i], other[15 - i]);
#pragma unroll
  for (int j = 8; j > 0; j >>= 1)
#pragma unroll
    for (int i = 0; i < 16; ++i) {
      const int l = i ^ j;
      if (l > i) { const int hi_ = max(best[i], best[l]), lo_ = min(best[i], best[l]); best[i] = hi_; best[l] = lo_; }
    }
}

__device__ void phase_peerq(const P& p, char* smem) {
  constexpr int K = 1024;
  bf16_t* As = (bf16_t*)smem;
  bf16_t* Bs = As + 128 * 72;
  bf16_t* Qs = (bf16_t*)smem;
  bf16_t* Ss = (bf16_t*)(smem + 34816);
  int* Ks = (int*)smem;
  const int tid = threadIdx.x, lane = tid & 63, wave = tid >> 6, wr = wave >> 1, wc = wave & 1;
  const int grp = blockIdx.x & 7, gidx = blockIdx.x >> 3, gsz = gridDim.x >> 3;
  const bool xcd_order = (gridDim.x & 7) == 0;
  const int ntl = xcd_order ? 32 * 16 : 256 * 16;
  for (int u = xcd_order ? gidx : (int)blockIdx.x; u < ntl; u += xcd_order ? gsz : (int)gridDim.x) {
    const int tm = xcd_order ? (u >> 4) * 8 + grp : u >> 4, hp = u & 15;
    const int m0 = tm * 128, n0 = hp * 128;
    f32x4 acc[4][4];
    gemm_mainloop_g<false, false>((const char*)p.h2, 2048, (const char*)p.wqT, m0, n0, smem, acc);
    __syncthreads();
#pragma unroll
    for (int i = 0; i < 4; ++i)
#pragma unroll
      for (int j = 0; j < 4; ++j) {
        const int mm = wr * 64 + i * 16 + (lane & 15), nn = wc * 64 + j * 16 + (lane >> 4) * 4;
        u32x2 o; o.x = cvtpk(acc[i][j][0], acc[i][j][1]); o.y = cvtpk(acc[i][j][2], acc[i][j][3]);
        *(u32x2*)(Qs + mm * 136 + nn) = o;
      }
    {
      const bf16_t* sk = p.skb + (hp & 1) * 16384;
#pragma unroll
      for (int j = 0; j < 8; ++j) {
        int c = tid + 256 * j, row = c >> 4, kc = c & 15;
        *(u32x4*)(Ss + row * 136 + kc * 8) = *(const u32x4*)(sk + row * 128 + kc * 8);
      }
    }
    __syncthreads();
#pragma unroll
    for (int i = 0; i < 4; ++i)
#pragma unroll
      for (int j = 0; j < 4; ++j) acc[i][j] = (f32x4){0.f, 0.f, 0.f, 0.f};
#pragma unroll
    for (int ks = 0; ks < 4; ++ks) {
      bf16x8 af[4], bfr[4];
#pragma unroll
      for (int i = 0; i < 4; ++i) af[i] = *(const bf16x8*)(Qs + (wr * 64 + i * 16 + (lane & 15)) * 136 + ks * 32 + (lane >> 4) * 8);
#pragma unroll
      for (int j = 0; j < 4; ++j) bfr[j] = *(const bf16x8*)(Ss + (wc * 64 + j * 16 + (lane & 15)) * 136 + ks * 32 + (lane >> 4) * 8);
#pragma unroll
      for (int i = 0; i < 4; ++i)
#pragma unroll
        for (int j = 0; j < 4; ++j) acc[i][j] = MFMA16(bfr[j], af[i], acc[i][j]);
    }
    __syncthreads();
#pragma unroll
    for (int i = 0; i < 4; ++i)
#pragma unroll
      for (int j = 0; j < 4; ++j) {
        const int mm = wr * 64 + i * 16 + (lane & 15), nn = wc * 64 + j * 16 + (lane >> 4) * 4;
#pragma unroll
        for (int r = 0; r < 4; ++r) Ks[mm * 129 + nn + r] = (f2key(acc[i][j][r]) & ~127) | (127 - (nn + r));
      }
    __syncthreads();
    {
      const int row = tid >> 1, half = tid & 1;
      const int* src = Ks + row * 129 + half * 64;
      int best[16];
#pragma unroll
      for (int k = 0; k < 16; ++k) best[k] = src[k];
      sort16_desc(best);
#pragma unroll
      for (int blk = 1; blk < 4; ++blk) {
        int cur[16];
#pragma unroll
        for (int k = 0; k < 16; ++k) cur[k] = src[blk * 16 + k];
        sort16_desc(cur);
        merge_top16(best, cur);
      }
      int oth[16];
#pragma unroll
      for (int k = 0; k < 16; ++k) oth[k] = __shfl_xor(best[k], 1);
      merge_top16(best, oth);
      if (half == 0) {
        int* dst = p.topl + ((size_t)(m0 + row) * 16 + hp) * 16;
#pragma unroll
        for (int k4 = 0; k4 < 4; ++k4) {
          u32x4 o; o.x = (uint32_t)best[k4 * 4]; o.y = (uint32_t)best[k4 * 4 + 1]; o.z = (uint32_t)best[k4 * 4 + 2]; o.w = (uint32_t)best[k4 * 4 + 3];
          *(u32x4*)(dst + k4 * 4) = o;
        }
      }
    }
    __syncthreads();
  }
  __syncthreads();
}

#define GW_BYTES 17408
__device__ void phase_gather(const P& p, char* smem) {
  const int wave = threadIdx.x >> 6, lane = threadIdx.x & 63;
  char* wb = smem + wave * GW_BYTES;
  int* lsA = (int*)wb;
  int* lsB = (int*)(wb + 4352);
  int* res_e = (int*)(wb + 8704);
  float* res_g = (float*)(wb + 8704 + 4096);
  float* coefs = (float*)(wb + 8704 + 8192);
  for (int grp = blockIdx.x * 4 + wave; grp < NTOK / 8; grp += gridDim.x * 4) {
    const int m8 = grp * 8;
    {
      const int tk = lane >> 3, hh = lane & 7;
      const int* src = p.topl + ((size_t)(m8 + tk) * 16 + hh * 2) * 16;
      int ka[16], kb[16];
#pragma unroll
      for (int k4 = 0; k4 < 4; ++k4) {
        u32x4 wa = *(const u32x4*)(src + k4 * 4), wb_ = *(const u32x4*)(src + 16 + k4 * 4);
        ka[k4 * 4] = (int)wa.x; ka[k4 * 4 + 1] = (int)wa.y; ka[k4 * 4 + 2] = (int)wa.z; ka[k4 * 4 + 3] = (int)wa.w;
        kb[k4 * 4] = (int)wb_.x; kb[k4 * 4 + 1] = (int)wb_.y; kb[k4 * 4 + 2] = (int)wb_.z; kb[k4 * 4 + 3] = (int)wb_.w;
      }
      float va[16], vb[16];
#pragma unroll
      for (int k = 0; k < 16; ++k) { lsA[lane * 17 + k] = ka[k]; lsB[lane * 17 + k] = kb[k]; va[k] = key2f(ka[k] & ~127); vb[k] = key2f(kb[k] & ~127); }
      int t2[16];
      {
        int c_[16];
        c_[0] = (f2key(va[0] + vb[0]) & ~255) | 0;
        c_[1] = (f2key(va[0] + vb[1]) & ~255) | 1;
        c_[2] = (f2key(va[0] + vb[2]) & ~255) | 2;
        c_[3] = (f2key(va[0] + vb[3]) & ~255) | 3;
        c_[4] = (f2key(va[0] + vb[4]) & ~255) | 4;
        c_[5] = (f2key(va[0] + vb[5]) & ~255) | 5;
        c_[6] = (f2key(va[0] + vb[6]) & ~255) | 6;
        c_[7] = (f2key(va[0] + vb[7]) & ~255) | 7;
        c_[8] = (f2key(va[0] + vb[8]) & ~255) | 8;
        c_[9] = (f2key(va[0] + vb[9]) & ~255) | 9;
        c_[10] = (f2key(va[0] + vb[10]) & ~255) | 10;
        c_[11] = (f2key(va[0] + vb[11]) & ~255) | 11;
        c_[12] = (f2key(va[0] + vb[12]) & ~255) | 12;
        c_[13] = (f2key(va[0] + vb[13]) & ~255) | 13;
        c_[14] = (f2key(va[0] + vb[14]) & ~255) | 14;
        c_[15] = (f2key(va[0] + vb[15]) & ~255) | 15;
        sort16_desc(c_);
#pragma unroll
        for (int k = 0; k < 16; ++k) t2[k] = c_[k];
      }
      {
        int c_[16];
        c_[0] = (f2key(va[1] + vb[0]) & ~255) | 16;
        c_[1] = (f2key(va[1] + vb[1]) & ~255) | 17;
        c_[2] = (f2key(va[1] + vb[2]) & ~255) | 18;
        c_[3] = (f2key(va[1] + vb[3]) & ~255) | 19;
        c_[4] = (f2key(va[1] + vb[4]) & ~255) | 20;
        c_[5] = (f2key(va[1] + vb[5]) & ~255) | 21;
        c_[6] = (f2key(va[1] + vb[6]) & ~255) | 22;
        c_[7] = (f2key(va[1] + vb[7]) & ~255) | 23;
        c_[8] = (f2key(va[2] + vb[0]) & ~255) | 32;
        c_[9] = (f2key(va[2] + vb[1]) & ~255) | 33;
        c_[10] = (f2key(va[2] + vb[2]) & ~255) | 34;
        c_[11] = (f2key(va[2] + vb[3]) & ~255) | 35;
        c_[12] = (f2key(va[2] + vb[4]) & ~255) | 36;
        c_[13] = (f2key(va[3] + vb[0]) & ~255) | 48;
        c_[14] = (f2key(va[3] + vb[1]) & ~255) | 49;
        c_[15] = (f2key(va[3] + vb[2]) & ~255) | 50;
        sort16_desc(c_);
        merge_top16(t2, c_);
      }
      {
        int c_[16];
        c_[0] = (f2key(va[3] + vb[3]) & ~255) | 51;
        c_[1] = (f2key(va[4] + vb[0]) & ~255) | 64;
        c_[2] = (f2key(va[4] + vb[1]) & ~255) | 65;
        c_[3] = (f2key(va[4] + vb[2]) & ~255) | 66;
        c_[4] = (f2key(va[5] + vb[0]) & ~255) | 80;
        c_[5] = (f2key(va[5] + vb[1]) & ~255) | 81;
        c_[6] = (f2key(va[6] + vb[0]) & ~255) | 96;
        c_[7] = (f2key(va[6] + vb[1]) & ~255) | 97;
        c_[8] = (f2key(va[7] + vb[0]) & ~255) | 112;
        c_[9] = (f2key(va[7] + vb[1]) & ~255) | 113;
        c_[10] = (f2key(va[8] + vb[0]) & ~255) | 128;
        c_[11] = (f2key(va[9] + vb[0]) & ~255) | 144;
        c_[12] = (f2key(va[10] + vb[0]) & ~255) | 160;
        c_[13] = (f2key(va[11] + vb[0]) & ~255) | 176;
        c_[14] = (f2key(va[12] + vb[0]) & ~255) | 192;
        c_[15] = (f2key(va[13] + vb[0]) & ~255) | 208;
        sort16_desc(c_);
        merge_top16(t2, c_);
      }
      {
        int c_[16];
        c_[0] = (f2key(va[14] + vb[0]) & ~255) | 224;
        c_[1] = (f2key(va[15] + vb[0]) & ~255) | 240;
        c_[2] = (int)0x80000000;
        c_[3] = (int)0x80000000;
        c_[4] = (int)0x80000000;
        c_[5] = (int)0x80000000;
        c_[6] = (int)0x80000000;
        c_[7] = (int)0x80000000;
        c_[8] = (int)0x80000000;
        c_[9] = (int)0x80000000;
        c_[10] = (int)0x80000000;
        c_[11] = (int)0x80000000;
        c_[12] = (int)0x80000000;
        c_[13] = (int)0x80000000;
        c_[14] = (int)0x80000000;
        c_[15] = (int)0x80000000;
        sort16_desc(c_);
        merge_top16(t2, c_);
      }
      float sv[16]; float sum = 0.f;
      const float mx = key2f(t2[0] & ~255);
#pragma unroll
      for (int k = 0; k < 16; ++k) { sv[k] = __expf(key2f(t2[k] & ~255) - mx); sum += sv[k]; }
      const float is = 1.f / sum;
#pragma unroll
      for (int k = 0; k < 16; ++k) {
        const int code = t2[k] & 255;
        const int ia = 127 - (lsA[lane * 17 + (code >> 4)] & 127), ib = 127 - (lsB[lane * 17 + (code & 15)] & 127);
        res_e[tk * 128 + hh * 16 + k] = ia * 128 + ib;
        res_g[tk * 128 + hh * 16 + k] = sv[k] * is;
      }
    }
    wave_lds_fence();
#pragma unroll 1
    for (int tk = 0; tk < 8; ++tk) {
      const int m = m8 + tk;
      int bb, t_, T_; tok_info(m, bb, t_, T_);
      int hq[4];
      { const u32x4 hw_ = *(const u32x4*)(p.hq8 + (size_t)m * DM + lane * 16); hq[0] = (int)hw_.x; hq[1] = (int)hw_.y; hq[2] = (int)hw_.z; hq[3] = (int)hw_.w; }
      const float hstep = p.hstep[m];
      const int* re = res_e + tk * 128;
      const float* rg = res_g + tk * 128;
      const int he0 = (int)__builtin_amdgcn_perm((uint32_t)hq[1], (uint32_t)hq[0], 0x06040200u), ho0 = (int)__builtin_amdgcn_perm((uint32_t)hq[1], (uint32_t)hq[0], 0x07050301u);
      const int he1 = (int)__builtin_amdgcn_perm((uint32_t)hq[3], (uint32_t)hq[2], 0x06040200u), ho1 = (int)__builtin_amdgcn_perm((uint32_t)hq[3], (uint32_t)hq[2], 0x07050301u);
      int hsum = __builtin_amdgcn_sdot4(hq[0], 0x01010101, 0, false);
      hsum = __builtin_amdgcn_sdot4(hq[1], 0x01010101, hsum, false); hsum = __builtin_amdgcn_sdot4(hq[2], 0x01010101, hsum, false); hsum = __builtin_amdgcn_sdot4(hq[3], 0x01010101, hsum, false);
      const int hoff = 8 * hsum;
      u32x2 ud[2][16]; bf16_t us[2][16];
#define GU_LOAD(SET, B_) { _Pragma("unroll") for (int s2 = 0; s2 < 16; ++s2) { const unsigned char* urow = p.ut4 + (size_t)re[(B_) * 16 + s2] * 640; \
        ud[SET][s2] = *(const u32x2*)(urow + lane * 8); us[SET][s2] = *(const bf16_t*)(urow + 512 + lane * 2); } }
#define GU_DOT(SET) { _Pragma("unroll") for (int s2 = 0; s2 < 16; ++s2) { const u32x2 u0 = ud[SET][s2]; \
        int d = __builtin_amdgcn_sdot4((int)(u0.x & 0x0f0f0f0fu), he0, 0, false); d = __builtin_amdgcn_sdot4((int)((u0.x >> 4) & 0x0f0f0f0fu), ho0, d, false); \
        d = __builtin_amdgcn_sdot4((int)(u0.y & 0x0f0f0f0fu), he1, d, false); d = __builtin_amdgcn_sdot4((int)((u0.y >> 4) & 0x0f0f0f0fu), ho1, d, false); \
        part[s2] = bf2f(us[SET][s2]) * (float)(d - hoff); } }
      GU_LOAD(0, 0);
#pragma unroll 1
      for (int b2 = 0; b2 < 4; ++b2) {
#pragma unroll
       for (int par = 0; par < 2; ++par) {
        const int b = b2 * 2 + par;
        float part[16];
        if (par == 0) { GU_LOAD(1, b + 1); GU_DOT(0); }
        else { if (b + 1 < 8) GU_LOAD(0, b + 1); GU_DOT(1); }
        {
          const bool up = (lane & 32) != 0;
#pragma unroll
          for (int k = 0; k < 8; ++k) { float a_ = part[k], b_ = part[k + 8]; float send = up ? a_ : b_, keep = up ? b_ : a_; part[k] = keep + __shfl_xor(send, 32); }
        }
        {
          const bool up = (lane & 16) != 0;
#pragma unroll
          for (int k = 0; k < 4; ++k) { float a_ = part[k], b_ = part[k + 4]; float send = up ? a_ : b_, keep = up ? b_ : a_; part[k] = keep + __shfl_xor(send, 16); }
        }
        {
          const bool up = (lane & 8) != 0;
#pragma unroll
          for (int k = 0; k < 2; ++k) { float a_ = part[k], b_ = part[k + 2]; float send = up ? a_ : b_, keep = up ? b_ : a_; part[k] = keep + __shfl_xor(send, 8); }
        }
        float totf;
        {
          const bool up = (lane & 4) != 0;
          float a_ = part[0], b_ = part[1]; float send = up ? a_ : b_, keep = up ? b_ : a_; totf = keep + __shfl_xor(send, 4);
        }
        totf += __shfl_xor(totf, 2); totf += __shfl_xor(totf, 1);
        const int slot = b * 16 + (lane >> 2);
        const int e = re[slot];
        const float tot = totf * hstep;
        const float act = 0.5f * tot * (1.f + erff(tot * 0.70710678f));
        if ((lane & 3) == 0) coefs[slot] = rg[slot] * act * p.vstep[e];
       }
      }
      wave_lds_fence();
      const int l32 = lane & 31, hf = lane >> 5;
      v32f acc;
#pragma unroll
      for (int i = 0; i < 32; ++i) acc[i] = 0.f;
#define V4_DEC(W, D, B) { const f32x2 d_ = __builtin_amdgcn_cvt_scalef32_pk_f32_fp4(W, 1.0f, B); acc[8 * (D) + 2 * (B)] += d_.x * cf; acc[8 * (D) + 2 * (B) + 1] += d_.y * cf; }
#define V4_DEC4(W, D) V4_DEC(W, D, 0) V4_DEC(W, D, 1) V4_DEC(W, D, 2) V4_DEC(W, D, 3)
#pragma unroll 4
      for (int s2 = 0; s2 < 128; s2 += 2) {
        const int e = re[s2 + hf];
        const float cf = coefs[s2 + hf];
        const u32x4 w4 = *(const u32x4*)(p.vt8 + (size_t)e * 512 + l32 * 16);
        V4_DEC4(w4.x, 0) V4_DEC4(w4.y, 1) V4_DEC4(w4.z, 2) V4_DEC4(w4.w, 3)
      }
      wave_lds_fence();
#pragma unroll
      for (int i = 0; i < 32; ++i) acc[i] += __shfl_xor(acc[i], 32);
      float* orow = p.out + (size_t)m * DM + l32 * 32 + hf * 16;
      const float* gt2 = p.mod + bb * 6144 + 5120 + l32 * 32 + hf * 16;
#pragma unroll
      for (int j = 0; j < 4; ++j) {
        f32x4 xa = *(const f32x4*)(orow + 4 * j);
        const f32x4 ga = *(const f32x4*)(gt2 + 4 * j);
#pragma unroll
        for (int k = 0; k < 4; ++k) xa[k] += ga[k] * (hf ? acc[16 + 4 * j + k] : acc[4 * j + k]);
        *(f32x4*)(orow + 4 * j) = xa;
      }
    }
    wave_lds_fence();
  }
}

#define XB_TMO      128
#define XB_XCNT(j)  (256  + 64 * (j))
#define XB_XSUB(j)  (1280 + 64 * (j))
#define XB_XGEN(j)  (2304 + 64 * (j))
#define XB_TOP      3328
#define XB_TOPGEN   3392
#define XCD_BAR_WORDS 3456
#define XB_SPIN_CAP (1u << 23)
__device__ __forceinline__ unsigned xb_ld(unsigned* p_) { return __hip_atomic_load(p_, __ATOMIC_RELAXED, __HIP_MEMORY_SCOPE_AGENT); }
__device__ __forceinline__ unsigned xb_add(unsigned* p_, unsigned v) { return __hip_atomic_fetch_add(p_, v, __ATOMIC_RELAXED, __HIP_MEMORY_SCOPE_AGENT); }
__device__ __forceinline__ unsigned xb_xcc_id() { return (unsigned)__builtin_amdgcn_s_getreg((3 << 11) | 20) & 0xFu; }
#define XB_SPIN(cond, bar) do { unsigned _sp = 0; while (cond) { __builtin_amdgcn_s_sleep(1); \
    if ((++_sp & 255u) == 0u) { if (xb_ld(&(bar)[XB_TMO])) break; if (_sp > XB_SPIN_CAP) { atomicAdd(&(bar)[XB_TMO], 1u); break; } } } } while (0)
struct XcdBarrier { unsigned* bar; unsigned x; volatile LAS unsigned* st; };
__device__ __forceinline__ XcdBarrier xcd_barrier_post(unsigned* bar, volatile LAS unsigned* st) {
  XcdBarrier b; b.bar = bar; b.x = xb_xcc_id(); b.st = st;
  if (threadIdx.x == 0) (void)xb_add(&bar[XB_XCNT(b.x)], 1u);
  return b;
}
__device__ __forceinline__ void xcd_barrier_complete(unsigned* bar, unsigned x, unsigned& nloc, unsigned& nx) {
  const unsigned G = gridDim.x * gridDim.y * gridDim.z;
  unsigned sum, cnt, mine, sp = 0u;
  for (;;) {
    sum = 0u; cnt = 0u; mine = 0u;
#pragma unroll
    for (unsigned j = 0; j < 16; ++j) { const unsigned c = xb_ld(&bar[XB_XCNT(j)]); sum += c; cnt += (c > 0u) ? 1u : 0u; mine = (j == x) ? c : mine; }
    if (sum == G) break;
    __builtin_amdgcn_s_sleep(1);
    if ((++sp & 255u) == 0u) { if (xb_ld(&bar[XB_TMO])) break; if (sp > XB_SPIN_CAP) { atomicAdd(&bar[XB_TMO], 1u); break; } }
  }
  nloc = mine > 0u ? mine : 1u; nx = cnt > 0u ? cnt : 1u;
}
__device__ __forceinline__ void xcd_barrier(const XcdBarrier& b) {
  asm volatile("s_waitcnt vmcnt(0)" ::: "memory");
  __syncthreads();
  if (threadIdx.x == 0) {
    unsigned* bar = b.bar;
    __builtin_amdgcn_s_waitcnt(0);
    unsigned nloc = b.st[0], nx = b.st[1];
    if (nloc == 0u) { xcd_barrier_complete(bar, b.x, nloc, nx); b.st[0] = nloc; b.st[1] = nx; }
    const unsigned old = xb_add(&bar[XB_XSUB(b.x)], 1u);
    const unsigned gen = old / nloc;
    if (old + 1u == (gen + 1u) * nloc) {
      __builtin_amdgcn_fence(__ATOMIC_RELEASE, "agent");
      asm volatile("s_waitcnt vmcnt(0)" ::: "memory");
      const unsigned og = xb_add(&bar[XB_TOP], 1u);
      const unsigned tg = og / nx;
      if (og + 1u == (tg + 1u) * nx) xb_add(&bar[XB_TOPGEN], 1u);
      else XB_SPIN(xb_ld(&bar[XB_TOPGEN]) == tg, bar);
      __builtin_amdgcn_fence(__ATOMIC_ACQUIRE, "agent");
      xb_add(&bar[XB_XGEN(b.x)], 1u);
      asm volatile("s_waitcnt vmcnt(0)" ::: "memory");
    } else {
      XB_SPIN(xb_ld(&bar[XB_XGEN(b.x)]) == gen, bar);
      __builtin_amdgcn_fence(__ATOMIC_ACQUIRE, "agent");
      asm volatile("s_waitcnt vmcnt(0)" ::: "memory");
    }
  }
  __syncthreads();
}

__global__ void __launch_bounds__(NTHR, 2) mega(P p) {
  __shared__ __attribute__((aligned(16))) char smem[77056];
  cg::grid_group grid = cg::this_grid();
  __shared__ __attribute__((aligned(16))) unsigned xb_words[4];
  if (threadIdx.x == 0) { xb_words[0] = 0u; xb_words[1] = 0u; xb_words[2] = 0u; xb_words[3] = 0u; }
  __syncthreads();
  XcdBarrier xb = xcd_barrier_post(p.bar, (volatile LAS unsigned*)xb_words);
  float* fs = (float*)smem;
  if (blockIdx.x == 0 && threadIdx.x == 0) { p.ctr[0] = 0; p.ctr[1] = 0; }
  phase_mod(p, fs);
  phase_wq8(p.w_in, 2688, p.w_in8, p.w_in_s, fs);
  phase_transpose(p.w_out, p.w_outT, 1024, 1024, fs);
  phase_transpose(p.wq, p.wqT, 1024, 2048, fs);
  phase_lorafrag(p);
  phase_transpose(p.g2, p.g2T, 128, 512, fs);
  for (int i = blockIdx.x * NTHR + threadIdx.x; i < 2048; i += gridDim.x * NTHR) {
    float sn, cs; sincosf((float)(i >> 4) * powf(10000.f, -(float)(i & 15) / 16.f), &sn, &cs);
    p.rope[2 * i] = cs; p.rope[2 * i + 1] = sn;
  }
  for (int i = blockIdx.x * NTHR + threadIdx.x; i < 32768; i += gridDim.x * NTHR) p.skb[i] = f2bf(p.subk[i]);
  if (p.never) grid.sync();
  xcd_barrier(xb);
  phase_norm(p, 1);
  xcd_barrier(xb);
  phase_gemm<0>(p, smem, 0, NTOK);
  xcd_barrier(xb);
  phase_shift(p);
  xcd_barrier(xb);
  phase_scan(p, smem);
  {
    float gq = fabsf(p.qn_g[threadIdx.x & 63]), gk = fabsf(p.kn_g[threadIdx.x & 63]);
#pragma unroll
    for (int o = 32; o >= 1; o >>= 1) { gq = fmaxf(gq, __shfl_xor(gq, o)); gk = fmaxf(gk, __shfl_xor(gk, o)); }
    const float bmax = 64.f * QSCALE * 1.02f * gq * gk;
    if (bmax * 1.13f < 16.f) phase_attn_f8(p, smem, fmaxf(bmax * 1.13f - 8.5f, 0.f));
    else if (bmax < 100.f) phase_attn_fast(p, smem);
    else phase_attn(p, smem);
  }
  xcd_barrier(xb);
  phase_post(p, smem);
  xcd_barrier(xb);
  phase_gemm<1>(p, smem, 0, NTOK);
  xcd_barrier(xb);
  phase_norm(p, 2);
  phase_convert8(p);
  xcd_barrier(xb);
  phase_peerq(p, smem);
  xcd_barrier(xb);
  phase_gather(p, smem);
}

extern "C" void kernel_launch(void* const* d_in, const int* in_sizes, int n_in, void* d_out, int out_size, void* d_ws, size_t ws_size, hipStream_t stream) {
  P p{};
  const float* const* in = (const float* const*)d_in;
  p.x_prompt = in[0]; p.x_sample = in[1]; p.c_prompt = in[2]; p.c_sample = in[3]; p.ada_w = in[4]; p.ada_b = in[5]; p.norm1_g = in[6]; p.norm2_g = in[7];
  p.w_in = in[8]; p.mu = in[9]; p.w0 = in[10]; p.w2 = in[11]; p.a0 = in[12]; p.a2 = in[13]; p.g2 = in[14]; p.k_k = in[15]; p.k_a = in[16]; p.r_k = in[17];
  p.ln_w = in[18]; p.ln_b = in[19]; p.qn_g = in[20]; p.kn_g = in[21]; p.ao_g = in[22]; p.w_out = in[23]; p.wq = in[24]; p.subk = in[25]; p.u_tab = in[26]; p.v_tab = in[27];
  p.out = (float*)d_out;
  char* ws = (char*)d_ws;
  const size_t MiB = 1048576;
  p.w_inT = (bf16_t*)(ws + 0);
  p.w_outT = (bf16_t*)(ws + 6 * MiB);
  p.wqT = (bf16_t*)(ws + 8 * MiB);
  p.mod = (float*)(ws + 12 * MiB);
  p.ctr = (int*)(ws + 12 * MiB + 512 * 1024);
  p.bar = (unsigned*)(ws + 12 * MiB + 640 * 1024);
  p.sflag = (unsigned*)(ws + 12 * MiB + 704 * 1024);
  p.Q8 = (unsigned char*)(ws + 275 * MiB);
  p.V8t = (unsigned char*)(ws + 295 * MiB);
  p.K8 = (unsigned char*)(ws + 291 * MiB);
  p.ring = ws + 248 * MiB;
  p.cd = (float*)(ws + 13 * MiB);
  p.w2f = (bf16_t*)(ws + 15 * MiB);
  p.a2f = (bf16_t*)(ws + 15 * MiB + 256 * 1024);
  p.skb = (bf16_t*)(ws + 15 * MiB + 512 * 1024);
  p.g2T = (bf16_t*)(ws + 15 * MiB + 768 * 1024);
  p.rope = (float*)(ws + 15 * MiB + 896 * 1024);
  p.w_in_s = (float*)(ws + 15 * MiB + 912 * 1024);
  p.wq_s = (float*)(ws + 15 * MiB + 924 * 1024);
  p.w_in8 = (unsigned char*)(ws + 0);
  p.wq8 = (unsigned char*)(ws + 8 * MiB);
  p.topl = (int*)(ws + 80 * MiB);
  p.hq8 = (unsigned char*)(ws + 112 * MiB);
  p.hstep = (float*)(ws + 144 * MiB);
  p.hs1 = (float*)(ws + 12 * MiB + 256 * 1024);
  p.ut8 = (unsigned char*)(ws + 16 * MiB);
  p.ut4 = (unsigned char*)(ws + 16 * MiB);
  p.vt8 = (unsigned char*)(ws + 32 * MiB);
  p.ustep = (float*)(ws + 15 * MiB + 640 * 1024);
  p.vstep = (float*)(ws + 15 * MiB + 704 * 1024);
  p.proj = (bf16_t*)(ws + 16 * MiB);
  p.h2 = (bf16_t*)(ws + 184 * MiB);
  p.h = (bf16_t*)d_out;
  p.h8 = (unsigned char*)d_out + 64 * MiB;
  p.yd = (bf16_t*)((char*)d_out + 64 * MiB);
  p.Kc = (bf16_t*)((char*)d_out + 48 * MiB);
  p.Vt = (bf16_t*)((char*)d_out + 56 * MiB);
  p.ps_vwa = (bf16_t*)d_out;
  p.ps_rk = (bf16_t*)(ws + 184 * MiB);
  p.ut = (bf16_t*)(ws + 16 * MiB);
  p.vt = (bf16_t*)(ws + 48 * MiB);
  p.eidx = (int*)(ws + 80 * MiB);
  p.gate = (float*)(ws + 96 * MiB);
  p.qp = (bf16_t*)(ws + 112 * MiB);

  static int grid_blocks = 0;
  if (!grid_blocks) {
    int dev = 0, cus = 0, per_cu = 0;
    (void)hipGetDevice(&dev);
    (void)hipDeviceGetAttribute(&cus, hipDeviceAttributeMultiprocessorCount, dev);
    (void)hipOccupancyMaxActiveBlocksPerMultiprocessor(&per_cu, mega, NTHR, 0);
    if (per_cu < 1) per_cu = 1;
    grid_blocks = cus * per_cu;
  }
  (void)hipMemsetAsync(p.bar, 0, 192 * 1024, stream);
  void* args[] = {&p};
  hipError_t e = hipLaunchCooperativeKernel((void*)mega, dim3(grid_blocks), dim3(NTHR), args, 0, stream);
  if (e != hipSuccess) fprintf(stderr, "cooperative launch failed: %s (grid %d)\n", hipGetErrorString(e), grid_blocks);
}
```

```cpp
#include <hip/hip_runtime.h>
#include <hip/hip_cooperative_groups.h>
#include <stdint.h>
#include <stdio.h>
namespace cg = cooperative_groups;

typedef unsigned short bf16_t;
typedef short bf16x8 __attribute__((ext_vector_type(8)));
#define LAS __attribute__((address_space(3)))
typedef int i32x4 __attribute__((ext_vector_type(4)));
typedef int i32x8 __attribute__((ext_vector_type(8)));
typedef float f32x4 __attribute__((ext_vector_type(4)));
typedef unsigned u32x4 __attribute__((ext_vector_type(4)));
typedef unsigned u32x2 __attribute__((ext_vector_type(2)));
typedef float f32x16 __attribute__((ext_vector_type(16)));

#define NTOK 32768
#define DM 1024
#define DIN 2688
#define NTHR 256

struct P {
  const float *x_prompt, *x_sample, *c_prompt, *c_sample, *ada_w, *ada_b, *norm1_g, *norm2_g, *w_in, *mu, *w0, *w2, *a0, *a2, *g2,
      *k_k, *k_a, *r_k, *ln_w, *ln_b, *qn_g, *kn_g, *ao_g, *w_out, *wq, *subk, *u_tab, *v_tab;
  float* out;
  bf16_t *w_inT, *w_outT, *wqT;
  float *mod, *cd;
  bf16_t *proj, *h2, *h, *yd, *ut, *vt, *qp;
  int* eidx;
  float* gate;
  int* ctr;
  bf16_t *Kc, *Vt, *w2f, *a2f, *skb;
  unsigned char *Q8, *K8, *V8t;
  int* topl;
  unsigned* bar;
  bf16_t *ps_rk, *ps_vwa, *g2T;
  float* rope;
  unsigned char *ut8, *vt8, *h8, *hq8, *w_in8, *wq8, *ut4;
  float *hs1, *hstep, *w_in_s, *wq_s;
  unsigned* sflag;
  char* ring;
  long long never;
  float *ustep, *vstep;
};

__device__ __forceinline__ bf16_t f2bf(float f) {
  uint32_t u = __float_as_uint(f);
  u += 0x7fffu + ((u >> 16) & 1u);
  return (bf16_t)(u >> 16);
}
__device__ __forceinline__ float bf2f(bf16_t b) { return __uint_as_float(((uint32_t)b) << 16); }
__device__ __forceinline__ float bflo(uint32_t w) { return __uint_as_float(w << 16); }
__device__ __forceinline__ float bfhi(uint32_t w) { return __uint_as_float(w & 0xffff0000u); }
__device__ __forceinline__ uint32_t pack2(float lo, float hi) { typedef float f2_ __attribute__((ext_vector_type(2))); typedef __bf16 b2_ __attribute__((ext_vector_type(2))); f2_ v = {lo, hi}; return __builtin_bit_cast(uint32_t, __builtin_convertvector(v, b2_)); }
typedef float f32x2 __attribute__((ext_vector_type(2)));
typedef __bf16 bf16x2n __attribute__((ext_vector_type(2)));
__device__ __forceinline__ uint32_t cvtpk(float lo, float hi) { f32x2 v = {lo, hi}; return __builtin_bit_cast(uint32_t, __builtin_convertvector(v, bf16x2n)); }
__device__ __forceinline__ float dot2bf(uint32_t a, uint32_t b_, float c) {
  return __builtin_amdgcn_fdot2_f32_bf16(__builtin_bit_cast(bf16x2n, a), __builtin_bit_cast(bf16x2n, b_), c, false);
}
__device__ __forceinline__ float sigmoidf_(float x) { return 1.f / (1.f + __expf(-x)); }
typedef unsigned pl_u2 __attribute__((ext_vector_type(2)));
__device__ __forceinline__ float xsum32(float v) { const pl_u2 r = __builtin_amdgcn_permlane32_swap(__float_as_uint(v), __float_as_uint(v), false, false); return __uint_as_float(r.x) + __uint_as_float(r.y); }
__device__ __forceinline__ float xsum16(float v) { const pl_u2 r = __builtin_amdgcn_permlane16_swap(__float_as_uint(v), __float_as_uint(v), false, false); return __uint_as_float(r.x) + __uint_as_float(r.y); }
__device__ __forceinline__ float xmax32(float v) { const pl_u2 r = __builtin_amdgcn_permlane32_swap(__float_as_uint(v), __float_as_uint(v), false, false); return fmaxf(__uint_as_float(r.x), __uint_as_float(r.y)); }
__device__ __forceinline__ float xmax16(float v) { const pl_u2 r = __builtin_amdgcn_permlane16_swap(__float_as_uint(v), __float_as_uint(v), false, false); return fmaxf(__uint_as_float(r.x), __uint_as_float(r.y)); }
#define dppf_(X, CTRL) __int_as_float(__builtin_amdgcn_update_dpp(0, __float_as_int(X), CTRL, 0xf, 0xf, false))
__device__ __forceinline__ float wave_sum(float v) {
  v = xsum32(v); v = xsum16(v);
  v += dppf_(v, 0x128); v += dppf_(v, 0x141); v += dppf_(v, 0x4E); v += dppf_(v, 0xB1);
  return v;
}
__device__ __forceinline__ void tok_info(int m, int& bb, int& t, int& T) {
  if (m < 16384) { bb = m >> 12; t = m & 4095; T = 4096; }
  else { int mm = m - 16384; bb = 4 + (mm >> 13); t = mm & 8191; T = 8192; }
}
__device__ __forceinline__ float shifted(const bf16_t* proj, const float* mu, int m, int t, int T, int col) {
  float mu_ = mu[col];
  float c = bf2f(proj[(size_t)m * DIN + col]);
  float pv = t > 0 ? bf2f(proj[(size_t)(m - 1) * DIN + col]) : 0.f;
  float nx = t < T - 1 ? bf2f(proj[(size_t)(m + 1) * DIN + col]) : 0.f;
  return c + mu_ * (0.5f * (pv + nx) - c);
}

#define ST16WT(PTR, VAL) asm volatile("global_store_dwordx4 %0, %1, off sc1\n\ts_nop 1" :: "v"(PTR), "v"(VAL))
#define ST8WT(PTR, VAL)  asm volatile("global_store_dwordx2 %0, %1, off sc1\n\ts_nop 1" :: "v"(PTR), "v"(VAL))
#define ST4WT(PTR, VAL)  asm volatile("global_store_dword %0, %1, off sc1\n\ts_nop 1" :: "v"(PTR), "v"(VAL))
#define ST16U(WT, PTR, VAL) do { if (WT) ST16WT(PTR, VAL); else *(u32x4*)(PTR) = (VAL); } while (0)
#define ST16F(WT, PTR, VAL) do { if (WT) ST16WT(PTR, VAL); else *(f32x4*)(PTR) = (VAL); } while (0)
#define ST8U(WT, PTR, VAL)  do { if (WT) ST8WT(PTR, VAL); else *(u32x2*)(PTR) = (VAL); } while (0)
#define ST4U(WT, PTR, VAL)  do { if (WT) ST4WT(PTR, VAL); else *(uint32_t*)(PTR) = (VAL); } while (0)

__device__ void phase_mod(const P& p, float* smem) {
  float* sc = smem;
  float* red = smem + 6144;
  const int tid = threadIdx.x;
  if (blockIdx.x >= 384) return;
  for (int i = tid; i < 6 * 1024; i += NTHR) {
    int bb = i >> 10, k = i & 1023;
    float c = bb < 4 ? p.c_prompt[bb * 1024 + k] : p.c_sample[(bb - 4) * 1024 + k];
    sc[i] = c / (1.f + __expf(-c));
  }
  __syncthreads();
  const int c4 = tid & 3, kg = tid >> 2;
  const float* wcol = p.ada_w + blockIdx.x * 16 + c4 * 4;
  f32x4 wv[16];
#pragma unroll
  for (int it = 0; it < 16; ++it) wv[it] = *(const f32x4*)(wcol + (size_t)(it * 64 + kg) * 6144);
  f32x4 ac[6];
#pragma unroll
  for (int b6 = 0; b6 < 6; ++b6) ac[b6] = (f32x4){0.f, 0.f, 0.f, 0.f};
#pragma unroll
  for (int it = 0; it < 16; ++it) {
    const int k = it * 64 + kg;
#pragma unroll
    for (int b6 = 0; b6 < 6; ++b6) { const float sv = sc[b6 * 1024 + k]; ac[b6][0] += sv * wv[it][0]; ac[b6][1] += sv * wv[it][1]; ac[b6][2] += sv * wv[it][2]; ac[b6][3] += sv * wv[it][3]; }
  }
#pragma unroll
  for (int b6 = 0; b6 < 6; ++b6) *(f32x4*)(red + (kg * 6 + b6) * 16 + c4 * 4) = ac[b6];
  __syncthreads();
  if (tid < 96) {
    const int bb = tid >> 4, cc = tid & 15;
    float s_ = 0.f;
#pragma unroll
    for (int g = 0; g < 64; ++g) s_ += red[(g * 6 + bb) * 16 + cc];
    p.mod[bb * 6144 + blockIdx.x * 16 + cc] = s_ + p.ada_b[blockIdx.x * 16 + cc];
  }
  __syncthreads();
}

__device__ void phase_transpose_all(const P& p, float* smem) {
  const int tid = threadIdx.x;
  int t0 = blockIdx.x, t1 = 784, ts = gridDim.x;
  if (gridDim.x == 512) {
    if (blockIdx.x >= 384) { t0 = blockIdx.x - 384; t1 = 256; ts = 128; }
    else { t0 = 256 + blockIdx.x; ts = 384; }
  }
  for (int tl = t0; tl < t1; tl += ts) {
    const float* in; bf16_t* out; int K, N, tile;
    if (tl < 256) { in = p.w_out; out = p.w_outT; K = 1024; N = 1024; tile = tl; }
    else if (tl < 768) { in = p.wq; out = p.wqT; K = 1024; N = 2048; tile = tl - 256; }
    else { in = p.g2; out = p.g2T; K = 128; N = 512; tile = tl - 768; }
    const int ntn = N / 64;
    const int k0 = (tile / ntn) * 64, n0 = (tile % ntn) * 64;
    const int c4 = tid & 15, r0 = tid >> 4;
    f32x4 v[4];
#pragma unroll
    for (int i = 0; i < 4; ++i) v[i] = *(const f32x4*)(in + (size_t)(k0 + r0 + 16 * i) * N + n0 + c4 * 4);
    __syncthreads();
#pragma unroll
    for (int i = 0; i < 4; ++i) { float* d_ = smem + (r0 + 16 * i) * 65 + c4 * 4; d_[0] = v[i][0]; d_[1] = v[i][1]; d_[2] = v[i][2]; d_[3] = v[i][3]; }
    __syncthreads();
#pragma unroll
    for (int i = 0; i < 2; ++i) {
      const int r = (tid >> 3) + 32 * i, kc = (tid & 7) * 8;
      u32x4 o;
#pragma unroll
      for (int w_ = 0; w_ < 4; ++w_) o[w_] = cvtpk(smem[(kc + 2 * w_) * 65 + r], smem[(kc + 2 * w_ + 1) * 65 + r]);
      *(u32x4*)(out + (size_t)(n0 + r) * K + k0 + kc) = o;
    }
  }
  __syncthreads();
}

__device__ void phase_norm(const P& p, int which) {
  int wave = threadIdx.x >> 6, lane = threadIdx.x & 63;
  const float* g = which == 1 ? p.norm1_g : p.norm2_g;
  unsigned char* dst8 = which == 1 ? p.h8 : p.hq8;
  float* dsts = which == 1 ? p.hs1 : p.hstep;
  int bb_cur = -1; f32x4 gm[4], hm[4];
  for (int m = blockIdx.x * 4 + wave; m < NTOK; m += gridDim.x * 4) {
    const bool lastm = m + (int)gridDim.x * 4 >= NTOK;
    int bb, t, T; tok_info(m, bb, t, T);
    if (bb != bb_cur) {
      bb_cur = bb;
      const float* sc_ = p.mod + bb * 6144 + (which == 1 ? 1024 : 4096);
      const float* sh_ = p.mod + bb * 6144 + (which == 1 ? 0 : 3072);
#pragma unroll
      for (int j = 0; j < 4; ++j) {
        const int c = (lane + 64 * j) * 4;
        const f32x4 gg = *(const f32x4*)(g + c), s4 = *(const f32x4*)(sc_ + c);
        hm[j] = *(const f32x4*)(sh_ + c);
#pragma unroll
        for (int e = 0; e < 4; ++e) gm[j][e] = gg[e] * (1.f + s4[e]);
      }
    }
    const float* src = which == 1 ? (m < 16384 ? p.x_prompt + (size_t)m * DM : p.x_sample + (size_t)(m - 16384) * DM) : p.out + (size_t)m * DM;
    f32x4 v[4]; float ss = 0.f;
#pragma unroll
    for (int j = 0; j < 4; ++j) {
      if (which == 1) v[j] = ((const f32x4*)src)[lane + 64 * j];
      else { const u32x2 w_ = *(const u32x2*)((const char*)src + 2048 + (lane + 64 * j) * 8);
             v[j][0] = __uint_as_float(w_.x << 16); v[j][1] = __uint_as_float(w_.x & 0xffff0000u); v[j][2] = __uint_as_float(w_.y << 16); v[j][3] = __uint_as_float(w_.y & 0xffff0000u); }
      ss += v[j][0] * v[j][0] + v[j][1] * v[j][1] + v[j][2] * v[j][2] + v[j][3] * v[j][3]; }
    ss = wave_sum(ss);
    const float rs = rsqrtf(ss * (1.f / 1024.f) + 1e-6f);
    float am = 0.f;
#pragma unroll
    for (int j = 0; j < 4; ++j) {
#pragma unroll
      for (int e = 0; e < 4; ++e) { v[j][e] = v[j][e] * rs * gm[j][e] + hm[j][e]; am = fmaxf(am, fabsf(v[j][e])); }
    }
    if (which == 2) {
#pragma unroll
      for (int j = 0; j < 4; ++j) { u32x2 o; o.x = cvtpk(v[j][0], v[j][1]); o.y = cvtpk(v[j][2], v[j][3]); ST8U(lastm, p.h2 + (size_t)m * DM + (lane + 64 * j) * 4, o); }
    }
    am = xmax32(am); am = xmax16(am);
    am = fmaxf(am, dppf_(am, 0x128)); am = fmaxf(am, dppf_(am, 0x141)); am = fmaxf(am, dppf_(am, 0x4E)); am = fmaxf(am, dppf_(am, 0xB1));
    const float step = am > 0.f ? am * (1.f / 127.f) : 1.f, inv = 1.f / step;
#pragma unroll
    for (int j = 0; j < 4; ++j) {
      const int q0 = (int)rintf(v[j][0] * inv), q1 = (int)rintf(v[j][1] * inv), q2 = (int)rintf(v[j][2] * inv), q3 = (int)rintf(v[j][3] * inv);
      const uint32_t qw_ = (uint32_t)(q0 & 0xff) | ((uint32_t)(q1 & 0xff) << 8) | ((uint32_t)(q2 & 0xff) << 16) | ((uint32_t)(q3 & 0xff) << 24);
      ST4U(lastm, dst8 + (size_t)m * DM + (lane + 64 * j) * 4, qw_);
    }
    if (lane == 0) dsts[m] = step;
  }
}

__device__ void phase_wq8(const float* w, int N, unsigned char* out8, float* scale, float* smem) {
  const int K = 1024;
  float* red = smem;
  float* sstep = smem + 1024;
  int* tile = (int*)(smem + 1088);
  const int tid = threadIdx.x, c4 = tid & 15, kq = tid >> 4;
  const int nblk_ = (int)gridDim.x > 384 ? (int)gridDim.x - 384 : (int)gridDim.x, bid_ = (int)gridDim.x > 384 ? (int)blockIdx.x - 384 : (int)blockIdx.x;
  for (int item = bid_; item >= 0 && item < (N / 64) * 3; item += nblk_) {
    const int blk = item / 3, kpart = item - blk * 3;
    const int kt0 = kpart == 0 ? 0 : (kpart == 1 ? 6 : 11), kt1 = kpart == 0 ? 6 : (kpart == 1 ? 11 : 16);
    const int n0 = blk * 64;
    const float* wb = w + n0 + c4 * 4;
    f32x4 am4 = (f32x4){0.f, 0.f, 0.f, 0.f};
#pragma unroll 1
    for (int k0 = 0; k0 < K; k0 += 256) {
      f32x4 v[16];
#pragma unroll
      for (int i = 0; i < 16; ++i) v[i] = *(const f32x4*)(wb + (size_t)(k0 + kq + 16 * i) * N);
#pragma unroll
      for (int i = 0; i < 16; ++i) { am4[0] = fmaxf(am4[0], fabsf(v[i][0])); am4[1] = fmaxf(am4[1], fabsf(v[i][1])); am4[2] = fmaxf(am4[2], fabsf(v[i][2])); am4[3] = fmaxf(am4[3], fabsf(v[i][3])); }
    }
    __syncthreads();
    *(f32x4*)(red + kq * 64 + c4 * 4) = am4;
    __syncthreads();
    if (tid < 64) {
      float a4 = 0.f;
#pragma unroll
      for (int g = 0; g < 16; ++g) a4 = fmaxf(a4, red[g * 64 + tid]);
      const float st = a4 > 0.f ? a4 * (1.f / 127.f) : 1.f;
      sstep[tid] = st; if (kpart == 0) scale[n0 + tid] = st;
    }
    __syncthreads();
    const f32x4 st4 = *(const f32x4*)(sstep + c4 * 4);
    const float i0 = 1.f / st4[0], i1 = 1.f / st4[1], i2 = 1.f / st4[2], i3 = 1.f / st4[3];
    f32x4 nx[4];
#pragma unroll
    for (int i = 0; i < 4; ++i) nx[i] = *(const f32x4*)(wb + (size_t)(kt0 * 64 + kq + 16 * i) * N);
    for (int k0 = kt0 * 64; k0 < kt1 * 64; k0 += 64) {
      f32x4 cur[4];
#pragma unroll
      for (int i = 0; i < 4; ++i) cur[i] = nx[i];
      if (k0 + 64 < kt1 * 64) {
#pragma unroll
        for (int i = 0; i < 4; ++i) nx[i] = *(const f32x4*)(wb + (size_t)(k0 + 64 + kq + 16 * i) * N);
      }
#pragma unroll
      for (int i = 0; i < 4; ++i) {
        int* tr = tile + (kq + 16 * i) * 65 + c4 * 4;
        tr[0] = (int)rintf(cur[i][0] * i0); tr[1] = (int)rintf(cur[i][1] * i1); tr[2] = (int)rintf(cur[i][2] * i2); tr[3] = (int)rintf(cur[i][3] * i3);
      }
      __syncthreads();
      {
        const int r = tid >> 2, part = tid & 3;
        u32x4 o;
#pragma unroll
        for (int wd = 0; wd < 4; ++wd) {
          const int kb = part * 16 + wd * 4;
          o[wd] = (uint32_t)(tile[kb * 65 + r] & 0xff) | ((uint32_t)(tile[(kb + 1) * 65 + r] & 0xff) << 8) | ((uint32_t)(tile[(kb + 2) * 65 + r] & 0xff) << 16) | ((uint32_t)(tile[(kb + 3) * 65 + r] & 0xff) << 24);
        }
        *(u32x4*)(out8 + (size_t)(n0 + r) * K + k0 + part * 16) = o;
      }
      __syncthreads();
    }
  }
}

#define QSCALE 0.18033688f
#define GG_BUF_BYTES 32768
template <bool I8, bool AMAP, typename ACC>
__device__ __forceinline__ void gemm_mainloop_g(const char* __restrict__ A, const int ldab, const char* __restrict__ Bt, const int m0, const int n0, char* sm, ACC (&acc)[4][4]) {
  constexpr int NK = I8 ? 8 : 16, ldbb = I8 ? 1024 : 2048;
  const int tid = threadIdx.x, lane = tid & 63, wave = tid >> 6, wr = wave >> 1, wc = wave & 1;
#pragma unroll
  for (int i = 0; i < 4; ++i)
#pragma unroll
    for (int j = 0; j < 4; ++j) { acc[i][j][0] = 0; acc[i][j][1] = 0; acc[i][j][2] = 0; acc[i][j][3] = 0; }
  const int srow = wave * 8 + (lane >> 3), sch = (lane & 7) ^ (4 * (wave & 1) + (lane >> 4));
  const char* Ag = A + (size_t)(m0 + srow) * ldab + sch * 16;
  const char* Bg = Bt + (size_t)(n0 + srow) * ldbb + sch * 16;
  const int fr = lane & 15, fq = lane >> 4;
  const int aoff0 = (wr * 64 + fr) * 128 + ((fq ^ (fr >> 1)) * 16), boff0 = (wc * 64 + fr) * 128 + ((fq ^ (fr >> 1)) * 16);
#define GG_STAGE(BUF, KT) { const int k0_ = (KT) * 128; const int ka_ = AMAP ? (k0_ < 1024 ? k0_ : k0_ + 2816) : k0_; \
    const unsigned lb_ = __builtin_amdgcn_readfirstlane(lds0 + (unsigned)((BUF) * GG_BUF_BYTES)); unsigned m0s_; \
    const char* a0_ = Ag + ka_; const char* a1_ = a0_ + (size_t)32 * ldab; const char* a2_ = a0_ + (size_t)64 * ldab; const char* a3_ = a0_ + (size_t)96 * ldab; \
    const char* b0_ = Bg + k0_; const char* b1_ = b0_ + (size_t)32 * ldbb; const char* b2_ = b0_ + (size_t)64 * ldbb; const char* b3_ = b0_ + (size_t)96 * ldbb; \
    asm volatile("s_mov_b32 %0, m0\n\t" \
                 "s_mov_b32 m0, %1\n\ts_nop 0\n\tglobal_load_lds_dwordx4 %2, off\n\t" \
                 "s_add_u32 m0, %1, 0x4000\n\ts_nop 0\n\tglobal_load_lds_dwordx4 %6, off\n\t" \
                 "s_add_u32 m0, %1, 0x1000\n\ts_nop 0\n\tglobal_load_lds_dwordx4 %3, off\n\t" \
                 "s_add_u32 m0, %1, 0x5000\n\ts_nop 0\n\tglobal_load_lds_dwordx4 %7, off\n\t" \
                 "s_add_u32 m0, %1, 0x2000\n\ts_nop 0\n\tglobal_load_lds_dwordx4 %4, off\n\t" \
                 "s_add_u32 m0, %1, 0x6000\n\ts_nop 0\n\tglobal_load_lds_dwordx4 %8, off\n\t" \
                 "s_add_u32 m0, %1, 0x3000\n\ts_nop 0\n\tglobal_load_lds_dwordx4 %5, off\n\t" \
                 "s_add_u32 m0, %1, 0x7000\n\ts_nop 0\n\tglobal_load_lds_dwordx4 %9, off\n\t" \
                 "s_mov_b32 m0, %0" \
                 : "=&s"(m0s_) : "s"(lb_), "v"(a0_), "v"(a1_), "v"(a2_), "v"(a3_), "v"(b0_), "v"(b1_), "v"(b2_), "v"(b3_) : "memory", "scc"); }
  const unsigned lds0 = (unsigned)(size_t)(LAS char*)sm + (unsigned)(wave * 1024);
  GG_STAGE(0, 0);
  asm volatile("s_waitcnt vmcnt(0)" ::: "memory");
  __syncthreads();
  for (int kt = 0; kt < NK; ++kt) {
    const int buf = kt & 1;
    if (kt + 1 < NK) GG_STAGE(buf ^ 1, kt + 1);
    const char* As = sm + buf * GG_BUF_BYTES;
    const char* Bs = As + 16384;
#pragma unroll
    for (int ks = 0; ks < 2; ++ks) {
      u32x4 af[4], bfr[4];
#pragma unroll
      for (int i = 0; i < 4; ++i) af[i] = *(const u32x4*)(As + ((aoff0 + i * 2048) ^ (ks * 64)));
#pragma unroll
      for (int j = 0; j < 4; ++j) bfr[j] = *(const u32x4*)(Bs + ((boff0 + j * 2048) ^ (ks * 64)));
#pragma unroll
      for (int i = 0; i < 4; ++i)
#pragma unroll
        for (int j = 0; j < 4; ++j) {
          if constexpr (I8) acc[i][j] = __builtin_amdgcn_mfma_i32_16x16x64_i8(__builtin_bit_cast(i32x4, bfr[j]), __builtin_bit_cast(i32x4, af[i]), acc[i][j], 0, 0, 0);
          else acc[i][j] = __builtin_amdgcn_mfma_f32_16x16x32_bf16(__builtin_bit_cast(bf16x8, bfr[j]), __builtin_bit_cast(bf16x8, af[i]), acc[i][j], 0, 0, 0);
        }
    }
    asm volatile("s_waitcnt vmcnt(0)" ::: "memory");
    __syncthreads();
  }
}

template <int MODE>
__device__ void phase_gemm(const P& p, char* smem, int mrow0, int Mrows, const bool f8only = false) {
  constexpr int N = MODE == 0 ? 2688 : MODE == 1 ? 1024 : 2048;
  constexpr int lda = MODE == 1 ? DIN : 1024;
  const bf16_t* A = MODE == 0 ? p.h : MODE == 1 ? p.proj : p.h2;
  const bf16_t* Bt = MODE == 0 ? p.w_inT : MODE == 1 ? p.w_outT : p.wqT;
  const int tid = threadIdx.x, lane = tid & 63, wave = tid >> 6, wr = wave >> 1, wc = wave & 1;
  const int nN = N / 128, nM = Mrows / 128;
  const int grp = blockIdx.x & 7, gidx = blockIdx.x >> 3, gsz = gridDim.x >> 3;
  const bool xcd_order = (gridDim.x & 7) == 0 && (nM & 7) == 0;
  const int ntl = xcd_order ? (nM >> 3) * nN : nM * nN;
  for (int u = xcd_order ? gidx : (int)blockIdx.x; u < ntl; u += xcd_order ? gsz : (int)gridDim.x) {
    const int tm = xcd_order ? (u / nN) * 8 + grp : u / nN, tn = u % nN;
    const bool lastt = u + (xcd_order ? gsz : (int)gridDim.x) >= ntl;
    const int m0 = mrow0 + tm * 128, n0 = tn * 128;
    f32x4 acc[4][4];
    if (MODE == 0) {
      i32x4 ai[4][4];
      gemm_mainloop_g<true, false>((const char*)p.h8, 1024, (const char*)p.w_in8, m0, n0, smem, ai);
#pragma unroll
      for (int i = 0; i < 4; ++i) {
        const float sa = p.hs1[m0 + wr * 64 + i * 16 + (lane & 15)];
#pragma unroll
        for (int j = 0; j < 4; ++j) {
          const f32x4 sb = *(const f32x4*)(p.w_in_s + n0 + wc * 64 + j * 16 + (lane >> 4) * 4);
          acc[i][j][0] = (float)ai[i][j][0] * sa * sb[0]; acc[i][j][1] = (float)ai[i][j][1] * sa * sb[1];
          acc[i][j][2] = (float)ai[i][j][2] * sa * sb[2]; acc[i][j][3] = (float)ai[i][j][3] * sa * sb[3];
        }
      }
    } else gemm_mainloop_g<false, MODE == 1>((const char*)A, lda * 2, (const char*)Bt, m0, n0, smem, acc);
    int bb, t_, T_; tok_info(m0, bb, t_, T_);
    if (MODE == 0) {
      bf16_t* stg = (bf16_t*)smem;
#pragma unroll
      for (int i = 0; i < 4; ++i)
#pragma unroll
        for (int j = 0; j < 4; ++j) {
          const f32x4 a = acc[i][j];
          u32x2 o; o.x = pack2(a[0], a[1]); o.y = pack2(a[2], a[3]);
          *(u32x2*)(stg + (wr * 64 + i * 16 + (lane & 15)) * 136 + wc * 64 + j * 16 + (lane >> 4) * 4) = o;
        }
      __syncthreads();
      if (tn >= 15 && tn < 20) {
        const int row = tid >> 1, hh = tid & 1;
        int b2, t, T2; tok_info(m0 + row, b2, t, T2);
        bf16_t* sp = stg + row * 136 + hh * 64;
        float ss = 0.f;
#pragma unroll
        for (int k = 0; k < 8; ++k) {
          const u32x4 w = *(const u32x4*)(sp + k * 8);
          ss += bflo(w.x) * bflo(w.x) + bfhi(w.x) * bfhi(w.x) + bflo(w.y) * bflo(w.y) + bfhi(w.y) * bfhi(w.y)
              + bflo(w.z) * bflo(w.z) + bfhi(w.z) * bfhi(w.z) + bflo(w.w) * bflo(w.w) + bfhi(w.w) * bfhi(w.w);
        }
        const float rs = rsqrtf(ss * (1.f / 64.f) + 1e-6f) * (tn < 19 ? QSCALE : 1.f);
        const float* g = tn < 19 ? p.qn_g : p.kn_g;
#pragma unroll
        for (int hf = 0; hf < 2; ++hf) {
          const float* rp = p.rope + (hf == 0 ? (t >> 6) : (t & 63)) * 32;
          float x[32];
#pragma unroll
          for (int k = 0; k < 4; ++k) {
            const u32x4 w = *(const u32x4*)(sp + hf * 32 + k * 8);
            x[8 * k + 0] = bflo(w.x); x[8 * k + 1] = bfhi(w.x); x[8 * k + 2] = bflo(w.y); x[8 * k + 3] = bfhi(w.y);
            x[8 * k + 4] = bflo(w.z); x[8 * k + 5] = bfhi(w.z); x[8 * k + 6] = bflo(w.w); x[8 * k + 7] = bfhi(w.w);
          }
#pragma unroll
          for (int j = 0; j < 16; ++j) {
            const f32x2 rr = *(const f32x2*)(rp + 2 * j);
            const float y0 = x[j] * rs * g[hf * 32 + j], y1 = x[j + 16] * rs * g[hf * 32 + j + 16];
            x[j] = y0 * rr.x - y1 * rr.y; x[j + 16] = y0 * rr.y + y1 * rr.x;
          }
          if (!f8only) {
#pragma unroll
            for (int k = 0; k < 4; ++k) {
              u32x4 w; w.x = cvtpk(x[8 * k], x[8 * k + 1]); w.y = cvtpk(x[8 * k + 2], x[8 * k + 3]); w.z = cvtpk(x[8 * k + 4], x[8 * k + 5]); w.w = cvtpk(x[8 * k + 6], x[8 * k + 7]);
              *(u32x4*)(sp + hf * 32 + k * 8) = w;
            }
          }
          {
            const float f8s = tn < 19 ? 8.f : 1.f;
            unsigned char* d8 = tn < 19 ? p.Q8 + ((size_t)(m0 + row) * 8 + (tn - 15) * 2 + hh) * 64 + hf * 32 : p.K8 + ((size_t)hh * NTOK + m0 + row) * 64 + hf * 32;
            u32x4 wa, wb;
#define F8PK(A, B, C, D) (uint32_t)__builtin_amdgcn_cvt_pk_fp8_f32((C) * f8s, (D) * f8s, __builtin_amdgcn_cvt_pk_fp8_f32((A) * f8s, (B) * f8s, 0, false), true)
            wa.x = F8PK(x[0], x[1], x[2], x[3]); wa.y = F8PK(x[4], x[5], x[6], x[7]); wa.z = F8PK(x[8], x[9], x[10], x[11]); wa.w = F8PK(x[12], x[13], x[14], x[15]);
            wb.x = F8PK(x[16], x[17], x[18], x[19]); wb.y = F8PK(x[20], x[21], x[22], x[23]); wb.z = F8PK(x[24], x[25], x[26], x[27]); wb.w = F8PK(x[28], x[29], x[30], x[31]);
            ST16U(lastt, d8, wa); ST16U(lastt, d8 + 16, wb);
          }
          __builtin_amdgcn_sched_barrier(0);
        }
        __syncthreads();
      }
      if (tn < 14) {
        const int ch = tid & 15, col = n0 + ch * 8;
        const f32x4 mA = *(const f32x4*)(p.mu + col), mB = *(const f32x4*)(p.mu + col + 4);
#pragma unroll
        for (int k = 0; k < 8; ++k) {
          const int row = (tid >> 4) + 16 * k;
          const u32x4 c = *(const u32x4*)(stg + row * 136 + ch * 8);
          if (row < 2 || row > 125) *(u32x4*)(p.proj + (size_t)(m0 + row) * DIN + col) = c;
          if (row > 0 && row < 127) {
            const u32x4 pv = *(const u32x4*)(stg + (row - 1) * 136 + ch * 8), nx = *(const u32x4*)(stg + (row + 1) * 136 + ch * 8);
            float o[8];
#pragma unroll
            for (int w = 0; w < 4; ++w) {
              const float c0 = bflo(c[w]), c1 = bfhi(c[w]);
              const float mu0 = w < 2 ? mA[2 * w] : mB[2 * w - 4], mu1 = w < 2 ? mA[2 * w + 1] : mB[2 * w - 3];
              o[2 * w] = c0 + mu0 * (0.5f * (bflo(pv[w]) + bflo(nx[w])) - c0);
              o[2 * w + 1] = c1 + mu1 * (0.5f * (bfhi(pv[w]) + bfhi(nx[w])) - c1);
            }
            if (tn == 12) {
#pragma unroll
              for (int e = 0; e < 8; ++e) { const float ex = __expf(2.f * o[e]); o[e] = 1.f - 2.f / (ex + 1.f); }
            }
            u32x4 r; r.x = cvtpk(o[0], o[1]); r.y = cvtpk(o[2], o[3]); r.z = cvtpk(o[4], o[5]); r.w = cvtpk(o[6], o[7]);
            if (tn < 8) ST16U(lastt, p.ps_rk + (size_t)(m0 + row) * 1024 + col, r);
            else ST16U(lastt, p.ps_vwa + (size_t)(m0 + row) * 768 + (col - 1024), r);
          }
        }
      } else if (tn < 19) {
        if (tn == 14 || !f8only) {
#pragma unroll
          for (int k = 0; k < 8; ++k) {
            const int c = tid + 256 * k, row = c >> 4, ch = c & 15;
            { const u32x4 w_ = *(const u32x4*)(stg + row * 136 + ch * 8); ST16U(lastt, p.proj + (size_t)(m0 + row) * DIN + n0 + ch * 8, w_); }
          }
        }
      } else if (tn == 19) {
        if (!f8only) {
#pragma unroll
          for (int k = 0; k < 8; ++k) {
            const int c = tid + 256 * k, row = c >> 4, ch = c & 15;
            *(u32x4*)(p.Kc + ((size_t)(ch >> 3) * NTOK + m0 + row) * 64 + (ch & 7) * 8) = *(const u32x4*)(stg + row * 136 + ch * 8);
          }
        }
      } else {
        const int c = tid >> 1, hf = tid & 1;
        const bf16_t* col = stg + (hf * 64) * 136 + c;
        bf16_t* dst = p.Vt + (size_t)c * NTOK + m0 + hf * 64;
        if (!f8only) {
#pragma unroll
          for (int q4 = 0; q4 < 8; ++q4) {
            u32x4 w;
            w.x = (uint32_t)col[(q4 * 8 + 0) * 136] | ((uint32_t)col[(q4 * 8 + 1) * 136] << 16);
            w.y = (uint32_t)col[(q4 * 8 + 2) * 136] | ((uint32_t)col[(q4 * 8 + 3) * 136] << 16);
            w.z = (uint32_t)col[(q4 * 8 + 4) * 136] | ((uint32_t)col[(q4 * 8 + 5) * 136] << 16);
            w.w = (uint32_t)col[(q4 * 8 + 6) * 136] | ((uint32_t)col[(q4 * 8 + 7) * 136] << 16);
            *(u32x4*)(dst + q4 * 8) = w;
          }
        }
        unsigned char* d8 = p.V8t + (size_t)c * NTOK + m0 + hf * 64;
#pragma unroll
        for (int g4 = 0; g4 < 4; ++g4) {
          u32x4 w8;
#pragma unroll
          for (int u = 0; u < 4; ++u) {
            const int dw = g4 * 4 + u, kb = 32 * ((dw >> 2) & 1) + 4 * (dw >> 3) + 8 * (dw & 3);
            const float f0 = bf2f(col[(kb + 0) * 136]), f1 = bf2f(col[(kb + 1) * 136]), f2 = bf2f(col[(kb + 2) * 136]), f3 = bf2f(col[(kb + 3) * 136]);
            w8[u] = (uint32_t)__builtin_amdgcn_cvt_pk_fp8_f32(f2, f3, __builtin_amdgcn_cvt_pk_fp8_f32(f0, f1, 0, false), true);
          }
          ST16U(lastt, d8 + g4 * 16, w8);
        }
      }
      __syncthreads();
    } else if (MODE == 1) {
      float* stg = (float*)smem;
#pragma unroll
      for (int i = 0; i < 4; ++i)
#pragma unroll
        for (int j = 0; j < 4; ++j) *(f32x4*)(stg + (wr * 64 + i * 16 + (lane & 15)) * 132 + wc * 64 + j * 16 + (lane >> 4) * 4) = acc[i][j];
      __syncthreads();
#pragma unroll
      for (int k = 0; k < 16; ++k) {
        const int c = tid + 256 * k, row = c >> 5, ch = c & 31;
        const int m = m0 + row, n = n0 + ch * 4;
        const float* xs = m < 16384 ? p.x_prompt + (size_t)m * DM : p.x_sample + (size_t)(m - 16384) * DM;
        const f32x4 xv = *(const f32x4*)(xs + n), gt = *(const f32x4*)(p.mod + bb * 6144 + 2048 + n), a = *(const f32x4*)(stg + row * 132 + ch * 4);
        f32x4 o; o[0] = xv[0] + gt[0] * a[0]; o[1] = xv[1] + gt[1] * a[1]; o[2] = xv[2] + gt[2] * a[2]; o[3] = xv[3] + gt[3] * a[3];
        u32x2 ob; ob.x = cvtpk(o[0], o[1]); ob.y = cvtpk(o[2], o[3]);
        ST8U(lastt, (char*)p.out + (size_t)m * 4096 + 2048 + n * 2, ob);
      }
      __syncthreads();
    }
  }
  __syncthreads();
}

__device__ void phase_shift(const P& p) {
  for (int idx = blockIdx.x * NTHR + threadIdx.x; idx < (NTOK / 64) * 224; idx += gridDim.x * NTHR) {
    const int mi = idx / 224, ch = idx - mi * 224, col = ch * 8, m = (mi >> 1) * 128 + (mi & 1) * 127;
    int bb, t, T; tok_info(m, bb, t, T);
    const bf16_t* q = p.proj + (size_t)m * DIN + col;
    const u32x4 c = *(const u32x4*)q;
    u32x4 pv = (u32x4){0u, 0u, 0u, 0u}, nx = (u32x4){0u, 0u, 0u, 0u};
    if (t > 0) pv = *(const u32x4*)(q - DIN);
    if (t < T - 1) nx = *(const u32x4*)(q + DIN);
    const f32x4 m0 = *(const f32x4*)(p.mu + col), m1 = *(const f32x4*)(p.mu + col + 4);
    float o[8];
#pragma unroll
    for (int w = 0; w < 4; ++w) {
      const float c0 = bflo(c[w]), c1 = bfhi(c[w]);
      const float mu0 = w < 2 ? m0[2 * w] : m1[2 * w - 4], mu1 = w < 2 ? m0[2 * w + 1] : m1[2 * w - 3];
      o[2 * w] = c0 + mu0 * (0.5f * (bflo(pv[w]) + bflo(nx[w])) - c0);
      o[2 * w + 1] = c1 + mu1 * (0.5f * (bfhi(pv[w]) + bfhi(nx[w])) - c1);
    }
    if (col >= 1536 && col < 1664) {
#pragma unroll
      for (int e = 0; e < 8; ++e) { const float ex = __expf(2.f * o[e]); o[e] = 1.f - 2.f / (ex + 1.f); }
    }
    u32x4 r; r.x = cvtpk(o[0], o[1]); r.y = cvtpk(o[2], o[3]); r.z = cvtpk(o[4], o[5]); r.w = cvtpk(o[6], o[7]);
    if (col < 1024) *(u32x4*)(p.ps_rk + (size_t)m * 1024 + col) = r;
    else *(u32x4*)(p.ps_vwa + (size_t)m * 768 + (col - 1024)) = r;
  }
}

__device__ void phase_lorafrag(const P& p) {
  for (int idx = blockIdx.x * NTHR + threadIdx.x; idx < 65536; idx += gridDim.x * NTHR) {
    int j = idx & 7, lane = (idx >> 3) & 63, ks = (idx >> 9) & 1, i = (idx >> 10) & 3, hh = (idx >> 12) & 7, d = idx >> 15;
    int l = 32 * ks + 8 * (lane >> 4) + j, n = hh * 64 + 16 * i + (lane & 15);
    p.w2f[idx] = f2bf(p.w2[(size_t)(d * 64 + l) * 512 + n]);
    p.a2f[idx] = f2bf(p.a2[(size_t)(d * 64 + l) * 512 + n]);
  }
}

#define SC_CHUNK_BYTES 13568
#define SC_AF 0
#define SC_RF 2048
#define SC_LAK 4096
#define SC_TM 5120
#define SC_MRK 6144
#define SC_VMF 7168
#define SC_BKF 9216
#define SC_GC 13312
#define SC_WAVE_BYTES 5376
__device__ __forceinline__ float dpp_shr1(float x) { return __int_as_float(__builtin_amdgcn_update_dpp(0, __float_as_int(x), 0x111, 0xf, 0xf, true)); }
__device__ __forceinline__ float dpp_shr2(float x) { return __int_as_float(__builtin_amdgcn_update_dpp(0, __float_as_int(x), 0x112, 0xf, 0xf, true)); }
__device__ __forceinline__ float dpp_shr4(float x) { return __int_as_float(__builtin_amdgcn_update_dpp(0, __float_as_int(x), 0x114, 0xf, 0xf, true)); }
__device__ __forceinline__ float dpp_shr8(float x) { return __int_as_float(__builtin_amdgcn_update_dpp(0, __float_as_int(x), 0x118, 0xf, 0xf, true)); }
__device__ __forceinline__ void wave_lds_fence() { __builtin_amdgcn_fence(__ATOMIC_RELEASE, "wavefront"); __builtin_amdgcn_wave_barrier(); __builtin_amdgcn_fence(__ATOMIC_ACQUIRE, "wavefront"); }
__device__ __forceinline__ f32x4 ld_shift4(const bf16_t* proj, const float* mu, int m, bool hp, bool hn, int col) {
  const bf16_t* q = proj + (size_t)m * DIN + col;
  u32x2 c = *(const u32x2*)q;
  u32x2 pv = (u32x2){0u, 0u}, nx = (u32x2){0u, 0u};
  if (hp) pv = *(const u32x2*)(q - DIN);
  if (hn) nx = *(const u32x2*)(q + DIN);
  f32x4 m4 = *(const f32x4*)(mu + col);
  f32x4 o;
  float c0 = bflo(c.x), c1 = bfhi(c.x), c2 = bflo(c.y), c3 = bfhi(c.y);
  o[0] = c0 + m4[0] * (0.5f * (bflo(pv.x) + bflo(nx.x)) - c0);
  o[1] = c1 + m4[1] * (0.5f * (bfhi(pv.x) + bfhi(nx.x)) - c1);
  o[2] = c2 + m4[2] * (0.5f * (bflo(pv.y) + bflo(nx.y)) - c2);
  o[3] = c3 + m4[3] * (0.5f * (bfhi(pv.y) + bfhi(nx.y)) - c3);
  return o;
}
__device__ __forceinline__ bf16x8 mk_frag(f32x4 a, f32x4 b) {
  union { bf16x8 v; uint32_t u[4]; } f;
  f.u[0] = cvtpk(a[0], a[1]); f.u[1] = cvtpk(a[2], a[3]); f.u[2] = cvtpk(b[0], b[1]); f.u[3] = cvtpk(b[2], b[3]);
  return f.v;
}
#define MFMA16(a, b, c) __builtin_amdgcn_mfma_f32_16x16x32_bf16((a), (b), (c), 0, 0, 0)

#define SCAN_H 3
#define SCAN_R 5
#define SCAN_GROUP_BYTES (4 * SC_CHUNK_BYTES)
#define SCAN_SPIN_CAP (1u << 22)
__device__ void phase_scan(const P& p, char* smem) {
  const int tid = threadIdx.x, lane = tid & 63, wave = tid >> 6, t = lane & 15, q = lane >> 4;
  char* wsc = smem + 4 * SC_CHUNK_BYTES + wave * SC_WAVE_BYTES;
  bf16_t* sT0 = (bf16_t*)wsc;
  bf16_t* sT1 = (bf16_t*)(wsc + 2176);
  float* LT = (float*)(wsc + 4352);
  float* cst = (float*)(smem + 4 * SC_CHUNK_BYTES + 4 * SC_WAVE_BYTES);
  const f32x4 z4 = (f32x4){0.f, 0.f, 0.f, 0.f};
  const int HH = (int)gridDim.x >= 96 * (1 + SCAN_H) ? SCAN_H : ((int)gridDim.x / 96 - 1 < 1 ? 1 : (int)gridDim.x / 96 - 1);
  if ((int)blockIdx.x >= 96 + 96 * HH) return;
  const bool consumer = blockIdx.x < 96;
  const int cid = consumer ? blockIdx.x : (blockIdx.x - 96) % 96;
  const int hj = consumer ? 0 : (blockIdx.x - 96) / 96;
  int d, h, T, mbase;
  if (cid < 32) { d = cid >> 4; int bs = (cid & 15) >> 3; h = cid & 7; T = 8192; mbase = 16384 + bs * 8192; }
  else { int c2 = cid - 32; d = c2 >> 5; int b = (c2 & 31) >> 3; h = c2 & 7; T = 4096; mbase = b * 4096; }
  const int ngroups = T / 64;
  unsigned* ready = p.sflag + cid * 128;
  unsigned* progress = p.sflag + 96 * 128 + cid * 16;
  char* ring = p.ring + (size_t)cid * SCAN_R * SCAN_GROUP_BYTES;
  if (!consumer) {
    __syncthreads();
    for (int i = tid; i < 320; i += NTHR) {
      const int w_ = i >> 6, n = i & 63;
      cst[i] = w_ == 0 ? p.w0[d * 512 + h * 64 + n] : w_ == 1 ? p.a0[d * 512 + h * 64 + n] : w_ == 2 ? p.k_k[h * 64 + n] : w_ == 3 ? p.k_a[h * 64 + n] : p.r_k[h * 64 + n];
    }
    u32x4 Rv[2], Rw[2], Ra[2]; u32x2 Rr[4], Rk[4];
#define SCAN_LOAD_RAW(M_) { const bf16_t* pv_ = p.ps_vwa + (size_t)(M_) * 768; const bf16_t* pr_ = p.ps_rk + (size_t)(M_) * 1024; \
      Rv[0] = *(const u32x4*)(pv_ + h * 64 + 16 * q); Rv[1] = *(const u32x4*)(pv_ + h * 64 + 16 * q + 8); \
      Rw[0] = *(const u32x4*)(pv_ + 512 + d * 64 + 8 * q); Rw[1] = *(const u32x4*)(pv_ + 512 + d * 64 + 32 + 8 * q); \
      Ra[0] = *(const u32x4*)(pv_ + 640 + d * 64 + 8 * q); Ra[1] = *(const u32x4*)(pv_ + 640 + d * 64 + 32 + 8 * q); \
      _Pragma("unroll") for (int i_ = 0; i_ < 4; ++i_) { Rr[i_] = *(const u32x2*)(pr_ + h * 64 + 16 * i_ + 4 * q); Rk[i_] = *(const u32x2*)(pr_ + 512 + h * 64 + 16 * i_ + 4 * q); } }
    {
      const int st = (hj * 4 + wave) * 16 + t;
      const int tt = d ? T - 1 - st : st;
      SCAN_LOAD_RAW(mbase + tt);
    }
    for (int g = hj; g < ngroups; g += HH) {
      if (tid == 0 && g >= SCAN_R) {
        unsigned sp = 0;
        while (__hip_atomic_load(progress, __ATOMIC_RELAXED, __HIP_MEMORY_SCOPE_AGENT) < (unsigned)(g - SCAN_R + 1)) { __builtin_amdgcn_s_sleep(2); if (++sp > SCAN_SPIN_CAP) break; }
      }
      __syncthreads();
      {
        char* slot = smem + wave * SC_CHUNK_BYTES;
        const int st = (g * 4 + wave) * 16 + t;
        const int tt = d ? T - 1 - st : st;
        const int m = mbase + tt;
        f32x4 wlv[4], alv[4];
        {
          typedef const __attribute__((address_space(1))) bf16x8* gfrag_t;
          const size_t fo0 = ((size_t)(((d * 8 + h) * 4) * 2 * 64 + lane)) * 8;
          gfrag_t wg_ = (gfrag_t)(p.w2f + fo0), ag_ = (gfrag_t)(p.a2f + fo0);
          bf16x8 wf_[8], af_[8];
#pragma unroll
          for (int u = 0; u < 8; ++u) { wf_[u] = wg_[u * 64]; af_[u] = ag_[u * 64]; }
          __builtin_amdgcn_sched_barrier(0);
#pragma unroll
          for (int i = 0; i < 4; ++i) {
            wlv[i] = *(const f32x4*)(cst + 0 * 64 + 16 * i + 4 * q);
            alv[i] = *(const f32x4*)(cst + 1 * 64 + 16 * i + 4 * q);
#pragma unroll
            for (int ks = 0; ks < 2; ++ks) {
              wlv[i] = MFMA16(wf_[i * 2 + ks], __builtin_bit_cast(bf16x8, Rw[ks]), wlv[i]);
              alv[i] = MFMA16(af_[i * 2 + ks], __builtin_bit_cast(bf16x8, Ra[ks]), alv[i]);
            }
          }
        }
        __builtin_amdgcn_sched_barrier(0);
        *(u32x2*)(sT0 + t * 68 + 16 * q) = (u32x2){Rv[0].x, Rv[0].y};
        *(u32x2*)(sT0 + t * 68 + 16 * q + 4) = (u32x2){Rv[0].z, Rv[0].w};
        *(u32x2*)(sT0 + t * 68 + 16 * q + 8) = (u32x2){Rv[1].x, Rv[1].y};
        *(u32x2*)(sT0 + t * 68 + 16 * q + 12) = (u32x2){Rv[1].z, Rv[1].w};
        wave_lds_fence();
#pragma unroll
        for (int w2_ = 0; w2_ < 4; ++w2_) {
          uint32_t v0 = sT0[(4 * q + 0) * 68 + 16 * w2_ + t], v1 = sT0[(4 * q + 1) * 68 + 16 * w2_ + t];
          uint32_t v2 = sT0[(4 * q + 2) * 68 + 16 * w2_ + t], v3 = sT0[(4 * q + 3) * 68 + 16 * w2_ + t];
          u32x2 o; o.x = v0 | (v1 << 16); o.y = v2 | (v3 << 16);
          *(u32x2*)(slot + SC_VMF + (w2_ * 64 + lane) * 8) = o;
        }
        wave_lds_fence();
        float ssq = 0.f;
#pragma unroll
        for (int i = 0; i < 4; ++i) {
          const f32x4 kk4 = *(const f32x4*)(cst + 2 * 64 + 16 * i + 4 * q);
          float kv;
          kv = bflo(Rk[i].x) * kk4[0]; ssq += kv * kv; kv = bfhi(Rk[i].x) * kk4[1]; ssq += kv * kv;
          kv = bflo(Rk[i].y) * kk4[2]; ssq += kv * kv; kv = bfhi(Rk[i].y) * kk4[3]; ssq += kv * kv;
        }
        ssq = xsum16(ssq); ssq = xsum32(ssq);
        const float inv = 1.f / fmaxf(sqrtf(ssq), 1e-12f);
        float cs = 0.f;
#pragma unroll
        for (int i = 0; i < 4; ++i) {
          __builtin_amdgcn_sched_barrier(0);
          const f32x4 wl = wlv[i], al = alv[i];
          const f32x4 kk4 = *(const f32x4*)(cst + 2 * 64 + 16 * i + 4 * q);
          const f32x4 ka4 = *(const f32x4*)(cst + 3 * 64 + 16 * i + 4 * q);
          const f32x4 rk4 = *(const f32x4*)(cst + 4 * 64 + 16 * i + 4 * q);
          f32x4 rS, kSi;
          rS[0] = bflo(Rr[i].x); rS[1] = bfhi(Rr[i].x); rS[2] = bflo(Rr[i].y); rS[3] = bfhi(Rr[i].y);
          kSi[0] = bflo(Rk[i].x); kSi[1] = bfhi(Rk[i].x); kSi[2] = bflo(Rk[i].y); kSi[3] = bfhi(Rk[i].y);
          f32x4 gc4, At, Bt, Kt, Rt, Bh, Kh;
#pragma unroll
          for (int e = 0; e < 4; ++e) {
            const float lw = -0.60653066f * __builtin_amdgcn_rcpf(1.f + __expf(-wl[e]));
            const float alp = __builtin_amdgcn_rcpf(1.f + __expf(-al[e]));
            float cum = lw;
            cum += dpp_shr1(cum); cum += dpp_shr2(cum); cum += dpp_shr4(cum); cum += dpp_shr8(cum);
            const float ep = __expf(cum);
            const float em = __builtin_amdgcn_rcpf(ep);
            float epv = dpp_shr1(ep); epv = (t == 0) ? 1.f : epv;
            const float ep15 = __int_as_float(__builtin_amdgcn_update_dpp(0, __float_as_int(ep), 0x15F, 0xf, 0xf, false));
            const float er = ep15 * em;
            const float kk = kSi[e] * kk4[e] * inv;
            const float kdv = kSi[e] * (1.f + (alp - 1.f) * ka4[e]);
            const float bb_ = kk * alp;
            At[e] = -kk * epv; Bt[e] = bb_ * em; Kt[e] = kdv * em; Rt[e] = rS[e] * ep;
            Bh[e] = bb_ * er; Kh[e] = kdv * er;
            gc4[e] = ep15;
            cs += rS[e] * rk4[e] * kdv;
          }
          if (t == 15) *(f32x4*)(slot + SC_GC + (16 * i + 4 * q) * 4) = gc4;
          const int fo2 = ((i >> 1) * 64 + lane) * 16 + (i & 1) * 8;
          u32x2 o;
          o.x = cvtpk(At[0], At[1]); o.y = cvtpk(At[2], At[3]); *(u32x2*)(slot + SC_AF + fo2) = o;
          o.x = cvtpk(Rt[0], Rt[1]); o.y = cvtpk(Rt[2], Rt[3]); *(u32x2*)(slot + SC_RF + fo2) = o;
          o.x = cvtpk(Bt[0], Bt[1]); o.y = cvtpk(Bt[2], Bt[3]); *(u32x2*)(slot + SC_BKF + fo2) = o;
          o.x = cvtpk(Kt[0], Kt[1]); o.y = cvtpk(Kt[2], Kt[3]); *(u32x2*)(slot + SC_BKF + 2048 + fo2) = o;
          o.x = cvtpk(Bh[0], Bh[1]); o.y = cvtpk(Bh[2], Bh[3]); *(u32x2*)(sT0 + t * 68 + 16 * i + 4 * q) = o;
          o.x = cvtpk(Kh[0], Kh[1]); o.y = cvtpk(Kh[2], Kh[3]); *(u32x2*)(sT1 + t * 68 + 16 * i + 4 * q) = o;
        }
        __builtin_amdgcn_sched_barrier(0);
        cs = xsum16(cs); cs = xsum32(cs);
        if (q == 0) p.cd[((size_t)d * NTOK + m) * 8 + h] = 0.5f * cs;
        wave_lds_fence();
        union { bf16x8 v; uint32_t u[4]; } Afu[2], Bfu[2], Kfu[2], Rfu[2];
#pragma unroll
        for (int ks = 0; ks < 2; ++ks) {
          Afu[ks].v = *(const bf16x8*)(slot + SC_AF + (ks * 64 + lane) * 16);
          Rfu[ks].v = *(const bf16x8*)(slot + SC_RF + (ks * 64 + lane) * 16);
          Bfu[ks].v = *(const bf16x8*)(slot + SC_BKF + (ks * 64 + lane) * 16);
          Kfu[ks].v = *(const bf16x8*)(slot + SC_BKF + 2048 + (ks * 64 + lane) * 16);
        }
        wave_lds_fence();
        f32x4 Lab = MFMA16(Afu[1].v, Bfu[1].v, MFMA16(Afu[0].v, Bfu[0].v, z4));
        f32x4 LakT = MFMA16(Kfu[1].v, Afu[1].v, MFMA16(Kfu[0].v, Afu[0].v, z4));
        f32x4 MrbT = MFMA16(Bfu[1].v, Rfu[1].v, MFMA16(Bfu[0].v, Rfu[0].v, z4));
        f32x4 MrkT = MFMA16(Kfu[1].v, Rfu[1].v, MFMA16(Kfu[0].v, Rfu[0].v, z4));
#pragma unroll
        for (int e = 0; e < 4; ++e) {
          const int row = 4 * q + e;
          if (!(t < row)) Lab[e] = 0.f;
          if (!(row < t)) LakT[e] = 0.f;
          if (!(row <= t)) { MrbT[e] = 0.f; MrkT[e] = 0.f; }
        }
        *(f32x4*)(LT + t * 16 + 4 * q) = Lab;
        {
          union { bf16x8 v; uint32_t u[4]; } f;
          f.u[0] = 0u; f.u[1] = 0u; f.u[2] = cvtpk(LakT[0], LakT[1]); f.u[3] = cvtpk(LakT[2], LakT[3]);
          *(bf16x8*)(slot + SC_LAK + lane * 16) = f.v;
          f.u[0] = cvtpk(MrbT[0], MrbT[1]); f.u[1] = cvtpk(MrbT[2], MrbT[3]); f.u[2] = cvtpk(MrkT[0], MrkT[1]); f.u[3] = cvtpk(MrkT[2], MrkT[3]);
          *(bf16x8*)(slot + SC_MRK + lane * 16) = f.v;
        }
        wave_lds_fence();
        {
          float x[16];
#pragma unroll
          for (int c = 15; c >= 0; --c) {
            float acc = (c == t) ? 1.f : 0.f;
#pragma unroll
            for (int s2 = c + 1; s2 < 16; ++s2) acc += x[s2] * LT[c * 16 + s2];
            x[c] = acc;
          }
          float s0 = q == 0 ? x[0] : q == 1 ? x[4] : q == 2 ? x[8] : x[12];
          float s1 = q == 0 ? x[1] : q == 1 ? x[5] : q == 2 ? x[9] : x[13];
          float s2_ = q == 0 ? x[2] : q == 1 ? x[6] : q == 2 ? x[10] : x[14];
          float s3 = q == 0 ? x[3] : q == 1 ? x[7] : q == 2 ? x[11] : x[15];
          union { bf16x8 v; uint32_t u[4]; } f;
          f.u[0] = cvtpk(s0, s1); f.u[1] = cvtpk(s2_, s3); f.u[2] = 0u; f.u[3] = 0u;
          *(bf16x8*)(slot + SC_TM + lane * 16) = f.v;
        }
#pragma unroll
        for (int i = 0; i < 4; ++i) {
          uint32_t b0 = sT0[(4 * q + 0) * 68 + 16 * i + t], b1 = sT0[(4 * q + 1) * 68 + 16 * i + t];
          uint32_t b2 = sT0[(4 * q + 2) * 68 + 16 * i + t], b3 = sT0[(4 * q + 3) * 68 + 16 * i + t];
          uint32_t k0 = sT1[(4 * q + 0) * 68 + 16 * i + t], k1 = sT1[(4 * q + 1) * 68 + 16 * i + t];
          uint32_t k2 = sT1[(4 * q + 2) * 68 + 16 * i + t], k3 = sT1[(4 * q + 3) * 68 + 16 * i + t];
          u32x4 o; o.x = b0 | (b1 << 16); o.y = b2 | (b3 << 16); o.z = k0 | (k1 << 16); o.w = k2 | (k3 << 16);
          *(u32x4*)(slot + SC_BKF + (i * 64 + lane) * 16) = o;
        }
      }
      if (g + HH < ngroups) {
        const int st = ((g + HH) * 4 + wave) * 16 + t;
        const int tt = d ? T - 1 - st : st;
        SCAN_LOAD_RAW(mbase + tt);
      }
      __syncthreads();
      {
        char* dst = ring + (size_t)(g % SCAN_R) * SCAN_GROUP_BYTES;
        const __amdgpu_buffer_rsrc_t rs = __builtin_amdgcn_make_buffer_rsrc(dst, 0, SCAN_GROUP_BYTES, 0x00020000);
        for (int i = tid; i < SCAN_GROUP_BYTES / 16; i += NTHR) __builtin_amdgcn_raw_buffer_store_b128(*(const u32x4*)(smem + i * 16), rs, (unsigned)(i * 16), 0,   16);
        asm volatile("s_waitcnt vmcnt(0)" ::: "memory");
        __syncthreads();
        if (tid == 0) __hip_atomic_store(ready + g, 1u, __ATOMIC_RELAXED, __HIP_MEMORY_SCOPE_AGENT);
      }
    }
  } else {
    const __amdgpu_buffer_rsrc_t rsY = __builtin_amdgcn_make_buffer_rsrc((void*)(p.yd + ((size_t)d * NTOK + mbase) * 512), 0, T * 1024, 0x00020000);
    const unsigned ylane = (unsigned)(h * 64 + 16 * wave + t) * 2u;
    __builtin_amdgcn_s_setprio(3);
    f32x4 Zt[4];
#pragma unroll
    for (int i = 0; i < 4; ++i) Zt[i] = z4;
    __shared__ int sc_ok;
    u32x4 pre[14];
#define SCAN_SLOT_LOAD(G_) { const __amdgpu_buffer_rsrc_t rs_ = __builtin_amdgcn_make_buffer_rsrc(ring + (size_t)((G_) % SCAN_R) * SCAN_GROUP_BYTES, 0, SCAN_GROUP_BYTES, 0x00020000); \
      _Pragma("unroll") for (int i = 0; i < 14; ++i) { const int c = tid + 256 * i; if (c < SCAN_GROUP_BYTES / 16) pre[i] = __builtin_amdgcn_raw_buffer_load_b128(rs_, (unsigned)(c * 16), 0,   16); } }
#define SCAN_WAIT_READY(G_) { if (tid == 0) { unsigned sp = 0; while (__hip_atomic_load(ready + (G_), __ATOMIC_RELAXED, __HIP_MEMORY_SCOPE_AGENT) == 0u) { __builtin_amdgcn_s_sleep(2); if (++sp > SCAN_SPIN_CAP) break; } } __syncthreads(); }
    SCAN_WAIT_READY(0);
    SCAN_SLOT_LOAD(0);
    bool have = true;
    if (tid == 0) sc_ok = (ngroups > 1) && (__hip_atomic_load(ready + 1, __ATOMIC_RELAXED, __HIP_MEMORY_SCOPE_AGENT) != 0u);
    __syncthreads();
    bool ok1 = sc_ok != 0;
    for (int g = 0; g < ngroups; ++g) {
      if (!have) { SCAN_WAIT_READY(g); SCAN_SLOT_LOAD(g); }
#pragma unroll
      for (int i = 0; i < 14; ++i) { const int c = tid + 256 * i; if (c < SCAN_GROUP_BYTES / 16) *(u32x4*)(smem + c * 16) = pre[i]; }
      __syncthreads();
      have = (g + 1 < ngroups) && ok1;
      if (have) SCAN_SLOT_LOAD(g + 1);
      unsigned fl2 = 0u;
      if (tid == 0 && g + 2 < ngroups) fl2 = __hip_atomic_load(ready + g + 2, __ATOMIC_RELAXED, __HIP_MEMORY_SCOPE_AGENT);
#pragma unroll 1
      for (int cs_ = 0; cs_ < 4; ++cs_) {
        const char* slot = smem + cs_ * SC_CHUNK_BYTES;
        bf16x8 Zb[2];
        Zb[0] = mk_frag(Zt[0], Zt[1]); Zb[1] = mk_frag(Zt[2], Zt[3]);
        const u32x2 vm = *(const u32x2*)(slot + SC_VMF + (wave * 64 + lane) * 8);
        union { bf16x8 v; uint32_t u[4]; } VB, XB, UB;
        VB.u[0] = 0u; VB.u[1] = 0u; VB.u[2] = vm.x; VB.u[3] = vm.y;
        const bf16x8 af0 = *(const bf16x8*)(slot + SC_AF + lane * 16), af1 = *(const bf16x8*)(slot + SC_AF + (64 + lane) * 16);
        const bf16x8 rf0 = *(const bf16x8*)(slot + SC_RF + lane * 16), rf1 = *(const bf16x8*)(slot + SC_RF + (64 + lane) * 16);
        const bf16x8 lakf = *(const bf16x8*)(slot + SC_LAK + lane * 16);
        const bf16x8 tmf = *(const bf16x8*)(slot + SC_TM + lane * 16);
        const bf16x8 mrkf = *(const bf16x8*)(slot + SC_MRK + lane * 16);
        f32x4 X = MFMA16(lakf, VB.v, z4);
        X = MFMA16(af0, Zb[0], X);
        X = MFMA16(af1, Zb[1], X);
        XB.u[0] = cvtpk(X[0], X[1]); XB.u[1] = cvtpk(X[2], X[3]); XB.u[2] = vm.x; XB.u[3] = vm.y;
        f32x4 U = MFMA16(tmf, XB.v, z4);
        UB.u[0] = cvtpk(U[0], U[1]); UB.u[1] = cvtpk(U[2], U[3]); UB.u[2] = vm.x; UB.u[3] = vm.y;
        f32x4 Y = MFMA16(rf0, Zb[0], z4);
        Y = MFMA16(rf1, Zb[1], Y);
        Y = MFMA16(mrkf, UB.v, Y);
#pragma unroll
        for (int i = 0; i < 4; ++i) {
          const f32x4 gc = *(const f32x4*)(slot + SC_GC + (16 * i + 4 * q) * 4);
          const bf16x8 bk = *(const bf16x8*)(slot + SC_BKF + (i * 64 + lane) * 16);
          f32x4 init; init[0] = gc[0] * Zt[i][0]; init[1] = gc[1] * Zt[i][1]; init[2] = gc[2] * Zt[i][2]; init[3] = gc[3] * Zt[i][3];
          Zt[i] = MFMA16(bk, UB.v, init);
        }
        {
          const int st0 = (g * 4 + cs_) * 16 + 4 * q;
          const int ttl = d ? T - 4 - st0 : st0;
          const unsigned vo_ = (unsigned)ttl * 1024u + ylane;
          const uint32_t y01 = cvtpk(Y[0], Y[1]), y23 = cvtpk(Y[2], Y[3]);
          const unsigned short h0 = (unsigned short)(y01 & 0xffff), h1 = (unsigned short)(y01 >> 16), h2 = (unsigned short)(y23 & 0xffff), h3 = (unsigned short)(y23 >> 16);
          __builtin_amdgcn_raw_buffer_store_b16(d ? h3 : h0, rsY, vo_, 0, 0);
          __builtin_amdgcn_raw_buffer_store_b16(d ? h2 : h1, rsY, vo_ + 1024u, 0, 0);
          __builtin_amdgcn_raw_buffer_store_b16(d ? h1 : h2, rsY, vo_ + 2048u, 0, 0);
          __builtin_amdgcn_raw_buffer_store_b16(d ? h0 : h3, rsY, vo_ + 3072u, 0, 0);
        }
      }
      if (tid == 0) { sc_ok = (fl2 != 0u); __hip_atomic_store(progress, (unsigned)(g + 1), __ATOMIC_RELAXED, __HIP_MEMORY_SCOPE_AGENT); }
      __syncthreads();
      ok1 = sc_ok != 0;
    }
    __builtin_amdgcn_s_setprio(0);
  }
  __syncthreads();
}

__device__ void phase_attn(const P& p, char* smem) {
  bf16_t* Ks = (bf16_t*)smem;
  bf16_t* Vs = (bf16_t*)(smem + 64 * 144);
  __shared__ int item_s;
  const int tid = threadIdx.x, lane = tid & 63, wave = tid >> 6, l31 = lane & 31, h = lane >> 5;
  bf16_t* Qw = (bf16_t*)(smem + 36864) + wave * 4608;
  for (;;) {
    __syncthreads();
    if (tid == 0) item_s = atomicAdd(p.ctr, 1);
    __syncthreads();
    const int item = item_s;
    if (item >= 1024) break;
    int mbase, T, kvh, tile;
    if (item < 512) { int bs = item >> 8; kvh = (item >> 7) & 1; tile = item & 127; T = 8192; mbase = 16384 + bs * 8192; }
    else { int it = item - 512; int b = it >> 7; kvh = (it >> 6) & 1; tile = it & 63; T = 4096; mbase = b * 4096; }
    const int hq = kvh * 4 + wave;
    const int mq0 = mbase + tile * 64;
    {
      const bf16_t* qsrc = p.proj + (size_t)mq0 * DIN + 1920 + hq * 64;
#pragma unroll
      for (int jj = 0; jj < 8; ++jj) {
        const int c = lane + 64 * jj, r = c >> 3, ch = c & 7;
        *(u32x4*)(Qw + r * 72 + ch * 8) = *(const u32x4*)(qsrc + (size_t)r * DIN + ch * 8);
      }
    }
    f32x16 O[2][2];
#pragma unroll
    for (int qs = 0; qs < 2; ++qs)
#pragma unroll
      for (int dt = 0; dt < 2; ++dt)
#pragma unroll
        for (int i = 0; i < 16; ++i) O[qs][dt][i] = 0.f;
    float mrun[2] = {-1e30f, -1e30f};
    f32x2 lsum2[2] = {(f32x2){0.f, 0.f}, (f32x2){0.f, 0.f}};
    const bf16_t* Kg = p.Kc + ((size_t)kvh * NTOK + mbase) * 64;
    const bf16_t* Vg = p.Vt + (size_t)(kvh * 64) * NTOK + mbase;
    u32x4 rk[2], rv[2];
    const int nt = T / 64;
    const int tr = tid >> 3, tch = tid & 7;
    const bf16_t* kp0 = Kg + tr * 64 + tch * 8;
    const bf16_t* vp0 = Vg + (size_t)tr * NTOK + tch * 8;
    const int vpos = (tch >> 1) * 16 + (tch & 1) * 4;
#define ATT_LOAD(KT) { rk[0] = *(const u32x4*)(kp0 + (size_t)(KT) * 4096); rk[1] = *(const u32x4*)(kp0 + (size_t)(KT) * 4096 + 32 * 64); \
        rv[0] = *(const u32x4*)(vp0 + (KT) * 64); rv[1] = *(const u32x4*)(vp0 + (size_t)32 * NTOK + (KT) * 64); }
#define ATT_STORE(BUF) { bf16_t* Kd = Ks + (BUF) * 9216; bf16_t* Vd = Vs + (BUF) * 9216; _Pragma("unroll") for (int jj = 0; jj < 2; ++jj) { const int r = tr + 32 * jj; \
        *(u32x4*)(Kd + r * 72 + tch * 8) = rk[jj]; *(u32x2*)(Vd + r * 72 + vpos) = (u32x2){rv[jj].x, rv[jj].y}; *(u32x2*)(Vd + r * 72 + vpos + 8) = (u32x2){rv[jj].z, rv[jj].w}; } }
    ATT_LOAD(0);
    ATT_STORE(0);
    if (nt > 1) ATT_LOAD(1);
    __syncthreads();
    for (int kt = 0; kt < nt; ++kt) {
      const int buf = kt & 1;
      if (kt + 1 < nt) ATT_STORE(buf ^ 1);
      if (kt + 2 < nt) ATT_LOAD(kt + 2);
      __builtin_amdgcn_sched_barrier(0);
      const bf16_t* Kb = Ks + buf * 9216;
      const bf16_t* Vb = Vs + buf * 9216;
      f32x16 S[2][2];
#pragma unroll
      for (int qs = 0; qs < 2; ++qs)
#pragma unroll
        for (int i = 0; i < 16; ++i) { S[qs][0][i] = 0.f; S[qs][1][i] = 0.f; }
#pragma unroll
      for (int ks = 0; ks < 4; ++ks) {
        const bf16x8 a0 = *(const bf16x8*)(Kb + l31 * 72 + ks * 16 + h * 8);
        const bf16x8 a1 = *(const bf16x8*)(Kb + (32 + l31) * 72 + ks * 16 + h * 8);
        const bf16x8 q0 = *(const bf16x8*)(Qw + l31 * 72 + ks * 16 + h * 8);
        const bf16x8 q1 = *(const bf16x8*)(Qw + (32 + l31) * 72 + ks * 16 + h * 8);
        S[0][0] = __builtin_amdgcn_mfma_f32_32x32x16_bf16(a0, q0, S[0][0], 0, 0, 0);
        S[0][1] = __builtin_amdgcn_mfma_f32_32x32x16_bf16(a1, q0, S[0][1], 0, 0, 0);
        S[1][0] = __builtin_amdgcn_mfma_f32_32x32x16_bf16(a0, q1, S[1][0], 0, 0, 0);
        S[1][1] = __builtin_amdgcn_mfma_f32_32x32x16_bf16(a1, q1, S[1][1], 0, 0, 0);
      }
      union { bf16x8 v; uint32_t u[4]; } Pf[2][4];
#pragma unroll
      for (int qs = 0; qs < 2; ++qs) {
        float mx = fmaxf(fmaxf(S[qs][0][0], S[qs][0][1]), S[qs][0][2]);
#pragma unroll
        for (int i = 3; i < 15; i += 2) mx = fmaxf(fmaxf(mx, S[qs][0][i]), S[qs][0][i + 1]);
        mx = fmaxf(fmaxf(mx, S[qs][0][15]), S[qs][1][0]);
#pragma unroll
        for (int i = 1; i < 15; i += 2) mx = fmaxf(fmaxf(mx, S[qs][1][i]), S[qs][1][i + 1]);
        mx = fmaxf(mx, S[qs][1][15]);
        if (__any(mx > mrun[qs] + 8.f)) {
          mx = fmaxf(mx, __shfl_xor(mx, 32));
          const float mnew = fmaxf(mrun[qs], mx);
          const float alpha = __builtin_amdgcn_exp2f(mrun[qs] - mnew);
          mrun[qs] = mnew;
          lsum2[qs] *= alpha;
          O[qs][0] *= alpha; O[qs][1] *= alpha;
        }
        const f32x2 mm = (f32x2){mrun[qs], mrun[qs]};
#pragma unroll
        for (int i = 0; i < 8; ++i) {
          const f32x2 v0 = (f32x2){S[qs][0][2 * i], S[qs][0][2 * i + 1]} - mm;
          const float e0 = __builtin_amdgcn_exp2f(v0.x), e1 = __builtin_amdgcn_exp2f(v0.y);
          lsum2[qs] += (f32x2){e0, e1};
          Pf[qs][i >> 2].u[i & 3] = cvtpk(e0, e1);
          const f32x2 v1 = (f32x2){S[qs][1][2 * i], S[qs][1][2 * i + 1]} - mm;
          const float g0 = __builtin_amdgcn_exp2f(v1.x), g1 = __builtin_amdgcn_exp2f(v1.y);
          lsum2[qs] += (f32x2){g0, g1};
          Pf[qs][2 + (i >> 2)].u[i & 3] = cvtpk(g0, g1);
        }
      }
#pragma unroll
      for (int sidx = 0; sidx < 4; ++sidx) {
        const bf16x8 A0 = *(const bf16x8*)(Vb + l31 * 72 + sidx * 16 + h * 8);
        const bf16x8 A1 = *(const bf16x8*)(Vb + (32 + l31) * 72 + sidx * 16 + h * 8);
        O[0][0] = __builtin_amdgcn_mfma_f32_32x32x16_bf16(A0, Pf[0][sidx].v, O[0][0], 0, 0, 0);
        O[0][1] = __builtin_amdgcn_mfma_f32_32x32x16_bf16(A1, Pf[0][sidx].v, O[0][1], 0, 0, 0);
        O[1][0] = __builtin_amdgcn_mfma_f32_32x32x16_bf16(A0, Pf[1][sidx].v, O[1][0], 0, 0, 0);
        O[1][1] = __builtin_amdgcn_mfma_f32_32x32x16_bf16(A1, Pf[1][sidx].v, O[1][1], 0, 0, 0);
      }
      __syncthreads();
    }
    const float* g = p.ao_g + hq * 64;
#pragma unroll
    for (int qs = 0; qs < 2; ++qs) {
      float lsum = lsum2[qs].x + lsum2[qs].y;
      lsum = xsum32(lsum);
      const float inv = 1.f / lsum;
      float ss = 0.f;
#pragma unroll
      for (int i = 0; i < 16; ++i) { O[qs][0][i] *= inv; O[qs][1][i] *= inv; ss += O[qs][0][i] * O[qs][0][i] + O[qs][1][i] * O[qs][1][i]; }
      ss = xsum32(ss);
      const float rs = rsqrtf(ss * (1.f / 64.f) + 1e-6f);
      bf16_t* qrow = p.proj + (size_t)(mq0 + qs * 32 + l31) * DIN + 1920 + hq * 64;
#pragma unroll
      for (int dt = 0; dt < 2; ++dt)
#pragma unroll
        for (int gq = 0; gq < 4; ++gq) {
          const int d0 = dt * 32 + gq * 8 + h * 4;
          const f32x4 gg = *(const f32x4*)(g + d0);
          const float v0 = O[qs][dt][gq * 4 + 0] * rs * gg[0], v1 = O[qs][dt][gq * 4 + 1] * rs * gg[1];
          const float v2 = O[qs][dt][gq * 4 + 2] * rs * gg[2], v3 = O[qs][dt][gq * 4 + 3] * rs * gg[3];
          u32x2 o; o.x = cvtpk(v0, v1); o.y = cvtpk(v2, v3);
          *(u32x2*)(qrow + d0) = o;
        }
    }
  }
  __syncthreads();
}

__device__ void phase_attn_fast(const P& p, char* smem) {
  unsigned char* Ks8 = (unsigned char*)smem;
  bf16_t* Vs = (bf16_t*)(smem + 10240);
  __shared__ int item_s;
  const int tid = threadIdx.x, lane = tid & 63, wave = tid >> 6, l31 = lane & 31, h = lane >> 5;
  for (;;) {
    __syncthreads();
    if (tid == 0) item_s = atomicAdd(p.ctr, 1);
    __syncthreads();
    const int item = item_s;
    if (item >= 1024) break;
    int mbase, T, kvh, tile;
    if (item < 512) { int bs = item >> 8; kvh = (item >> 7) & 1; tile = item & 127; T = 8192; mbase = 16384 + bs * 8192; }
    else { int it = item - 512; int b = it >> 7; kvh = (it >> 6) & 1; tile = it & 63; T = 4096; mbase = b * 4096; }
    const int hq = kvh * 4 + wave;
    const int mq0 = mbase + tile * 64;
    i32x8 Qf[2];
#pragma unroll
    for (int qs = 0; qs < 2; ++qs) {
      const unsigned char* q8 = p.Q8 + ((size_t)(mq0 + qs * 32 + l31) * 8 + hq) * 64 + h * 32;
      const u32x4 qa = *(const u32x4*)q8, qb = *(const u32x4*)(q8 + 16);
      Qf[qs] = (i32x8){(int)qa.x, (int)qa.y, (int)qa.z, (int)qa.w, (int)qb.x, (int)qb.y, (int)qb.z, (int)qb.w};
    }
    f32x16 O[2][2];
#pragma unroll
    for (int qs = 0; qs < 2; ++qs)
#pragma unroll
      for (int dt = 0; dt < 2; ++dt)
#pragma unroll
        for (int i = 0; i < 16; ++i) O[qs][dt][i] = 0.f;
    float ls0 = 0.f, ls1 = 0.f;
    const unsigned char* kp8 = p.K8 + ((size_t)kvh * NTOK + mbase + (tid >> 2)) * 64 + (tid & 3) * 16;
    const bf16_t* Vg = p.Vt + (size_t)(kvh * 64) * NTOK + mbase;
    u32x4 rk8, rv[2];
    const int nt = T / 64;
    const int tr = tid >> 3, tch = tid & 7;
    const bf16_t* vp0 = Vg + (size_t)tr * NTOK + tch * 8;
    const int vpos = (tch >> 1) * 16 + (tch & 1) * 4;
#define ATF_LOAD(KT) { rk8 = *(const u32x4*)(kp8 + (size_t)(KT) * 4096); \
        rv[0] = *(const u32x4*)(vp0 + (KT) * 64); rv[1] = *(const u32x4*)(vp0 + (size_t)32 * NTOK + (KT) * 64); }
#define ATF_STORE(BUF) { *(u32x4*)(Ks8 + (BUF) * 5120 + (tid >> 2) * 80 + (tid & 3) * 16) = rk8; \
        bf16_t* Vd = Vs + (BUF) * 4608; _Pragma("unroll") for (int jj = 0; jj < 2; ++jj) { const int r = tr + 32 * jj; \
        *(u32x2*)(Vd + r * 72 + vpos) = (u32x2){rv[jj].x, rv[jj].y}; *(u32x2*)(Vd + r * 72 + vpos + 8) = (u32x2){rv[jj].z, rv[jj].w}; } }
    ATF_LOAD(0);
    ATF_STORE(0);
    if (nt > 1) ATF_LOAD(1);
    __syncthreads();
    for (int kt = 0; kt < nt; ++kt) {
      const int buf = kt & 1;
      if (kt + 1 < nt) ATF_STORE(buf ^ 1);
      if (kt + 2 < nt) ATF_LOAD(kt + 2);
      __builtin_amdgcn_sched_barrier(0);
      const unsigned char* Kb = Ks8 + buf * 5120;
      const bf16_t* Vb = Vs + buf * 4608;
      f32x16 S[2][2];
      {
        f32x16 zero16;
#pragma unroll
        for (int i = 0; i < 16; ++i) zero16[i] = 0.f;
#pragma unroll
        for (int ksub = 0; ksub < 2; ++ksub) {
          const u32x4 ka = *(const u32x4*)(Kb + (ksub * 32 + l31) * 80 + h * 32), kb = *(const u32x4*)(Kb + (ksub * 32 + l31) * 80 + h * 32 + 16);
          const i32x8 A8 = (i32x8){(int)ka.x, (int)ka.y, (int)ka.z, (int)ka.w, (int)kb.x, (int)kb.y, (int)kb.z, (int)kb.w};
          S[0][ksub] = __builtin_amdgcn_mfma_scale_f32_32x32x64_f8f6f4(A8, Qf[0], zero16, 0, 0, 0, 0x7F7F7F7F, 0, 0x7C7C7C7C);
          S[1][ksub] = __builtin_amdgcn_mfma_scale_f32_32x32x64_f8f6f4(A8, Qf[1], zero16, 0, 0, 0, 0x7F7F7F7F, 0, 0x7C7C7C7C);
        }
      }
      union { bf16x8 v; uint32_t u[4]; } Pf[2][4];
#define ATT_EXP(QS, LS) { _Pragma("unroll") for (int i = 0; i < 8; ++i) { \
          const float e0 = __builtin_amdgcn_exp2f(S[QS][0][2 * i]), e1 = __builtin_amdgcn_exp2f(S[QS][0][2 * i + 1]); \
          const float g0 = __builtin_amdgcn_exp2f(S[QS][1][2 * i]), g1 = __builtin_amdgcn_exp2f(S[QS][1][2 * i + 1]); \
          const uint32_t pe_ = cvtpk(e0, e1), pg_ = cvtpk(g0, g1); \
          LS = dot2bf(pg_, 0x3f803f80u, dot2bf(pe_, 0x3f803f80u, LS));     \
          Pf[QS][i >> 2].u[i & 3] = pe_; Pf[QS][2 + (i >> 2)].u[i & 3] = pg_; } }
      ATT_EXP(0, ls0); ATT_EXP(1, ls1);
#pragma unroll
      for (int sidx = 0; sidx < 4; ++sidx) {
        const bf16x8 A0 = *(const bf16x8*)(Vb + l31 * 72 + sidx * 16 + h * 8);
        const bf16x8 A1 = *(const bf16x8*)(Vb + (32 + l31) * 72 + sidx * 16 + h * 8);
        O[0][0] = __builtin_amdgcn_mfma_f32_32x32x16_bf16(A0, Pf[0][sidx].v, O[0][0], 0, 0, 0);
        O[0][1] = __builtin_amdgcn_mfma_f32_32x32x16_bf16(A1, Pf[0][sidx].v, O[0][1], 0, 0, 0);
        O[1][0] = __builtin_amdgcn_mfma_f32_32x32x16_bf16(A0, Pf[1][sidx].v, O[1][0], 0, 0, 0);
        O[1][1] = __builtin_amdgcn_mfma_f32_32x32x16_bf16(A1, Pf[1][sidx].v, O[1][1], 0, 0, 0);
      }
      __syncthreads();
    }
    const float* g = p.ao_g + hq * 64;
#pragma unroll
    for (int qs = 0; qs < 2; ++qs) {
      float lsum = qs ? ls1 : ls0;
      lsum = xsum32(lsum);
      const float inv = 1.f / lsum;
      float ss = 0.f;
#pragma unroll
      for (int i = 0; i < 16; ++i) { O[qs][0][i] *= inv; O[qs][1][i] *= inv; ss += O[qs][0][i] * O[qs][0][i] + O[qs][1][i] * O[qs][1][i]; }
      ss = xsum32(ss);
      const float rs = rsqrtf(ss * (1.f / 64.f) + 1e-6f);
      bf16_t* qrow = p.proj + (size_t)(mq0 + qs * 32 + l31) * DIN + 1920 + hq * 64;
#pragma unroll
      for (int dt = 0; dt < 2; ++dt)
#pragma unroll
        for (int gq = 0; gq < 4; ++gq) {
          const int d0 = dt * 32 + gq * 8 + h * 4;
          const f32x4 gg = *(const f32x4*)(g + d0);
          const float v0 = O[qs][dt][gq * 4 + 0] * rs * gg[0], v1 = O[qs][dt][gq * 4 + 1] * rs * gg[1];
          const float v2 = O[qs][dt][gq * 4 + 2] * rs * gg[2], v3 = O[qs][dt][gq * 4 + 3] * rs * gg[3];
          u32x2 o; o.x = cvtpk(v0, v1); o.y = cvtpk(v2, v3);
          *(u32x2*)(qrow + d0) = o;
        }
    }
  }
  __syncthreads();
}

__device__ void phase_attn_f8(const P& p, char* smem) {
  unsigned char* Ks8 = (unsigned char*)smem;
  unsigned char* Vs8 = (unsigned char*)smem + 10240;
  __shared__ int item_s;
  const int tid = threadIdx.x, lane = tid & 63, wave = tid >> 6, l31 = lane & 31, h = lane >> 5;
  for (;;) {
    __syncthreads();
    if (tid == 0) item_s = atomicAdd(p.ctr, 1);
    __syncthreads();
    const int item = item_s;
    if (item >= 1024) break;
    int mbase, T, kvh, tile;
    if (item < 512) { int bs = item >> 8; kvh = (item >> 7) & 1; tile = item & 127; T = 8192; mbase = 16384 + bs * 8192; }
    else { int it = item - 512; int b = it >> 7; kvh = (it >> 6) & 1; tile = it & 63; T = 4096; mbase = b * 4096; }
    const int hq = kvh * 4 + wave;
    const int mq0 = mbase + tile * 64;
    i32x8 Qf[2];
#pragma unroll
    for (int qs = 0; qs < 2; ++qs) {
      const unsigned char* q8 = p.Q8 + ((size_t)(mq0 + qs * 32 + l31) * 8 + hq) * 64 + h * 32;
      const u32x4 qa = *(const u32x4*)q8, qb = *(const u32x4*)(q8 + 16);
      Qf[qs] = (i32x8){(int)qa.x, (int)qa.y, (int)qa.z, (int)qa.w, (int)qb.x, (int)qb.y, (int)qb.z, (int)qb.w};
    }
    f32x16 O[2][2], L[2];
#pragma unroll
    for (int qs = 0; qs < 2; ++qs) {
#pragma unroll
      for (int i = 0; i < 16; ++i) { O[qs][0][i] = 0.f; O[qs][1][i] = 0.f; L[qs][i] = 0.f; }
    }
    f32x16 zero16;
#pragma unroll
    for (int i = 0; i < 16; ++i) zero16[i] = 0.f;
    const i32x8 ones8 = (i32x8){0x38383838, 0x38383838, 0x38383838, 0x38383838, 0x38383838, 0x38383838, 0x38383838, 0x38383838};
    const unsigned char* kp8 = p.K8 + ((size_t)kvh * NTOK + mbase + (tid >> 2)) * 64 + (tid & 3) * 16;
    const unsigned char* vp8 = p.V8t + (size_t)(kvh * 64 + (tid >> 2)) * NTOK + mbase + (tid & 3) * 16;
    u32x4 rk8, rv8;
    const int nt = T / 64;
#define AT8_LOAD(KT) { rk8 = *(const u32x4*)(kp8 + (size_t)(KT) * 4096); rv8 = *(const u32x4*)(vp8 + (KT) * 64); }
#define AT8_STORE(BUF) { *(u32x4*)(Ks8 + (BUF) * 5120 + (tid >> 2) * 80 + (tid & 3) * 16) = rk8; *(u32x4*)(Vs8 + (BUF) * 5120 + (tid >> 2) * 80 + (tid & 3) * 16) = rv8; }
    AT8_LOAD(0);
    AT8_STORE(0);
    if (nt > 1) AT8_LOAD(1);
    __syncthreads();
    i32x8 Pb[2] = {(i32x8){0, 0, 0, 0, 0, 0, 0, 0}, (i32x8){0, 0, 0, 0, 0, 0, 0, 0}};
    for (int kt = 0; kt < nt; ++kt) {
      const int buf = kt & 1;
      if (kt + 1 < nt) AT8_STORE(buf ^ 1);
      if (kt + 2 < nt) AT8_LOAD(kt + 2);
      __builtin_amdgcn_sched_barrier(0);
      const unsigned char* Kb = Ks8 + buf * 5120;
      const unsigned char* Vb = Vs8 + buf * 5120;
      i32x8 Ak[2];
#pragma unroll
      for (int ksub = 0; ksub < 2; ++ksub) {
        const u32x4 ka = *(const u32x4*)(Kb + (ksub * 32 + l31) * 80 + h * 32), kb = *(const u32x4*)(Kb + (ksub * 32 + l31) * 80 + h * 32 + 16);
        Ak[ksub] = (i32x8){(int)ka.x, (int)ka.y, (int)ka.z, (int)ka.w, (int)kb.x, (int)kb.y, (int)kb.z, (int)kb.w};
      }
#pragma unroll
      for (int qs = 0; qs < 2; ++qs) {
        const f32x16 S0 = __builtin_amdgcn_mfma_scale_f32_32x32x64_f8f6f4(Ak[0], Qf[qs], zero16, 0, 0, 0, 0x7F7F7F7F, 0, 0x7C7C7C7C);
        const f32x16 S1 = __builtin_amdgcn_mfma_scale_f32_32x32x64_f8f6f4(Ak[1], Qf[qs], zero16, 0, 0, 0, 0x7F7F7F7F, 0, 0x7C7C7C7C);
#pragma unroll
        for (int u = 0; u < 4; ++u) {
          const float e0 = __builtin_amdgcn_exp2f(S0[4 * u]), e1 = __builtin_amdgcn_exp2f(S0[4 * u + 1]), e2 = __builtin_amdgcn_exp2f(S0[4 * u + 2]), e3 = __builtin_amdgcn_exp2f(S0[4 * u + 3]);
          const float g0 = __builtin_amdgcn_exp2f(S1[4 * u]), g1 = __builtin_amdgcn_exp2f(S1[4 * u + 1]), g2 = __builtin_amdgcn_exp2f(S1[4 * u + 2]), g3 = __builtin_amdgcn_exp2f(S1[4 * u + 3]);
          Pb[qs][u] = __builtin_amdgcn_cvt_pk_bf8_f32(e2, e3, __builtin_amdgcn_cvt_pk_bf8_f32(e0, e1, Pb[qs][u], false), true);
          Pb[qs][4 + u] = __builtin_amdgcn_cvt_pk_bf8_f32(g2, g3, __builtin_amdgcn_cvt_pk_bf8_f32(g0, g1, Pb[qs][4 + u], false), true);
        }
      }
#pragma unroll
      for (int dt = 0; dt < 2; ++dt) {
        const u32x4 va = *(const u32x4*)(Vb + (dt * 32 + l31) * 80 + h * 32), vb_ = *(const u32x4*)(Vb + (dt * 32 + l31) * 80 + h * 32 + 16);
        const i32x8 Av = (i32x8){(int)va.x, (int)va.y, (int)va.z, (int)va.w, (int)vb_.x, (int)vb_.y, (int)vb_.z, (int)vb_.w};
        O[0][dt] = __builtin_amdgcn_mfma_scale_f32_32x32x64_f8f6f4(Av, Pb[0], O[0][dt], 0, 1, 0, 0x7F7F7F7F, 0, 0x7F7F7F7F);
        O[1][dt] = __builtin_amdgcn_mfma_scale_f32_32x32x64_f8f6f4(Av, Pb[1], O[1][dt], 0, 1, 0, 0x7F7F7F7F, 0, 0x7F7F7F7F);
      }
      L[0] = __builtin_amdgcn_mfma_scale_f32_32x32x64_f8f6f4(ones8, Pb[0], L[0], 0, 1, 0, 0x7F7F7F7F, 0, 0x7F7F7F7F);
      L[1] = __builtin_amdgcn_mfma_scale_f32_32x32x64_f8f6f4(ones8, Pb[1], L[1], 0, 1, 0, 0x7F7F7F7F, 0, 0x7F7F7F7F);
      __syncthreads();
    }
    const float* g = p.ao_g + hq * 64;
#pragma unroll
    for (int qs = 0; qs < 2; ++qs) {
      const float inv = 1.f / L[qs][0];
      float ss = 0.f;
#pragma unroll
      for (int i = 0; i < 16; ++i) { O[qs][0][i] *= inv; O[qs][1][i] *= inv; ss += O[qs][0][i] * O[qs][0][i] + O[qs][1][i] * O[qs][1][i]; }
      ss = xsum32(ss);
      const float rs = rsqrtf(ss * (1.f / 64.f) + 1e-6f);
      bf16_t* qrow = p.proj + (size_t)(mq0 + qs * 32 + l31) * DIN + 1920 + hq * 64;
#pragma unroll
      for (int dt = 0; dt < 2; ++dt)
#pragma unroll
        for (int gq = 0; gq < 4; ++gq) {
          const int d0 = dt * 32 + gq * 8 + h * 4;
          const f32x4 gg = *(const f32x4*)(g + d0);
          const float v0 = O[qs][dt][gq * 4 + 0] * rs * gg[0], v1 = O[qs][dt][gq * 4 + 1] * rs * gg[1];
          const float v2 = O[qs][dt][gq * 4 + 2] * rs * gg[2], v3 = O[qs][dt][gq * 4 + 3] * rs * gg[3];
          u32x2 o; o.x = cvtpk(v0, v1); o.y = cvtpk(v2, v3);
          *(u32x2*)(qrow + d0) = o;
        }
    }
  }
  __syncthreads();
}

__device__ void phase_post(const P& p, char* smem) {
  bf16_t* As = (bf16_t*)smem;
  bf16_t* Bs = (bf16_t*)(smem + 34816);
  const int tid = threadIdx.x, lane = tid & 63, wave = tid >> 6, wr = wave >> 1, wc = wave & 1, q4 = lane >> 4;
  for (int item = blockIdx.x; item < 1024; item += gridDim.x) {
    const int m0 = (item >> 2) * 128, n0 = (item & 3) * 128;
    __syncthreads();
#pragma unroll
    for (int j = 0; j < 8; ++j) {
      const int c = tid + 256 * j, row = c >> 4, kc = c & 15;
      const int m = m0 + row; int bb, t, T; tok_info(m, bb, t, T);
      const bf16_t* q = p.proj + (size_t)m * DIN + 1792 + kc * 8;
      const u32x4 cc = *(const u32x4*)q;
      u32x4 pv = (u32x4){0u, 0u, 0u, 0u}, nx = (u32x4){0u, 0u, 0u, 0u};
      if (t > 0) pv = *(const u32x4*)(q - DIN);
      if (t < T - 1) nx = *(const u32x4*)(q + DIN);
      const f32x4 mu0 = *(const f32x4*)(p.mu + 1792 + kc * 8), mu1 = *(const f32x4*)(p.mu + 1792 + kc * 8 + 4);
      u32x4 o;
#pragma unroll
      for (int w = 0; w < 4; ++w) {
        const float c0 = bflo(cc[w]), c1 = bfhi(cc[w]);
        const float m_0 = w < 2 ? mu0[2 * w] : mu1[2 * w - 4], m_1 = w < 2 ? mu0[2 * w + 1] : mu1[2 * w - 3];
        const float s0 = c0 + m_0 * (0.5f * (bflo(pv[w]) + bflo(nx[w])) - c0);
        const float s1 = c1 + m_1 * (0.5f * (bfhi(pv[w]) + bfhi(nx[w])) - c1);
        o[w] = cvtpk(__builtin_amdgcn_rcpf(1.f + __expf(-s0)), __builtin_amdgcn_rcpf(1.f + __expf(-s1)));
      }
      *(u32x4*)(As + row * 136 + kc * 8) = o;
      *(u32x4*)(Bs + row * 136 + kc * 8) = *(const u32x4*)(p.g2T + (size_t)(n0 + row) * 128 + kc * 8);
    }
    __syncthreads();
    f32x4 acc[4][4];
#pragma unroll
    for (int i = 0; i < 4; ++i)
#pragma unroll
      for (int j = 0; j < 4; ++j) acc[i][j] = (f32x4){0.f, 0.f, 0.f, 0.f};
#pragma unroll
    for (int ks = 0; ks < 4; ++ks) {
      bf16x8 af[4], bfr[4];
#pragma unroll
      for (int i = 0; i < 4; ++i) af[i] = *(const bf16x8*)(As + (wr * 64 + i * 16 + (lane & 15)) * 136 + ks * 32 + q4 * 8);
#pragma unroll
      for (int j = 0; j < 4; ++j) bfr[j] = *(const bf16x8*)(Bs + (wc * 64 + j * 16 + (lane & 15)) * 136 + ks * 32 + q4 * 8);
#pragma unroll
      for (int i = 0; i < 4; ++i)
#pragma unroll
        for (int j = 0; j < 4; ++j) acc[i][j] = MFMA16(bfr[j], af[i], acc[i][j]);
    }
    const int hd = (n0 >> 6) + wc;
    const int cb = n0 + wc * 64 + q4 * 4;
    uint32_t gpk[4][4][2];
#pragma unroll
    for (int i = 0; i < 4; ++i)
#pragma unroll
      for (int j = 0; j < 4; ++j) { gpk[i][j][0] = cvtpk(acc[i][j][0], acc[i][j][1]); gpk[i][j][1] = cvtpk(acc[i][j][2], acc[i][j][3]); }
    f32x4 lw_[4], lb_[4];
#pragma unroll
    for (int j = 0; j < 4; ++j) { lw_[j] = *(const f32x4*)(p.ln_w + cb + j * 16); lb_[j] = *(const f32x4*)(p.ln_b + cb + j * 16); }
#pragma unroll
    for (int ih = 0; ih < 2; ++ih) {
      u32x2 ya_[2][4], yb_[2][4], vv_[2][4]; float cc_[2];
#pragma unroll
      for (int i2 = 0; i2 < 2; ++i2) {
        const int m = m0 + wr * 64 + (ih * 2 + i2) * 16 + (lane & 15);
#pragma unroll
        for (int j = 0; j < 4; ++j) {
          ya_[i2][j] = *(const u32x2*)(p.yd + (size_t)m * 512 + cb + j * 16);
          yb_[i2][j] = *(const u32x2*)(p.yd + ((size_t)NTOK + m) * 512 + cb + j * 16);
          vv_[i2][j] = *(const u32x2*)(p.ps_vwa + (size_t)m * 768 + cb + j * 16);
        }
        cc_[i2] = p.cd[(size_t)m * 8 + hd] + p.cd[((size_t)NTOK + m) * 8 + hd];
      }
      __builtin_amdgcn_sched_barrier(0);
#pragma unroll
      for (int i2 = 0; i2 < 2; ++i2) {
        const int i = ih * 2 + i2;
        const int m = m0 + wr * 64 + i * 16 + (lane & 15);
        float y[16]; float sum = 0.f;
#pragma unroll
        for (int j = 0; j < 4; ++j) {
          const u32x2 a = ya_[i2][j], b = yb_[i2][j];
          y[4 * j] = bflo(a.x) + bflo(b.x); y[4 * j + 1] = bfhi(a.x) + bfhi(b.x); y[4 * j + 2] = bflo(a.y) + bflo(b.y); y[4 * j + 3] = bfhi(a.y) + bfhi(b.y);
          sum += (y[4 * j] + y[4 * j + 1]) + (y[4 * j + 2] + y[4 * j + 3]);
        }
        sum = xsum16(sum); sum = xsum32(sum);
        const float mean = sum * (1.f / 64.f);
        float vs_ = 0.f;
#pragma unroll
        for (int k = 0; k < 16; ++k) { y[k] -= mean; vs_ += y[k] * y[k]; }
        vs_ = xsum16(vs_); vs_ = xsum32(vs_);
        const float rstd = rsqrtf(vs_ * (1.f / 64.f) + 64e-5f);
        const float cc = cc_[i2];
#pragma unroll
        for (int j = 0; j < 4; ++j) {
          const int c = cb + j * 16;
          const f32x4 lw = lw_[j], lb = lb_[j];
          const u32x2 vv = vv_[i2][j];
          const float v0 = bflo(vv.x), v1 = bfhi(vv.x), v2 = bflo(vv.y), v3 = bfhi(vv.y);
          const float o0 = (y[4 * j] * rstd * lw[0] + lb[0] + cc * v0) * bflo(gpk[i][j][0]);
          const float o1 = (y[4 * j + 1] * rstd * lw[1] + lb[1] + cc * v1) * bfhi(gpk[i][j][0]);
          const float o2 = (y[4 * j + 2] * rstd * lw[2] + lb[2] + cc * v2) * bflo(gpk[i][j][1]);
          const float o3 = (y[4 * j + 3] * rstd * lw[3] + lb[3] + cc * v3) * bfhi(gpk[i][j][1]);
          u32x2 o; o.x = cvtpk(o0, o1); o.y = cvtpk(o2, o3);
          *(u32x2*)(p.proj + (size_t)m * DIN + c) = o;
        }
      }
      __builtin_amdgcn_sched_barrier(0);
    }
  }
  __syncthreads();
}

__device__ void phase_convert(const float* src, bf16_t* dst, size_t n) {
  size_t n4 = n / 4;
  for (size_t i = (size_t)blockIdx.x * NTHR + threadIdx.x; i < n4; i += (size_t)gridDim.x * NTHR) {
    float4 v = ((const float4*)src)[i];
    u32x2 o; o.x = pack2(v.x, v.y); o.y = pack2(v.z, v.w);
    ((u32x2*)dst)[i] = o;
  }
}

typedef float v16f __attribute__((ext_vector_type(16)));
typedef float v32f __attribute__((ext_vector_type(32)));
typedef unsigned v6u __attribute__((ext_vector_type(6)));
template <int WHICH>
__device__ __forceinline__ void phase_convert8(const P& p) {
  const int wave = threadIdx.x >> 6, lane = threadIdx.x & 63;
  if (WHICH == 0)
  for (int e = blockIdx.x * 4 + wave; e < 16384; e += gridDim.x * 4) {
    const float* src = p.u_tab + (size_t)e * DM + lane * 16;
    f32x4 x[4]; float sq = 0.f;
#pragma unroll
    for (int j = 0; j < 4; ++j) { x[j] = *(const f32x4*)(src + 4 * j); sq += (x[j][0] * x[j][0] + x[j][1] * x[j][1]) + (x[j][2] * x[j][2] + x[j][3] * x[j][3]); }
    sq = wave_sum(sq);
    const float st = sq > 0.f ? 0.335f * sqrtf(sq * (1.f / 1024.f)) : 1.f, inv4 = 1.f / st;
    uint32_t w0 = 0u, w1 = 0u;
#pragma unroll
    for (int j = 0; j < 4; ++j)
#pragma unroll
      for (int e_ = 0; e_ < 4; ++e_) {
        int q = (int)rintf(x[j][e_] * inv4); q = q > 7 ? 7 : (q < -7 ? -7 : q);
        const uint32_t nb = (uint32_t)(q + 8);
        if (j < 2) w0 |= nb << (4 * (j * 4 + e_)); else w1 |= nb << (4 * ((j - 2) * 4 + e_));
      }
    *(u32x2*)(p.ut4 + (size_t)e * 512 + lane * 8) = (u32x2){w0, w1};
    if (lane == 0) p.ustep[e] = st;
  }
  if (WHICH == 1)
  for (int rp = blockIdx.x * 4 + wave; rp < 8192; rp += gridDim.x * 4) {
    const int e = rp * 2 + (lane >> 5), l32 = lane & 31;
    const float* src = p.v_tab + (size_t)e * DM + l32 * 32;
    f32x4 x[8]; float am = 0.f;
#pragma unroll
    for (int j = 0; j < 8; ++j) { x[j] = *(const f32x4*)(src + 4 * j); am = fmaxf(am, fmaxf(fmaxf(fabsf(x[j][0]), fabsf(x[j][1])), fmaxf(fabsf(x[j][2]), fabsf(x[j][3])))); }
#pragma unroll
    for (int o = 16; o >= 16; o >>= 1) am = xmax16(am);
    am = fmaxf(am, dppf_(am, 0x128)); am = fmaxf(am, dppf_(am, 0x141)); am = fmaxf(am, dppf_(am, 0x4E)); am = fmaxf(am, dppf_(am, 0xB1));
    const float step = am > 0.f ? am * (1.f / 6.f) : 1.f, inv = 1.f / step;
    u32x4 w = (u32x4){0u, 0u, 0u, 0u};
#pragma unroll
    for (int j = 0; j < 8; ++j)
#pragma unroll
      for (int c = 0; c < 4; ++c) {
        const float a = x[j][c] * inv, m = fabsf(a);
        const unsigned code = (m < 0.25f ? 0u : m < 0.75f ? 1u : m < 1.25f ? 2u : m < 1.75f ? 3u : m < 2.5f ? 4u : m < 3.5f ? 5u : m < 5.f ? 6u : 7u) | (a < 0.f ? 8u : 0u);
        w[j >> 1] |= code << (4 * (4 * (j & 1) + c));
      }
    *(u32x4*)(p.vt8 + (size_t)e * 512 + l32 * 16) = w;
    if (l32 == 0) p.vstep[e] = step;
  }
}

__device__ __forceinline__ int f2key(float f) { int b_ = __float_as_int(f); return b_ ^ ((b_ >> 31) & 0x7fffffff); }
__device__ __forceinline__ float key2f(int k) { int b_ = k ^ ((k >> 31) & 0x7fffffff); return __int_as_float(b_); }
__device__ __forceinline__ void sort16_desc(int (&a)[16]) {
#define S16_CE(I, J) { const int hi_ = max(a[I], a[J]), lo_ = min(a[I], a[J]); a[I] = hi_; a[J] = lo_; }
  S16_CE(0, 13) S16_CE(1, 12) S16_CE(2, 15) S16_CE(3, 14) S16_CE(4, 8) S16_CE(5, 6) S16_CE(7, 11) S16_CE(9, 10)
  S16_CE(0, 5) S16_CE(1, 7) S16_CE(2, 9) S16_CE(3, 4) S16_CE(6, 13) S16_CE(8, 14) S16_CE(10, 15) S16_CE(11, 12)
  S16_CE(0, 1) S16_CE(2, 3) S16_CE(4, 5) S16_CE(6, 8) S16_CE(7, 9) S16_CE(10, 11) S16_CE(12, 13) S16_CE(14, 15)
  S16_CE(0, 2) S16_CE(1, 3) S16_CE(4, 10) S16_CE(5, 11) S16_CE(6, 7) S16_CE(8, 9) S16_CE(12, 14) S16_CE(13, 15)
  S16_CE(1, 2) S16_CE(3, 12) S16_CE(4, 6) S16_CE(5, 7) S16_CE(8, 10) S16_CE(9, 11) S16_CE(13, 14)
  S16_CE(1, 4) S16_CE(2, 6) S16_CE(5, 8) S16_CE(7, 10) S16_CE(9, 13) S16_CE(11, 14)
  S16_CE(2, 4) S16_CE(3, 6) S16_CE(9, 12) S16_CE(11, 13)
  S16_CE(3, 5) S16_CE(6, 8) S16_CE(7, 9) S16_CE(10, 12)
  S16_CE(3, 4) S16_CE(5, 6) S16_CE(7, 8) S16_CE(9, 10) S16_CE(11, 12)
  S16_CE(6, 7) S16_CE(8, 9)
}
__device__ __forceinline__ void merge_top16(int (&best)[16], const int (&other)[16]) {
#pragma unroll
  for (int i = 0; i < 16; ++i) best[i] = max(best[i], other[15 - i]);
#pragma unroll
  for (int j = 8; j > 0; j >>= 1)
#pragma unroll
    for (int i = 0; i < 16; ++i) {
      const int l = i ^ j;
      if (l > i) { const int hi_ = max(best[i], best[l]), lo_ = min(best[i], best[l]); best[i] = hi_; best[l] = lo_; }
    }
}

__device__ void phase_peerq(const P& p, char* smem) {
  constexpr int K = 1024;
  bf16_t* As = (bf16_t*)smem;
  bf16_t* Bs = As + 128 * 72;
  bf16_t* Qs = (bf16_t*)smem;
  bf16_t* Ss = (bf16_t*)(smem + 34816);
  int* Ks = (int*)smem;
  const int tid = threadIdx.x, lane = tid & 63, wave = tid >> 6, wr = wave >> 1, wc = wave & 1;
  const int grp = blockIdx.x & 7, gidx = blockIdx.x >> 3, gsz = gridDim.x >> 3;
  const bool xcd_order = (gridDim.x & 7) == 0;
  const int ntl = xcd_order ? 32 * 16 : 256 * 16;
  for (int u = xcd_order ? gidx : (int)blockIdx.x; u < ntl; u += xcd_order ? gsz : (int)gridDim.x) {
    const int tm = xcd_order ? (u >> 4) * 8 + grp : u >> 4, hp = u & 15;
    const int m0 = tm * 128, n0 = hp * 128;
    f32x4 acc[4][4];
    gemm_mainloop_g<false, false>((const char*)p.h2, 2048, (const char*)p.wqT, m0, n0, smem, acc);
    __syncthreads();
#pragma unroll
    for (int i = 0; i < 4; ++i)
#pragma unroll
      for (int j = 0; j < 4; ++j) {
        const int mm = wr * 64 + i * 16 + (lane & 15), nn = wc * 64 + j * 16 + (lane >> 4) * 4;
        u32x2 o; o.x = cvtpk(acc[i][j][0], acc[i][j][1]); o.y = cvtpk(acc[i][j][2], acc[i][j][3]);
        *(u32x2*)(Qs + mm * 136 + nn) = o;
      }
    {
      const bf16_t* sk = p.skb + (hp & 1) * 16384;
#pragma unroll
      for (int j = 0; j < 8; ++j) {
        int c = tid + 256 * j, row = c >> 4, kc = c & 15;
        *(u32x4*)(Ss + row * 136 + kc * 8) = *(const u32x4*)(sk + row * 128 + kc * 8);
      }
    }
    __syncthreads();
#pragma unroll
    for (int i = 0; i < 4; ++i)
#pragma unroll
      for (int j = 0; j < 4; ++j) acc[i][j] = (f32x4){0.f, 0.f, 0.f, 0.f};
#pragma unroll
    for (int ks = 0; ks < 4; ++ks) {
      bf16x8 af[4], bfr[4];
#pragma unroll
      for (int i = 0; i < 4; ++i) af[i] = *(const bf16x8*)(Qs + (wr * 64 + i * 16 + (lane & 15)) * 136 + ks * 32 + (lane >> 4) * 8);
#pragma unroll
      for (int j = 0; j < 4; ++j) bfr[j] = *(const bf16x8*)(Ss + (wc * 64 + j * 16 + (lane & 15)) * 136 + ks * 32 + (lane >> 4) * 8);
#pragma unroll
      for (int i = 0; i < 4; ++i)
#pragma unroll
        for (int j = 0; j < 4; ++j) acc[i][j] = MFMA16(bfr[j], af[i], acc[i][j]);
    }
    __syncthreads();
#pragma unroll
    for (int i = 0; i < 4; ++i)
#pragma unroll
      for (int j = 0; j < 4; ++j) {
        const int mm = wr * 64 + i * 16 + (lane & 15), nn = wc * 64 + j * 16 + (lane >> 4) * 4;
#pragma unroll
        for (int r = 0; r < 4; ++r) Ks[mm * 129 + nn + r] = (f2key(acc[i][j][r]) & ~127) | (127 - (nn + r));
      }
    __syncthreads();
    {
      const int row = tid >> 1, half = tid & 1;
      const int* src = Ks + row * 129 + half * 64;
      int best[16];
#pragma unroll
      for (int k = 0; k < 16; ++k) best[k] = src[k];
      sort16_desc(best);
#pragma unroll
      for (int blk = 1; blk < 4; ++blk) {
        int cur[16];
#pragma unroll
        for (int k = 0; k < 16; ++k) cur[k] = src[blk * 16 + k];
        sort16_desc(cur);
        merge_top16(best, cur);
      }
      int oth[16];
#pragma unroll
      for (int k = 0; k < 16; ++k) oth[k] = __builtin_amdgcn_update_dpp(0, best[k], 0xB1, 0xf, 0xf, false);
      merge_top16(best, oth);
      if (half == 0) {
        int* dst = p.topl + ((size_t)(m0 + row) * 16 + hp) * 16;
#pragma unroll
        for (int k4 = 0; k4 < 4; ++k4) {
          u32x4 o; o.x = (uint32_t)best[k4 * 4]; o.y = (uint32_t)best[k4 * 4 + 1]; o.z = (uint32_t)best[k4 * 4 + 2]; o.w = (uint32_t)best[k4 * 4 + 3];
          *(u32x4*)(dst + k4 * 4) = o;
        }
      }
    }
    __syncthreads();
  }
  __syncthreads();
}

#define GW_BYTES 17408
__device__ void phase_gather(const P& p, char* smem) {
  const int wave = threadIdx.x >> 6, lane = threadIdx.x & 63;
  char* wb = smem + wave * GW_BYTES;
  int* lsA = (int*)wb;
  int* lsB = (int*)(wb + 4352);
  int* res_e = (int*)(wb + 8704);
  float* res_g = (float*)(wb + 8704 + 4096);
  float* coefs = (float*)(wb + 8704 + 8192);
  for (int grp = blockIdx.x * 4 + wave; grp < NTOK / 8; grp += gridDim.x * 4) {
    const int m8 = grp * 8;
    {
      const int tk = lane >> 3, hh = lane & 7;
      const int* src = p.topl + ((size_t)(m8 + tk) * 16 + hh * 2) * 16;
      int ka[16], kb[16];
#pragma unroll
      for (int k4 = 0; k4 < 4; ++k4) {
        u32x4 wa = *(const u32x4*)(src + k4 * 4), wb_ = *(const u32x4*)(src + 16 + k4 * 4);
        ka[k4 * 4] = (int)wa.x; ka[k4 * 4 + 1] = (int)wa.y; ka[k4 * 4 + 2] = (int)wa.z; ka[k4 * 4 + 3] = (int)wa.w;
        kb[k4 * 4] = (int)wb_.x; kb[k4 * 4 + 1] = (int)wb_.y; kb[k4 * 4 + 2] = (int)wb_.z; kb[k4 * 4 + 3] = (int)wb_.w;
      }
      float va[16], vb[16];
#pragma unroll
      for (int k = 0; k < 16; ++k) { lsA[lane * 17 + k] = ka[k]; lsB[lane * 17 + k] = kb[k]; va[k] = key2f(ka[k] & ~127); vb[k] = key2f(kb[k] & ~127); }
      int t2[16];
      {
        int c_[16];
        c_[0] = (f2key(va[0] + vb[0]) & ~255) | 0;
        c_[1] = (f2key(va[0] + vb[1]) & ~255) | 1;
        c_[2] = (f2key(va[0] + vb[2]) & ~255) | 2;
        c_[3] = (f2key(va[0] + vb[3]) & ~255) | 3;
        c_[4] = (f2key(va[0] + vb[4]) & ~255) | 4;
        c_[5] = (f2key(va[0] + vb[5]) & ~255) | 5;
        c_[6] = (f2key(va[0] + vb[6]) & ~255) | 6;
        c_[7] = (f2key(va[0] + vb[7]) & ~255) | 7;
        c_[8] = (f2key(va[0] + vb[8]) & ~255) | 8;
        c_[9] = (f2key(va[0] + vb[9]) & ~255) | 9;
        c_[10] = (f2key(va[0] + vb[10]) & ~255) | 10;
        c_[11] = (f2key(va[0] + vb[11]) & ~255) | 11;
        c_[12] = (f2key(va[0] + vb[12]) & ~255) | 12;
        c_[13] = (f2key(va[0] + vb[13]) & ~255) | 13;
        c_[14] = (f2key(va[0] + vb[14]) & ~255) | 14;
        c_[15] = (f2key(va[0] + vb[15]) & ~255) | 15;
        sort16_desc(c_);
#pragma unroll
        for (int k = 0; k < 16; ++k) t2[k] = c_[k];
      }
      {
        int c_[16];
        c_[0] = (f2key(va[1] + vb[0]) & ~255) | 16;
        c_[1] = (f2key(va[1] + vb[1]) & ~255) | 17;
        c_[2] = (f2key(va[1] + vb[2]) & ~255) | 18;
        c_[3] = (f2key(va[1] + vb[3]) & ~255) | 19;
        c_[4] = (f2key(va[1] + vb[4]) & ~255) | 20;
        c_[5] = (f2key(va[1] + vb[5]) & ~255) | 21;
        c_[6] = (f2key(va[1] + vb[6]) & ~255) | 22;
        c_[7] = (f2key(va[1] + vb[7]) & ~255) | 23;
        c_[8] = (f2key(va[2] + vb[0]) & ~255) | 32;
        c_[9] = (f2key(va[2] + vb[1]) & ~255) | 33;
        c_[10] = (f2key(va[2] + vb[2]) & ~255) | 34;
        c_[11] = (f2key(va[2] + vb[3]) & ~255) | 35;
        c_[12] = (f2key(va[2] + vb[4]) & ~255) | 36;
        c_[13] = (f2key(va[3] + vb[0]) & ~255) | 48;
        c_[14] = (f2key(va[3] + vb[1]) & ~255) | 49;
        c_[15] = (f2key(va[3] + vb[2]) & ~255) | 50;
        sort16_desc(c_);
        merge_top16(t2, c_);
      }
      {
        int c_[16];
        c_[0] = (f2key(va[3] + vb[3]) & ~255) | 51;
        c_[1] = (f2key(va[4] + vb[0]) & ~255) | 64;
        c_[2] = (f2key(va[4] + vb[1]) & ~255) | 65;
        c_[3] = (f2key(va[4] + vb[2]) & ~255) | 66;
        c_[4] = (f2key(va[5] + vb[0]) & ~255) | 80;
        c_[5] = (f2key(va[5] + vb[1]) & ~255) | 81;
        c_[6] = (f2key(va[6] + vb[0]) & ~255) | 96;
        c_[7] = (f2key(va[6] + vb[1]) & ~255) | 97;
        c_[8] = (f2key(va[7] + vb[0]) & ~255) | 112;
        c_[9] = (f2key(va[7] + vb[1]) & ~255) | 113;
        c_[10] = (f2key(va[8] + vb[0]) & ~255) | 128;
        c_[11] = (f2key(va[9] + vb[0]) & ~255) | 144;
        c_[12] = (f2key(va[10] + vb[0]) & ~255) | 160;
        c_[13] = (f2key(va[11] + vb[0]) & ~255) | 176;
        c_[14] = (f2key(va[12] + vb[0]) & ~255) | 192;
        c_[15] = (f2key(va[13] + vb[0]) & ~255) | 208;
        sort16_desc(c_);
        merge_top16(t2, c_);
      }
      {
        int c_[16];
        const int x0_ = (f2key(va[14] + vb[0]) & ~255) | 224, x1_ = (f2key(va[15] + vb[0]) & ~255) | 240;
        c_[0] = max(x0_, x1_); c_[1] = min(x0_, x1_);
#pragma unroll
        for (int k = 2; k < 16; ++k) c_[k] = (int)0x80000000;
        merge_top16(t2, c_);
      }
      float sv[16]; float sum = 0.f;
      const float mx = key2f(t2[0] & ~255);
#pragma unroll
      for (int k = 0; k < 16; ++k) { sv[k] = __expf(key2f(t2[k] & ~255) - mx); sum += sv[k]; }
      const float is = 1.f / sum;
#pragma unroll
      for (int k = 0; k < 16; ++k) {
        const int code = t2[k] & 255;
        const int ia = 127 - (lsA[lane * 17 + (code >> 4)] & 127), ib = 127 - (lsB[lane * 17 + (code & 15)] & 127);
        res_e[tk * 128 + hh * 16 + k] = ia * 128 + ib;
        res_g[tk * 128 + hh * 16 + k] = sv[k] * is;
      }
    }
    wave_lds_fence();
    u32x2 ud[2][16];
    u32x4 hqn; float hstepn;
    const int l32 = lane & 31, hf = lane >> 5;
    const __amdgpu_buffer_rsrc_t rsU = __builtin_amdgcn_make_buffer_rsrc((void*)p.ut4, 0, 16384 * 512, 0x00020000);
    const __amdgpu_buffer_rsrc_t rsV = __builtin_amdgcn_make_buffer_rsrc((void*)p.vt8, 0, 16384 * 512, 0x00020000);
    const unsigned uo8 = (unsigned)lane * 8u, vo16 = (unsigned)l32 * 16u;
#define GU_LOAD_AT(SET, REP) { _Pragma("unroll") for (int s2 = 0; s2 < 16; ++s2) ud[SET][s2] = __builtin_amdgcn_raw_buffer_load_b64(rsU, ((unsigned)(REP)[s2] << 9) + uo8, 0, 0); }
    hqn = *(const u32x4*)(p.hq8 + (size_t)m8 * DM + lane * 16); hstepn = p.hstep[m8];
#pragma unroll 1
    for (int tk = 0; tk < 8; ++tk) {
      const int m = m8 + tk;
      int bb, t_, T_; tok_info(m, bb, t_, T_);
      const char* xb_ = (const char*)p.out + (size_t)m * 4096 + 2048 + ((lane & 31) * 32 + (lane >> 5) * 16) * 2;
      u32x4 xw0 = *(const u32x4*)xb_, xw1 = *(const u32x4*)(xb_ + 16);
      int hq[4];
      hq[0] = (int)hqn.x; hq[1] = (int)hqn.y; hq[2] = (int)hqn.z; hq[3] = (int)hqn.w;
      const float hstep = hstepn;
      const int* re = res_e + tk * 128;
      const float* rg = res_g + tk * 128;
      const int he0 = (int)__builtin_amdgcn_perm((uint32_t)hq[1], (uint32_t)hq[0], 0x06040200u), ho0 = (int)__builtin_amdgcn_perm((uint32_t)hq[1], (uint32_t)hq[0], 0x07050301u);
      const int he1 = (int)__builtin_amdgcn_perm((uint32_t)hq[3], (uint32_t)hq[2], 0x06040200u), ho1 = (int)__builtin_amdgcn_perm((uint32_t)hq[3], (uint32_t)hq[2], 0x07050301u);
      int hsum = __builtin_amdgcn_sdot4(hq[0], 0x01010101, 0, false);
      hsum = __builtin_amdgcn_sdot4(hq[1], 0x01010101, hsum, false); hsum = __builtin_amdgcn_sdot4(hq[2], 0x01010101, hsum, false); hsum = __builtin_amdgcn_sdot4(hq[3], 0x01010101, hsum, false);
      const float hoffT = 8.f * wave_sum((float)hsum);
#define GU_LOAD(SET, B_) { _Pragma("unroll") for (int s2 = 0; s2 < 16; ++s2) ud[SET][s2] = __builtin_amdgcn_raw_buffer_load_b64(rsU, ((unsigned)re[(B_) * 16 + s2] << 9) + uo8, 0, 0); }
#define GU_DOT(SET) { _Pragma("unroll") for (int s2 = 0; s2 < 16; ++s2) { const u32x2 u0 = ud[SET][s2]; \
        int d = __builtin_amdgcn_sdot4((int)(u0.x & 0x0f0f0f0fu), he0, 0, false); d = __builtin_amdgcn_sdot4((int)((u0.x >> 4) & 0x0f0f0f0fu), ho0, d, false); \
        d = __builtin_amdgcn_sdot4((int)(u0.y & 0x0f0f0f0fu), he1, d, false); d = __builtin_amdgcn_sdot4((int)((u0.y >> 4) & 0x0f0f0f0fu), ho1, d, false); \
        part[s2] = (float)d; } }
      u32x4 wn[4]; float cn[4];
      GU_LOAD_AT(0, re);
#pragma unroll 1
      for (int b2 = 0; b2 < 4; ++b2) {
#pragma unroll
       for (int par = 0; par < 2; ++par) {
        const int b = b2 * 2 + par;
        float part[16];
        if (par == 0) { GU_LOAD(1, b + 1); GU_DOT(0); }
        else {
          if (b + 1 < 8) { GU_LOAD(0, b + 1); }
          else {
            { const i32x4 e4_ = *(const i32x4*)(re + hf * 64); _Pragma("unroll") for (int k = 0; k < 4; ++k) wn[k] = __builtin_amdgcn_raw_buffer_load_b128(rsV, ((unsigned)e4_[k] << 9) + vo16, 0, 0); }
          }
          GU_DOT(1);
        }
        {
          typedef unsigned u2_ __attribute__((ext_vector_type(2)));
#pragma unroll
          for (int k = 0; k < 8; ++k) { const u2_ r = __builtin_amdgcn_permlane32_swap(__float_as_uint(part[k]), __float_as_uint(part[k + 8]), false, false); part[k] = __uint_as_float(r.x) + __uint_as_float(r.y); }
#pragma unroll
          for (int k = 0; k < 4; ++k) { const u2_ r = __builtin_amdgcn_permlane16_swap(__float_as_uint(part[k]), __float_as_uint(part[k + 4]), false, false); part[k] = __uint_as_float(r.x) + __uint_as_float(r.y); }
        }
        {
          const bool up = (lane & 8) != 0;
#pragma unroll
          for (int k = 0; k < 2; ++k) { float a_ = part[k], b_ = part[k + 2]; float send = up ? a_ : b_, keep = up ? b_ : a_; part[k] = keep + dppf_(send, 0x128); }
        }
        float totf;
        {
          const bool up = (lane & 4) != 0;
          float a_ = part[0], b_ = part[1]; float send = up ? a_ : b_, keep = up ? b_ : a_; totf = keep + dppf_(send, 0x141);
        }
        totf += dppf_(totf, 0x4E); totf += dppf_(totf, 0xB1);
        const int slot = b * 16 + (lane >> 2);
        const int e = re[slot];
        const float tot = (totf - hoffT) * hstep * p.ustep[e];
        const float act = 0.5f * tot * (1.f + erff(tot * 0.70710678f));
        if ((lane & 3) == 0) coefs[slot] = rg[slot] * act * p.vstep[e];
       }
      }
      wave_lds_fence();
      v32f acc;
#pragma unroll
      for (int i = 0; i < 32; ++i) acc[i] = 0.f;
#define V4_DEC(W, D, B) { const f32x2 d_ = __builtin_amdgcn_cvt_scalef32_pk_f32_fp4(W, 1.0f, B); acc[8 * (D) + 2 * (B)] += d_.x * cf; acc[8 * (D) + 2 * (B) + 1] += d_.y * cf; }
#define V4_DEC4(W, D) V4_DEC(W, D, 0) V4_DEC(W, D, 1) V4_DEC(W, D, 2) V4_DEC(W, D, 3)
#define V4_FETCH(BODY, W, C) { const i32x4 e4_ = *(const i32x4*)(re + hf * 64 + (BODY) * 4); const f32x4 c4_ = *(const f32x4*)(coefs + hf * 64 + (BODY) * 4); \
        _Pragma("unroll") for (int k = 0; k < 4; ++k) { C[k] = c4_[k]; W[k] = __builtin_amdgcn_raw_buffer_load_b128(rsV, ((unsigned)e4_[k] << 9) + vo16, 0, 0); } }
#define V4_BODY(W, C) { _Pragma("unroll") for (int k = 0; k < 4; ++k) { const float cf = C[k]; const u32x4 w4 = W[k]; \
        V4_DEC4(w4.x, 0) V4_DEC4(w4.y, 1) V4_DEC4(w4.z, 2) V4_DEC4(w4.w, 3) } }
      u32x4 wB[4]; float cB[4];
#pragma unroll
      for (int k = 0; k < 4; ++k) cn[k] = coefs[hf * 64 + k];
      if (tk + 1 < 8) { hqn = *(const u32x4*)(p.hq8 + (size_t)(m + 1) * DM + lane * 16); hstepn = p.hstep[m + 1]; }
#pragma unroll 1
      for (int body = 0; body < 16; body += 2) {
        V4_FETCH(body + 1, wB, cB);
        __builtin_amdgcn_sched_barrier(0);
        V4_BODY(wn, cn);
        if (body + 2 < 16) V4_FETCH(body + 2, wn, cn);
        __builtin_amdgcn_sched_barrier(0);
        V4_BODY(wB, cB);
      }
      wave_lds_fence();
#pragma unroll
      for (int i = 0; i < 16; ++i) {
        const pl_u2 r = __builtin_amdgcn_permlane32_swap(__float_as_uint(acc[i]), __float_as_uint(acc[16 + i]), false, false);
        const float sfull = __uint_as_float(r.x) + __uint_as_float(r.y);
        acc[i] = sfull; acc[16 + i] = sfull;
      }
      float* orow = p.out + (size_t)m * DM + l32 * 32 + hf * 16;
      const float* gt2 = p.mod + bb * 6144 + 5120 + l32 * 32 + hf * 16;
      asm volatile("" : "+v"(xw0), "+v"(xw1));
#pragma unroll
      for (int j = 0; j < 4; ++j) {
        const uint32_t wa_ = (j < 2 ? xw0 : xw1)[(j & 1) * 2], wb_ = (j < 2 ? xw0 : xw1)[(j & 1) * 2 + 1];
        f32x4 xa; xa[0] = __uint_as_float(wa_ << 16); xa[1] = __uint_as_float(wa_ & 0xffff0000u); xa[2] = __uint_as_float(wb_ << 16); xa[3] = __uint_as_float(wb_ & 0xffff0000u);
        const f32x4 ga = *(const f32x4*)(gt2 + 4 * j);
#pragma unroll
        for (int k = 0; k < 4; ++k) xa[k] += ga[k] * (hf ? acc[16 + 4 * j + k] : acc[4 * j + k]);
        *(f32x4*)(orow + 4 * j) = xa;
      }
    }
    wave_lds_fence();
  }
}

#define XB_TMO      128
#define XB_XCNT(j)  (256  + 64 * (j))
#define XB_XSUB(j)  (1280 + 64 * (j))
#define XB_XGEN(j)  (2304 + 64 * (j))
#define XB_TOP      3328
#define XB_TOPGEN   3392
#define XCD_BAR_WORDS 3456
#define XB_SPIN_CAP (1u << 23)
__device__ __forceinline__ unsigned xb_ld(unsigned* p_) { return __hip_atomic_load(p_, __ATOMIC_RELAXED, __HIP_MEMORY_SCOPE_AGENT); }
__device__ __forceinline__ unsigned xb_add(unsigned* p_, unsigned v) { return __hip_atomic_fetch_add(p_, v, __ATOMIC_RELAXED, __HIP_MEMORY_SCOPE_AGENT); }
__device__ __forceinline__ unsigned xb_xcc_id() { return (unsigned)__builtin_amdgcn_s_getreg((3 << 11) | 20) & 0xFu; }
#define XB_SPIN(cond, bar) do { unsigned _sp = 0; while (cond) { __builtin_amdgcn_s_sleep(1); \
    if ((++_sp & 255u) == 0u) { if (xb_ld(&(bar)[XB_TMO])) break; if (_sp > XB_SPIN_CAP) { atomicAdd(&(bar)[XB_TMO], 1u); break; } } } } while (0)
struct XcdBarrier { unsigned* bar; unsigned x; volatile LAS unsigned* st; };
__device__ __forceinline__ XcdBarrier xcd_barrier_post(unsigned* bar, volatile LAS unsigned* st) {
  XcdBarrier b; b.bar = bar; b.x = xb_xcc_id(); b.st = st;
  if (threadIdx.x == 0) (void)xb_add(&bar[XB_XCNT(b.x)], 1u);
  return b;
}
__device__ __forceinline__ void xcd_barrier_complete(unsigned* bar, unsigned x, unsigned& nloc, unsigned& nx) {
  const unsigned G = gridDim.x * gridDim.y * gridDim.z;
  unsigned sum, cnt, mine, sp = 0u;
  for (;;) {
    sum = 0u; cnt = 0u; mine = 0u;
#pragma unroll
    for (unsigned j = 0; j < 16; ++j) { const unsigned c = xb_ld(&bar[XB_XCNT(j)]); sum += c; cnt += (c > 0u) ? 1u : 0u; mine = (j == x) ? c : mine; }
    if (sum == G) break;
    __builtin_amdgcn_s_sleep(1);
    if ((++sp & 255u) == 0u) { if (xb_ld(&bar[XB_TMO])) break; if (sp > XB_SPIN_CAP) { atomicAdd(&bar[XB_TMO], 1u); break; } }
  }
  nloc = mine > 0u ? mine : 1u; nx = cnt > 0u ? cnt : 1u;
}
__device__ __forceinline__ void xcd_barrier(const XcdBarrier& b) {
  asm volatile("s_waitcnt vmcnt(0)" ::: "memory");
  __syncthreads();
  if (threadIdx.x == 0) {
    unsigned* bar = b.bar;
    __builtin_amdgcn_s_waitcnt(0);
    unsigned nloc = b.st[0], nx = b.st[1];
    if (nloc == 0u) { xcd_barrier_complete(bar, b.x, nloc, nx); b.st[0] = nloc; b.st[1] = nx; }
    const unsigned old = xb_add(&bar[XB_XSUB(b.x)], 1u);
    const unsigned gen = old / nloc;
    if (old + 1u == (gen + 1u) * nloc) {
      __builtin_amdgcn_fence(__ATOMIC_RELEASE, "agent");
      asm volatile("s_waitcnt vmcnt(0)" ::: "memory");
      const unsigned og = xb_add(&bar[XB_TOP], 1u);
      const unsigned tg = og / nx;
      if (og + 1u == (tg + 1u) * nx) xb_add(&bar[XB_TOPGEN], 1u);
      else XB_SPIN(xb_ld(&bar[XB_TOPGEN]) == tg, bar);
      __builtin_amdgcn_fence(__ATOMIC_ACQUIRE, "agent");
      xb_add(&bar[XB_XGEN(b.x)], 1u);
      asm volatile("s_waitcnt vmcnt(0)" ::: "memory");
    } else {
      XB_SPIN(xb_ld(&bar[XB_XGEN(b.x)]) == gen, bar);
      __builtin_amdgcn_fence(__ATOMIC_ACQUIRE, "agent");
      asm volatile("s_waitcnt vmcnt(0)" ::: "memory");
    }
  }
  __syncthreads();
}

__global__ void __launch_bounds__(NTHR, 2) mega(P p) {
  __shared__ __attribute__((aligned(16))) char smem[77056];
  cg::grid_group grid = cg::this_grid();
  __shared__ __attribute__((aligned(16))) unsigned xb_words[4];
  if (threadIdx.x == 0) { xb_words[0] = 0u; xb_words[1] = 0u; xb_words[2] = 0u; xb_words[3] = 0u; }
  __syncthreads();
  XcdBarrier xb = xcd_barrier_post(p.bar, (volatile LAS unsigned*)xb_words);
  float* fs = (float*)smem;
  if (blockIdx.x == 0 && threadIdx.x == 0) { p.ctr[0] = 0; p.ctr[1] = 0; }
  phase_mod(p, fs);
  phase_wq8(p.w_in, 2688, p.w_in8, p.w_in_s, fs);
  phase_transpose_all(p, fs);
  phase_lorafrag(p);
  for (int i = blockIdx.x * 4 + threadIdx.x; threadIdx.x < 4 && i < 2048; i += gridDim.x * 4) {
    float sn, cs; sincosf((float)(i >> 4) * powf(10000.f, -(float)(i & 15) / 16.f), &sn, &cs);
    p.rope[2 * i] = cs; p.rope[2 * i + 1] = sn;
  }
  for (int i = blockIdx.x * NTHR + threadIdx.x; i < 32768; i += gridDim.x * NTHR) p.skb[i] = f2bf(p.subk[i]);
  if (p.never) grid.sync();
  xcd_barrier(xb);
  phase_norm(p, 1);
  xcd_barrier(xb);
  float bmax;
  {
    float gq = fabsf(p.qn_g[threadIdx.x & 63]), gk = fabsf(p.kn_g[threadIdx.x & 63]);
#pragma unroll
    for (int o = 32; o >= 1; o >>= 1) { gq = fmaxf(gq, __shfl_xor(gq, o)); gk = fmaxf(gk, __shfl_xor(gk, o)); }
    bmax = 64.f * QSCALE * 1.02f * gq * gk;
  }
  const bool use_f8 = bmax * 1.13f < 15.5f;
  phase_gemm<0>(p, smem, 0, NTOK, use_f8);
  xcd_barrier(xb);
  phase_shift(p);
  xcd_barrier(xb);
  phase_scan(p, smem);
  {
    if (use_f8) phase_attn_f8(p, smem);
    else if (bmax < 100.f) phase_attn_fast(p, smem);
    else phase_attn(p, smem);
  }
  xcd_barrier(xb);
  const bool conv_first = ((blockIdx.x >> 3) & 1u) != 0u;
  if (conv_first) phase_convert8<0>(p);
  phase_post(p, smem);
  if (!conv_first) phase_convert8<0>(p);
  xcd_barrier(xb);
  phase_gemm<1>(p, smem, 0, NTOK);
  xcd_barrier(xb);
  phase_norm(p, 2);
  xcd_barrier(xb);
#pragma unroll 1
  for (int pass = 0; pass < 2; ++pass) {
    if ((pass == 0) == conv_first) phase_convert8<1>(p); else phase_peerq(p, smem);
  }
  xcd_barrier(xb);
  phase_gather(p, smem);
}

extern "C" void kernel_launch(void* const* d_in, const int* in_sizes, int n_in, void* d_out, int out_size, void* d_ws, size_t ws_size, hipStream_t stream) {
  P p{};
  const float* const* in = (const float* const*)d_in;
  p.x_prompt = in[0]; p.x_sample = in[1]; p.c_prompt = in[2]; p.c_sample = in[3]; p.ada_w = in[4]; p.ada_b = in[5]; p.norm1_g = in[6]; p.norm2_g = in[7];
  p.w_in = in[8]; p.mu = in[9]; p.w0 = in[10]; p.w2 = in[11]; p.a0 = in[12]; p.a2 = in[13]; p.g2 = in[14]; p.k_k = in[15]; p.k_a = in[16]; p.r_k = in[17];
  p.ln_w = in[18]; p.ln_b = in[19]; p.qn_g = in[20]; p.kn_g = in[21]; p.ao_g = in[22]; p.w_out = in[23]; p.wq = in[24]; p.subk = in[25]; p.u_tab = in[26]; p.v_tab = in[27];
  p.out = (float*)d_out;
  char* ws = (char*)d_ws;
  const size_t MiB = 1048576;
  p.w_inT = (bf16_t*)(ws + 0);
  p.w_outT = (bf16_t*)(ws + 6 * MiB);
  p.wqT = (bf16_t*)(ws + 8 * MiB);
  p.mod = (float*)(ws + 12 * MiB);
  p.ctr = (int*)(ws + 12 * MiB + 512 * 1024);
  p.bar = (unsigned*)(ws + 12 * MiB + 640 * 1024);
  p.sflag = (unsigned*)(ws + 12 * MiB + 704 * 1024);
  p.Q8 = (unsigned char*)(ws + 275 * MiB);
  p.V8t = (unsigned char*)(ws + 295 * MiB);
  p.K8 = (unsigned char*)(ws + 291 * MiB);
  p.ring = ws + 248 * MiB;
  p.cd = (float*)(ws + 13 * MiB);
  p.w2f = (bf16_t*)(ws + 15 * MiB);
  p.a2f = (bf16_t*)(ws + 15 * MiB + 256 * 1024);
  p.skb = (bf16_t*)(ws + 15 * MiB + 512 * 1024);
  p.g2T = (bf16_t*)(ws + 15 * MiB + 768 * 1024);
  p.rope = (float*)(ws + 15 * MiB + 896 * 1024);
  p.w_in_s = (float*)(ws + 15 * MiB + 912 * 1024);
  p.wq_s = (float*)(ws + 15 * MiB + 924 * 1024);
  p.w_in8 = (unsigned char*)(ws + 0);
  p.wq8 = (unsigned char*)(ws + 8 * MiB);
  p.topl = (int*)(ws + 80 * MiB);
  p.hq8 = (unsigned char*)(ws + 112 * MiB);
  p.hstep = (float*)(ws + 144 * MiB);
  p.hs1 = (float*)(ws + 12 * MiB + 256 * 1024);
  p.ut8 = (unsigned char*)(ws + 16 * MiB);
  p.ut4 = (unsigned char*)(ws + 248 * MiB);
  p.vt8 = (unsigned char*)(ws + 256 * MiB);
  p.ustep = (float*)(ws + 15 * MiB + 640 * 1024);
  p.vstep = (float*)(ws + 15 * MiB + 704 * 1024);
  p.proj = (bf16_t*)(ws + 16 * MiB);
  p.h2 = (bf16_t*)(ws + 184 * MiB);
  p.h = (bf16_t*)d_out;
  p.h8 = (unsigned char*)d_out + 64 * MiB;
  p.yd = (bf16_t*)((char*)d_out + 64 * MiB);
  p.Kc = (bf16_t*)((char*)d_out + 48 * MiB);
  p.Vt = (bf16_t*)((char*)d_out + 56 * MiB);
  p.ps_vwa = (bf16_t*)d_out;
  p.ps_rk = (bf16_t*)(ws + 184 * MiB);
  p.ut = (bf16_t*)(ws + 16 * MiB);
  p.vt = (bf16_t*)(ws + 48 * MiB);
  p.eidx = (int*)(ws + 80 * MiB);
  p.gate = (float*)(ws + 96 * MiB);
  p.qp = (bf16_t*)(ws + 112 * MiB);

  static int grid_blocks = 0;
  if (!grid_blocks) {
    int dev = 0, cus = 0, per_cu = 0;
    (void)hipGetDevice(&dev);
    (void)hipDeviceGetAttribute(&cus, hipDeviceAttributeMultiprocessorCount, dev);
    (void)hipOccupancyMaxActiveBlocksPerMultiprocessor(&per_cu, mega, NTHR, 0);
    if (per_cu < 1) per_cu = 1;
    grid_blocks = cus * per_cu;
  }
  (void)hipMemsetAsync(p.bar, 0, 192 * 1024, stream);
  void* args[] = {&p};
  hipError_t e = hipLaunchCooperativeKernel((void*)mega, dim3(grid_blocks), dim3(NTHR), args, 0, stream);
  if (e != hipSuccess) fprintf(stderr, "cooperative launch failed: %s (grid %d)\n", hipGetErrorString(e), grid_blocks);
}
```
